# Optimizing an MI355X kernel written in HIP

```python
import math
import jax, jax.numpy as jnp
from jax import lax
import numpy as np

D_MODEL = 2048
BATCH = 1
SEQ = 8192
DEPTH = 4

D_MIX = D_MODEL
ATTN_WIDTH = D_MIX // 2
CONV_WIDTH = D_MIX - ATTN_WIDTH
DIFF_HEAD_DIM = 64
V_HEAD_DIM = 2 * DIFF_HEAD_DIM
N_DIFF_HEADS = ATTN_WIDTH // V_HEAD_DIM
CONV_GROUP = 128
N_CONV_GROUPS = CONV_WIDTH // CONV_GROUP
ROT_DIM = DIFF_HEAD_DIM // 4
ROPE_THETA = 500000.0
CONV_K = 3
D_FF = 5632
BLOCK_Q = 128
EPS = 1e-5
IN_WIDTH = 3 * ATTN_WIDTH + 3 * CONV_WIDTH
NEG_INF = -1e30

kernel_name = 'hymba_diffattn_shortconv_macaron'


def rms_norm(x, g):
    xf = x.astype(jnp.float32)
    y = xf * lax.rsqrt(jnp.mean(xf * xf, axis=-1, keepdims=True) + EPS)
    return (y * g.astype(jnp.float32)).astype(x.dtype)


def swiglu(h, w_gate, w_up, w_down):
    return (jax.nn.silu(h @ w_gate) * (h @ w_up)) @ w_down


def lambda_init_fn(layer_idx):
    return 0.8 - 0.6 * math.exp(-0.3 * layer_idx)


def rope_tables(seq):
    pos = jnp.arange(seq, dtype=jnp.float32)
    inv_freq = ROPE_THETA ** (-jnp.arange(0, ROT_DIM, 2, dtype=jnp.float32) / ROT_DIM)
    ang = pos[:, None] * inv_freq[None, :]
    return jnp.cos(ang), jnp.sin(ang)


def apply_partial_rope(t, cos, sin):
    rot, rest = t[..., :ROT_DIM], t[..., ROT_DIM:]
    x1, x2 = rot[..., :ROT_DIM // 2], rot[..., ROT_DIM // 2:]
    c = cos[:, None, None, :].astype(t.dtype)
    s = sin[:, None, None, :].astype(t.dtype)
    return jnp.concatenate([x1 * c - x2 * s, x2 * c + x1 * s, rest], axis=-1)


def diff_attention(q1, q2, k1, k2, v, lam):
    b, s, h, d = q1.shape
    nb = s // BLOCK_Q
    scale = d ** -0.5
    kpos = jnp.arange(s)

    def to_blocks(t):
        return jnp.moveaxis(t.reshape(b, nb, BLOCK_Q, h, t.shape[-1]), 1, 0)

    def one_block(args):
        q1b, q2b, start = args
        qpos = start + jnp.arange(BLOCK_Q)
        mask = kpos[None, :] <= qpos[:, None]

        def probs(qb, k):
            sc = jnp.einsum('bqhd,bkhd->bhqk', qb, k).astype(jnp.float32) * scale
            return jax.nn.softmax(jnp.where(mask, sc, NEG_INF), axis=-1)

        attn = probs(q1b, k1) - lam * probs(q2b, k2)
        return jnp.einsum('bhqk,bkhe->bqhe', attn.astype(v.dtype), v)

    starts = jnp.arange(nb) * BLOCK_Q
    out = lax.map(one_block, (to_blocks(q1), to_blocks(q2), starts))
    return jnp.moveaxis(out, 0, 1).reshape(b, s, h, v.shape[-1])


def causal_depthwise_conv(u, w):
    return lax.conv_general_dilated(
        u, w[:, None, :].astype(u.dtype), window_strides=(1,),
        padding=[(CONV_K - 1, 0)], dimension_numbers=('NWC', 'WIO', 'NWC'),
        feature_group_count=u.shape[-1])


def hybrid_mixer(h, w_in, conv_w, lq1, lk1, lq2, lk2, subln_w, w_out, lambda_init, cos, sin):
    b, s, _ = h.shape
    proj = h @ w_in
    q, k, v, gate_b, gate_c, u = jnp.split(
        proj, [ATTN_WIDTH, 2 * ATTN_WIDTH, 3 * ATTN_WIDTH,
               3 * ATTN_WIDTH + CONV_WIDTH, 3 * ATTN_WIDTH + 2 * CONV_WIDTH], axis=-1)
    q = apply_partial_rope(q.reshape(b, s, N_DIFF_HEADS, 2, DIFF_HEAD_DIM), cos, sin)
    k = apply_partial_rope(k.reshape(b, s, N_DIFF_HEADS, 2, DIFF_HEAD_DIM), cos, sin)
    v = v.reshape(b, s, N_DIFF_HEADS, V_HEAD_DIM)
    f32 = jnp.float32
    lam = (jnp.exp(jnp.sum(lq1.astype(f32) * lk1.astype(f32)))
           - jnp.exp(jnp.sum(lq2.astype(f32) * lk2.astype(f32))) + lambda_init)
    attn = diff_attention(q[..., 0, :], q[..., 1, :], k[..., 0, :], k[..., 1, :], v, lam)
    attn = (rms_norm(attn, subln_w) * (1.0 - lambda_init)).reshape(b, s, ATTN_WIDTH)
    conv_out = gate_b * causal_depthwise_conv(gate_c * u, conv_w)
    return jnp.concatenate([attn, conv_out], axis=-1) @ w_out


def setup_inputs(seed: int = 0) -> dict:
    key = jax.random.key(seed)
    ks = jax.random.split(key, 20)
    f32 = jnp.float32

    def nrm(k, shape, scale):
        return jax.random.normal(k, shape, f32) * scale

    def gain(k, shape):
        return 1.0 + 0.02 * jax.random.normal(k, shape, f32)

    return {
        'x': nrm(ks[0], (BATCH, SEQ, D_MODEL), 1.0),
        'norm_ffn1': gain(ks[1], (DEPTH, D_MODEL)),
        'ffn1_w_gate': nrm(ks[2], (DEPTH, D_MODEL, D_FF), D_MODEL ** -0.5),
        'ffn1_w_up': nrm(ks[3], (DEPTH, D_MODEL, D_FF), D_MODEL ** -0.5),
        'ffn1_w_down': nrm(ks[4], (DEPTH, D_FF, D_MODEL), D_FF ** -0.5),
        'norm_mix': gain(ks[5], (DEPTH, D_MODEL)),
        'w_in': nrm(ks[6], (DEPTH, D_MODEL, IN_WIDTH), D_MODEL ** -0.5),
        'conv_w': nrm(ks[7], (DEPTH, CONV_K, CONV_WIDTH), CONV_K ** -0.5),
        'lambda_q1': nrm(ks[8], (DEPTH, DIFF_HEAD_DIM), 0.1),
        'lambda_k1': nrm(ks[9], (DEPTH, DIFF_HEAD_DIM), 0.1),
        'lambda_q2': nrm(ks[10], (DEPTH, DIFF_HEAD_DIM), 0.1),
        'lambda_k2': nrm(ks[11], (DEPTH, DIFF_HEAD_DIM), 0.1),
        'subln_w': gain(ks[12], (DEPTH, V_HEAD_DIM)),
        'w_out': nrm(ks[13], (DEPTH, D_MIX, D_MODEL), D_MIX ** -0.5),
        'norm_ffn2': gain(ks[14], (DEPTH, D_MODEL)),
        'ffn2_w_gate': nrm(ks[15], (DEPTH, D_MODEL, D_FF), D_MODEL ** -0.5),
        'ffn2_w_up': nrm(ks[16], (DEPTH, D_MODEL, D_FF), D_MODEL ** -0.5),
        'ffn2_w_down': nrm(ks[17], (DEPTH, D_FF, D_MODEL), D_FF ** -0.5),
        'norm_final': gain(ks[18], (D_MODEL,)),
    }


def reference(x, norm_ffn1, ffn1_w_gate, ffn1_w_up, ffn1_w_down, norm_mix, w_in, conv_w,
              lambda_q1, lambda_k1, lambda_q2, lambda_k2, subln_w, w_out,
              norm_ffn2, ffn2_w_gate, ffn2_w_up, ffn2_w_down, norm_final):
    cos, sin = rope_tables(x.shape[1])
    for l in range(DEPTH):
        lambda_init = lambda_init_fn(l)
        x = x + 0.5 * swiglu(rms_norm(x, norm_ffn1[l]), ffn1_w_gate[l], ffn1_w_up[l], ffn1_w_down[l])
        x = x + hybrid_mixer(rms_norm(x, norm_mix[l]), w_in[l], conv_w[l],
                             lambda_q1[l], lambda_k1[l], lambda_q2[l], lambda_k2[l],
                             subln_w[l], w_out[l], lambda_init, cos, sin)
        x = x + 0.5 * swiglu(rms_norm(x, norm_ffn2[l]), ffn2_w_gate[l], ffn2_w_up[l], ffn2_w_down[l])
    return rms_norm(x, norm_final)
```

```cpp
#include <hip/hip_runtime.h>
#include <cstdio>
#include <cstdint>
namespace pg8 {
#define PG8_LAS __attribute__((address_space(3)))
typedef unsigned short bf16_t;
typedef short bf16x8 __attribute__((ext_vector_type(8)));
typedef float f32x4 __attribute__((ext_vector_type(4)));
typedef unsigned u32x4 __attribute__((ext_vector_type(4)));
constexpr int BM = 256, BK = 64, HALF = 128, HTB = HALF * BK * 2  , STAGE_BYTES = 8 * HTB, NXCD = 8, WGM = 8;

__host__ __device__ __forceinline__ int lds_byte(int r, int c) { const int st = (r >> 4) * 2 + (c >> 5), rr = r & 15, cc = c & 31, ob = rr * 64 + cc * 2; return st * 1024 + (ob ^ (((ob >> 9) & 1) << 5)); }
__host__ __device__ __forceinline__ void stage_rc(int b, int& R, int& C) { const int st = b / 1024, sb = b % 1024, swz = sb ^ (((sb >> 9) & 1) << 5); R = (st >> 1) * 16 + swz / 64; C = (st & 1) * 32 + (swz % 64) / 2; }
__host__ __device__ __forceinline__ int perm32(int rho) { const int n = rho >> 4, i = rho & 15; return 8 * (i >> 2) + 4 * n + (i & 3); }

struct Unit { int pm, pn; };
struct Gemm { const bf16_t* A; const bf16_t* Bt; int M, N, K; };

struct StaticOrder {
    int nM, nN, nwg, G, c;
    __host__ __device__ void init(int M, int N, int G_, int c_) { nM = M / BM; nN = N / BM; nwg = nM * nN; G = G_; c = c_; }
    __host__ __device__ bool next(int i, Unit& u) const {
        const long L = (long)i * G + c; if (L >= nwg) return false;
        int wgid = (int)L; { const int q = nwg / NXCD, r = nwg % NXCD, xcd = wgid % NXCD, off = wgid / NXCD; wgid = (xcd < r ? xcd * (q + 1) : r * (q + 1) + (xcd - r) * q) + off; }
        const int nig = WGM * nN, gid = wgid / nig, fm = gid * WGM, gsz = (nM - fm) < WGM ? (nM - fm) : WGM;
        u.pm = fm + ((wgid % nig) % gsz); u.pn = (wgid % nig) / gsz; return true;
    }
    __device__ __forceinline__ void a_ready(const Unit&) const {}
    __device__ __forceinline__ void done(const Unit&) const {}
};

__device__ __forceinline__ unsigned cvt_pk_bf16(float lo, float hi) { unsigned r; asm volatile("v_cvt_pk_bf16_f32 %0, %1, %2" : "=v"(r) : "v"(lo), "v"(hi)); return r; }
typedef float f32x2 __attribute__((ext_vector_type(2)));
__device__ __forceinline__ float silu_f(float g) { const float e = __builtin_amdgcn_exp2f(g * -1.4426950408889634f); return g * __builtin_amdgcn_rcpf(1.0f + e); }
struct EpiSwiGLU {
    static constexpr bool PERM = true, AFTER_DRAIN = false;
    bf16_t* O; int ldc;
    __device__ __forceinline__ void operator()(const f32x4 (&acc)[2][2][4][2], const Unit& u, int wr, int wc, int fr, int fq) const {
        const int row0 = u.pm * BM + wr * 64 + fr, col0 = u.pn * HALF + wc * 32 + 8 * fq;
#pragma unroll
        for (int ai = 0; ai < 2; ++ai)
#pragma unroll
            for (int m = 0; m < 4; ++m) { bf16_t* rowp = O + (size_t)(row0 + ai * HALF + m * 16) * ldc + col0;
                const f32x4 g0 = acc[ai][0][m][0], g1 = acc[ai][0][m][1], u0 = acc[ai][1][m][0], u1 = acc[ai][1][m][1];
                u32x4 w; w.x = cvt_pk_bf16(silu_f(g0[0]) * u0[0], silu_f(g0[1]) * u0[1]); w.y = cvt_pk_bf16(silu_f(g0[2]) * u0[2], silu_f(g0[3]) * u0[3]);
                w.z = cvt_pk_bf16(silu_f(g1[0]) * u1[0], silu_f(g1[1]) * u1[1]); w.w = cvt_pk_bf16(silu_f(g1[2]) * u1[2], silu_f(g1[3]) * u1[3]);
                *(u32x4*)rowp = w; }
    }
};
struct EpiResidual {
    static constexpr bool PERM = false, AFTER_DRAIN = false;
    const float* base; float* out; int ldc; float scale;
    __device__ __forceinline__ void operator()(const f32x4 (&acc)[2][2][4][2], const Unit& u, int wr, int wc, int fr, int fq) const {
        const int row0 = u.pm * BM + wr * 64 + fr, col0 = u.pn * BM + wc * 32 + 4 * fq;
#pragma unroll
        for (int ai = 0; ai < 2; ++ai)
#pragma unroll
            for (int m = 0; m < 4; ++m) { const size_t off = (size_t)(row0 + ai * HALF + m * 16) * ldc + col0;
#pragma unroll
                for (int bj = 0; bj < 2; ++bj)
#pragma unroll
                    for (int n = 0; n < 2; ++n) { const f32x4 b = *(const f32x4*)(base + off + bj * HALF + n * 16); *(f32x4*)(out + off + bj * HALF + n * 16) = b + acc[ai][bj][m][n] * scale; } }
    }
};
struct EpiWin {
    static constexpr bool PERM = true, AFTER_DRAIN = false;
    bf16_t *Q, *Kb, *V, *GB, *CU; const float* cs; float qscale;
    __device__ __forceinline__ void operator()(const f32x4 (&acc)[2][2][4][2], const Unit& u, int wr, int wc, int fr, int fq) const {
        const int row0 = u.pm * BM + wr * 64 + fr; const int pn = u.pn;
        if (pn >= 16) {
            const int col0 = (pn - 16) * HALF + wc * 32 + 8 * fq;
#pragma unroll
            for (int ai = 0; ai < 2; ++ai)
#pragma unroll
                for (int m = 0; m < 4; ++m) { bf16_t* rowp = CU + (size_t)(row0 + ai * HALF + m * 16) * 1024 + col0;
                    const f32x4 a0 = acc[ai][0][m][0] * acc[ai][1][m][0], a1 = acc[ai][0][m][1] * acc[ai][1][m][1];
                    u32x4 w; w.x = cvt_pk_bf16(a0[0], a0[1]); w.y = cvt_pk_bf16(a0[2], a0[3]); w.z = cvt_pk_bf16(a1[0], a1[1]); w.w = cvt_pk_bf16(a1[2], a1[3]);
                    *(u32x4*)rowp = w; }
            return;
        }
        bf16_t* base = pn < 4 ? Q : pn < 8 ? Kb : pn < 12 ? V : GB;
        const int col0 = (pn & 3) * BM + wc * 32 + 8 * fq;
        const bool rope = (pn < 8) && ((wc & 1) == 0) && (fq < 2);
        const float sc = pn < 4 ? qscale : 1.0f;
#pragma unroll
        for (int ai = 0; ai < 2; ++ai)
#pragma unroll
            for (int m = 0; m < 4; ++m) { const int row = row0 + ai * HALF + m * 16; bf16_t* rowp = base + (size_t)row * 1024 + col0;
                f32x4 c = (f32x4){1.f, 1.f, 1.f, 1.f}, s = (f32x4){0.f, 0.f, 0.f, 0.f};
                if (rope) { c = *(const f32x4*)(cs + (size_t)row * 16 + 4 * fq); s = *(const f32x4*)(cs + (size_t)row * 16 + 8 + 4 * fq); }
#pragma unroll
                for (int bj = 0; bj < 2; ++bj) { const f32x4 v0 = acc[ai][bj][m][0], v1 = acc[ai][bj][m][1];
                    f32x4 o0, o1;
                    o0[0] = v0[0] * c[0] - v0[1] * s[0]; o0[1] = v0[1] * c[0] + v0[0] * s[0]; o0[2] = v0[2] * c[1] - v0[3] * s[1]; o0[3] = v0[3] * c[1] + v0[2] * s[1];
                    o1[0] = v1[0] * c[2] - v1[1] * s[2]; o1[1] = v1[1] * c[2] + v1[0] * s[2]; o1[2] = v1[2] * c[3] - v1[3] * s[3]; o1[3] = v1[3] * c[3] + v1[2] * s[3];
                    o0 = o0 * sc; o1 = o1 * sc;
                    u32x4 w; w.x = cvt_pk_bf16(o0[0], o0[1]); w.y = cvt_pk_bf16(o0[2], o0[3]); w.z = cvt_pk_bf16(o1[0], o1[1]); w.w = cvt_pk_bf16(o1[2], o1[3]);
                    *(u32x4*)(rowp + bj * HALF) = w; } }
    }
};

template <class Epi, class Sched, bool ALIGN_EPI = false, bool SP2 = false>
__device__ __forceinline__ void gemm_phase(PG8_LAS unsigned char* lds, const Gemm g, const Sched& S, const Epi& E) {
    int tid_ = threadIdx.x; asm volatile("" : "+v"(tid_));
    const int tid = tid_, wid = __builtin_amdgcn_readfirstlane(tid >> 6), lane = tid & 63, wr = wid >> 2, wc = wid & 3, fr = lane & 15, fq = lane >> 4;
    const int K = g.K, nt = K / BK;
    unsigned voffA[2], voffB[2];
#pragma unroll
    for (int i = 0; i < 2; ++i) { int R, C; stage_rc(tid * 16 + i * 8192, R, C); const int Rb = Epi::PERM ? ((R & ~31) + perm32(R & 31)) : R;
        voffA[i] = (unsigned)(R * K + C) * 2u; voffB[i] = (unsigned)(Rb * K + C) * 2u; }
    const size_t kstep = (size_t)(BK * 2);
    const size_t hstep = (size_t)HALF * K * 2;
    const size_t tstep = 2 * hstep;
    const unsigned ldsw = (unsigned)wid * 1024u;
    const int aoff = lds_byte(wr * 64 + fr, fq * 8), boff = lds_byte(wc * 32 + fr, fq * 8);
#define PG8_SA(b, h) (((b) * 2 + (h)) * HTB)
#define PG8_SB(b, h) ((4 + (b) * 2 + (h)) * HTB)
#define PG8_STAGE(bufoff, gbase, voff) do { _Pragma("unroll") for (int _i = 0; _i < 2; ++_i) \
        __builtin_amdgcn_global_load_lds((const unsigned*)((const char*)(gbase) + (voff)[_i]), (PG8_LAS unsigned*)(lds + (bufoff) + ldsw + _i * 8192), 16, 0, 0); } while (0)
#define PG8_LDA(dst, b, h) do { _Pragma("unroll") for (int m = 0; m < 4; ++m) _Pragma("unroll") for (int k = 0; k < 2; ++k) dst[m][k] = *(const PG8_LAS bf16x8*)(lds + PG8_SA(b, h) + aoff + m * 2048 + k * 1024); } while (0)
#define PG8_LDB(dst, b, h) do { _Pragma("unroll") for (int n = 0; n < 2; ++n) _Pragma("unroll") for (int k = 0; k < 2; ++k) dst[n][k] = *(const PG8_LAS bf16x8*)(lds + PG8_SB(b, h) + boff + n * 2048 + k * 1024); } while (0)
#define PG8_MMA(ai, bj, At, Bt) do { __builtin_amdgcn_s_setprio(1); _Pragma("unroll") for (int m = 0; m < 4; ++m) _Pragma("unroll") for (int n = 0; n < 2; ++n) _Pragma("unroll") for (int k = 0; k < 2; ++k) \
        acc[ai][bj][m][n] = __builtin_amdgcn_mfma_f32_16x16x32_bf16(Bt[n][k], At[m][k], acc[ai][bj][m][n], 0, 0, 0); __builtin_amdgcn_s_setprio(0); } while (0)
#define PG8_WAIT_V(n) asm volatile("s_waitcnt vmcnt(" #n ")" ::: "memory")
#define PG8_WAIT_L(n) asm volatile("s_waitcnt lgkmcnt(" #n ")" ::: "memory")
#define PG8_BAR __builtin_amdgcn_s_barrier()
#define PG8_SCHED __builtin_amdgcn_sched_barrier(0)
    Unit cur, nxt; int ui = 0;
    if (!S.next(0, cur)) return;
    f32x4 acc[2][2][4][2];
#pragma unroll
    for (int a = 0; a < 2; ++a)
#pragma unroll
        for (int b = 0; b < 2; ++b)
#pragma unroll
            for (int m = 0; m < 4; ++m)
#pragma unroll
                for (int n = 0; n < 2; ++n) acc[a][b][m][n] = (f32x4){0.f, 0.f, 0.f, 0.f};
    bf16x8 At[4][2], B0[2][2], B1[2][2];
    const char* cA = (const char*)g.A + (size_t)cur.pm * tstep; const char* cB = (const char*)g.Bt + (size_t)cur.pn * tstep;
    S.a_ready(cur);
    if constexpr (SP2) {
        PG8_STAGE(PG8_SB(0, 0), cB, voffB); PG8_STAGE(PG8_SB(0, 1), cB + hstep, voffB); PG8_STAGE(PG8_SA(0, 0), cA, voffA); PG8_STAGE(PG8_SA(0, 1), cA + hstep, voffA);
        if (wr == 1) PG8_BAR;
        PG8_WAIT_V(2); PG8_BAR;
        PG8_STAGE(PG8_SB(1, 0), cB + kstep, voffB); PG8_STAGE(PG8_SA(1, 0), cA + kstep, voffA); PG8_STAGE(PG8_SB(1, 1), cB + hstep + kstep, voffB);
        PG8_WAIT_V(6); PG8_BAR;
    } else {
        PG8_STAGE(PG8_SB(0, 0), cB, voffB); PG8_STAGE(PG8_SA(0, 0), cA, voffA); PG8_STAGE(PG8_SB(0, 1), cB + hstep, voffB); PG8_STAGE(PG8_SA(0, 1), cA + hstep, voffA);
        if (wr == 1) PG8_BAR;
        PG8_WAIT_V(4); PG8_BAR;
        PG8_STAGE(PG8_SB(1, 0), cB + kstep, voffB); PG8_STAGE(PG8_SA(1, 0), cA + kstep, voffA); PG8_STAGE(PG8_SB(1, 1), cB + hstep + kstep, voffB);
        PG8_WAIT_V(6); PG8_BAR;
    }
    for (;;) {
        const bool has_next = S.next(ui + 1, nxt);
        const char* nA = has_next ? (const char*)g.A + (size_t)nxt.pm * tstep : cA; const char* nB = has_next ? (const char*)g.Bt + (size_t)nxt.pn * tstep : cB;
        for (int t = 0; t < nt; t += 2) {
            const bool last = (t == nt - 2);
            const char* a1 = cA + (size_t)(t + 1) * kstep;
            const char* a2 = last ? nA : cA + (size_t)(t + 2) * kstep; const char* b2 = last ? nB : cB + (size_t)(t + 2) * kstep;
            const char* a3 = a2 + kstep; const char* b3 = b2 + kstep;
            if (last && has_next) S.a_ready(nxt);
            if constexpr (SP2) {
            PG8_LDB(B0, 0, 0); PG8_LDB(B1, 0, 1); PG8_SCHED; PG8_LDA(At, 0, 0); PG8_STAGE(PG8_SA(1, 1), a1 + hstep, voffA);
            PG8_WAIT_V(8); PG8_WAIT_L(0); PG8_BAR; PG8_MMA(0, 0, At, B0); PG8_MMA(0, 1, At, B1); PG8_BAR; PG8_SCHED;
            PG8_LDA(At, 0, 1); PG8_STAGE(PG8_SB(0, 0), b2, voffB); PG8_STAGE(PG8_SB(0, 1), b2 + hstep, voffB); PG8_STAGE(PG8_SA(0, 0), a2, voffA);
            PG8_WAIT_V(8); PG8_WAIT_L(0); PG8_BAR; PG8_MMA(1, 0, At, B0); PG8_MMA(1, 1, At, B1); PG8_BAR; PG8_SCHED;
            PG8_LDB(B0, 1, 0); PG8_LDB(B1, 1, 1); PG8_SCHED; PG8_LDA(At, 1, 0); PG8_STAGE(PG8_SA(0, 1), a2 + hstep, voffA);
            PG8_WAIT_V(8); PG8_WAIT_L(0); PG8_BAR; PG8_MMA(0, 0, At, B0); PG8_MMA(0, 1, At, B1); PG8_BAR; PG8_SCHED;
            PG8_LDA(At, 1, 1); PG8_STAGE(PG8_SB(1, 0), b3, voffB); PG8_STAGE(PG8_SB(1, 1), b3 + hstep, voffB); PG8_STAGE(PG8_SA(1, 0), a3, voffA);
            PG8_WAIT_V(8); PG8_WAIT_L(0); PG8_BAR; PG8_MMA(1, 0, At, B0); PG8_MMA(1, 1, At, B1); PG8_BAR; PG8_SCHED;
            } else {
            PG8_LDB(B0, 0, 0); PG8_SCHED; PG8_LDA(At, 0, 0); PG8_STAGE(PG8_SA(1, 1), a1 + hstep, voffA);
            PG8_WAIT_L(8); PG8_BAR; PG8_WAIT_L(0); PG8_MMA(0, 0, At, B0); PG8_BAR; PG8_SCHED;
            PG8_LDB(B1, 0, 1); PG8_STAGE(PG8_SB(0, 0), b2, voffB);
            PG8_BAR; PG8_WAIT_L(0); PG8_MMA(0, 1, At, B1); PG8_BAR;
            PG8_LDA(At, 0, 1); PG8_STAGE(PG8_SA(0, 0), a2, voffA);
            PG8_BAR; PG8_WAIT_L(0); PG8_MMA(1, 0, At, B0); PG8_BAR; PG8_SCHED;
            PG8_STAGE(PG8_SB(0, 1), b2 + hstep, voffB);
            PG8_WAIT_V(6); PG8_BAR; PG8_MMA(1, 1, At, B1); PG8_BAR;
            PG8_LDB(B0, 1, 0); PG8_SCHED; PG8_LDA(At, 1, 0); PG8_STAGE(PG8_SA(0, 1), a2 + hstep, voffA);
            PG8_WAIT_L(8); PG8_BAR; PG8_WAIT_L(0); PG8_MMA(0, 0, At, B0); PG8_BAR; PG8_SCHED;
            PG8_LDB(B1, 1, 1); PG8_STAGE(PG8_SB(1, 0), b3, voffB);
            PG8_BAR; PG8_WAIT_L(0); PG8_MMA(0, 1, At, B1); PG8_BAR;
            PG8_LDA(At, 1, 1); PG8_STAGE(PG8_SA(1, 0), a3, voffA);
            PG8_BAR; PG8_WAIT_L(0); PG8_MMA(1, 0, At, B0); PG8_BAR; PG8_SCHED;
            PG8_STAGE(PG8_SB(1, 1), b3 + hstep, voffB);
            PG8_WAIT_V(6); PG8_BAR; PG8_MMA(1, 1, At, B1); PG8_BAR;
            }
        }
        if constexpr (ALIGN_EPI) { if (wr == 0) PG8_BAR; }
        if constexpr (!Epi::AFTER_DRAIN) { E(acc, cur, wr, wc, fr, fq); S.done(cur); }
        if (!has_next) break;
#pragma unroll
        for (int a = 0; a < 2; ++a)
#pragma unroll
            for (int b = 0; b < 2; ++b)
#pragma unroll
                for (int m = 0; m < 4; ++m)
#pragma unroll
                    for (int n = 0; n < 2; ++n) acc[a][b][m][n] = (f32x4){0.f, 0.f, 0.f, 0.f};
        cur = nxt; cA = nA; cB = nB; ++ui;
        if constexpr (ALIGN_EPI) { if (wr == 1) PG8_BAR; }
    }
    PG8_WAIT_V(0);
    if constexpr (!ALIGN_EPI) { if (wr == 0) PG8_BAR; }
    PG8_BAR;
    if constexpr (Epi::AFTER_DRAIN) { E.fused(acc, cur, wr, wc, fr, fq, lds, wid, lane); S.done(cur); }
#undef PG8_SA
#undef PG8_SB
#undef PG8_STAGE
#undef PG8_LDA
#undef PG8_LDB
#undef PG8_MMA
#undef PG8_WAIT_V
#undef PG8_WAIT_L
#undef PG8_BAR
#undef PG8_SCHED
}
}

#ifndef PG8_SP2
#define PG8_SP2 true
#endif
#ifndef PG8_ALIGN
#define PG8_ALIGN true
#endif
#include <hip/hip_bf16.h>
#include <cmath>
namespace attn_body {
using bf16=__hip_bfloat16;
using bf16x8=__attribute__((ext_vector_type(8)))short;
using s16x4=__attribute__((ext_vector_type(4)))short;
using f32x16=__attribute__((ext_vector_type(16)))float;
using u32x4=__attribute__((ext_vector_type(4)))unsigned;
constexpr int BATCH=1,NHEAD=32,SEQ=8192,D=64,DM=1024,OP=2048;
constexpr int NW=8,QBLK=32,QB=QBLK*NW,KVBLK=64,NQB=SEQ/QB;
constexpr int ATTN_PITCH=DM, ATTN_UNIT_ROWS=QB;
__device__ __forceinline__ int crow(int r,int hi){return (r&3)+8*(r>>2)+4*hi;}
#define SBAR() __builtin_amdgcn_sched_barrier(0)
__device__ __forceinline__ void cmask(f32x16&p0,f32x16&p1,int jb,int qrel,int hi){
  const float NEG=-INFINITY; int kb=64*jb+4*hi;
  #pragma unroll
  for(int r=0;r<16;++r){int kv=kb+(r&3)+8*(r>>2); if(kv>qrel)p0[r]=NEG; if(kv+32>qrel)p1[r]=NEG;}
}

constexpr int NSLOT=3, SLOTB=8192;
constexpr int LDS_K=0, LDS_V=NSLOT*SLOTB, LDS_WS=2*NSLOT*SLOTB, LDS_OST=LDS_WS+NW*64*4, LDS_BYTES=LDS_OST+NW*4096;
constexpr float C2=0.125f*1.4426950408889634f;
__device__ __forceinline__ void glds16(const void*gsrc,unsigned lds_dst){unsigned keep;
  asm volatile("s_mov_b32 %0, m0\n\ts_mov_b32 m0, %2\n\ts_nop 0\n\tglobal_load_lds_dwordx4 %1, off\n\ts_mov_b32 m0, %0":"=&s"(keep):"v"(gsrc),"s"(lds_dst):"memory");}
__device__ __forceinline__ float max3f(float a,float b,float c){float r;asm("v_max3_f32 %0, %1, %2, %3":"=v"(r):"v"(a),"v"(b),"v"(c));return r;}
__device__ __forceinline__ float max2f(float a,float b){float r;asm("v_max_f32_e32 %0, %1, %2":"=v"(r):"v"(a),"v"(b));return r;}
__device__ __forceinline__ float fadd_s(float a,float b){float r;asm("v_add_f32_e32 %0, %1, %2":"=v"(r):"v"(a),"v"(b));return r;}
__device__ __forceinline__ float fsub_s(float a,float b){float r;asm("v_sub_f32_e32 %0, %1, %2":"=v"(r):"v"(a),"v"(b));return r;}
typedef float f32x2_t __attribute__((ext_vector_type(2))); typedef __bf16 bf16x2_t __attribute__((ext_vector_type(2)));
__device__ __forceinline__ unsigned cvtpk_s(float lo,float hi){f32x2_t v={lo,hi};bf16x2_t b=__builtin_convertvector(v,bf16x2_t);return __builtin_bit_cast(unsigned,b);}
#define WAIT_BAR(N) asm volatile("s_waitcnt vmcnt(" #N ") lgkmcnt(0)\n\ts_barrier":::"memory")

__device__ __forceinline__ void qkt(f32x16&p0,f32x16&p1,const char*Kslot,const bf16x8*qr,const f32x16&negm,int r32,int hi){
  const char*kb=Kslot+hi*1024+r32*16;
  #pragma unroll
  for(int d0=0;d0<4;++d0){
    const bf16x8 b0=*reinterpret_cast<const bf16x8*>(kb+d0*2048);
    const bf16x8 b1=*reinterpret_cast<const bf16x8*>(kb+d0*2048+512);
    if(d0==0){p0=__builtin_amdgcn_mfma_f32_32x32x16_bf16(b0,qr[0],negm,0,0,0);p1=__builtin_amdgcn_mfma_f32_32x32x16_bf16(b1,qr[0],negm,0,0,0);}
    else{p0=__builtin_amdgcn_mfma_f32_32x32x16_bf16(b0,qr[d0],p0,0,0,0);p1=__builtin_amdgcn_mfma_f32_32x32x16_bf16(b1,qr[d0],p1,0,0,0);}}
}
typedef __attribute__((address_space(3))) const char* lds_cptr;
typedef short v4i16_t __attribute__((ext_vector_type(4)));
__device__ __forceinline__ void kload8(bf16x8*kf,lds_cptr kp){
  kf[0]=*(const __attribute__((address_space(3))) bf16x8*)(kp);      kf[1]=*(const __attribute__((address_space(3))) bf16x8*)(kp+512);
  kf[2]=*(const __attribute__((address_space(3))) bf16x8*)(kp+2048); kf[3]=*(const __attribute__((address_space(3))) bf16x8*)(kp+2560);
  kf[4]=*(const __attribute__((address_space(3))) bf16x8*)(kp+4096); kf[5]=*(const __attribute__((address_space(3))) bf16x8*)(kp+4608);
  kf[6]=*(const __attribute__((address_space(3))) bf16x8*)(kp+6144); kf[7]=*(const __attribute__((address_space(3))) bf16x8*)(kp+6656);
}
__device__ __forceinline__ void kload2(bf16x8*kf,lds_cptr kp,int j){ kf[2*j]=*(const __attribute__((address_space(3))) bf16x8*)(kp+j*2048); kf[2*j+1]=*(const __attribute__((address_space(3))) bf16x8*)(kp+j*2048+512); }
__device__ __forceinline__ s16x4 vtr(lds_cptr p){ return __builtin_bit_cast(s16x4,__builtin_amdgcn_ds_read_tr16_b64_v4i16((__attribute__((address_space(3))) v4i16_t*)p)); }
__device__ __forceinline__ float rowmax(const f32x16&p0,const f32x16&p1){
  float a=max3f(p0[0],p0[1],p1[0]),b=max3f(p0[2],p0[3],p1[1]);a=max3f(a,p1[2],p1[3]);
  #pragma unroll
  for(int r=4;r<16;r+=4){a=max3f(a,p0[r],p0[r+1]);b=max3f(b,p0[r+2],p0[r+3]);a=max3f(a,p1[r],p1[r+1]);b=max3f(b,p1[r+2],p1[r+3]);}
  const float m=max2f(a,b);
  auto rr=__builtin_amdgcn_permlane32_swap(__float_as_uint(m),__float_as_uint(m),false,false);
  return max2f(__uint_as_float(rr[0]),__uint_as_float(rr[1]));
}
__device__ __forceinline__ void pv(f32x16*o,int vb,bf16x8 pa0,bf16x8 pa1,bf16x8 pa2,bf16x8 pa3){
  #pragma unroll
  for(int d0=0;d0<2;++d0){s16x4 lo[4],hi[4];
    #pragma unroll
    for(int ks=0;ks<4;++ks){
      asm volatile("ds_read_b64_tr_b16 %0,%1 offset:%c2":"=&v"(lo[ks]):"v"(vb),"i"(d0*4096+ks*1024):"memory");
      asm volatile("ds_read_b64_tr_b16 %0,%1 offset:%c2":"=&v"(hi[ks]):"v"(vb),"i"(d0*4096+ks*1024+512):"memory");}
    asm volatile("s_waitcnt lgkmcnt(0)":::"memory");SBAR();
    #define PK(k) (bf16x8){lo[k][0],lo[k][1],lo[k][2],lo[k][3],hi[k][0],hi[k][1],hi[k][2],hi[k][3]}
    o[d0]=__builtin_amdgcn_mfma_f32_32x32x16_bf16(pa0,PK(0),o[d0],0,0,0);
    o[d0]=__builtin_amdgcn_mfma_f32_32x32x16_bf16(pa1,PK(1),o[d0],0,0,0);
    o[d0]=__builtin_amdgcn_mfma_f32_32x32x16_bf16(pa2,PK(2),o[d0],0,0,0);
    o[d0]=__builtin_amdgcn_mfma_f32_32x32x16_bf16(pa3,PK(3),o[d0],0,0,0);
    #undef PK
  }
}

#ifndef ATTN_STORE16
#define ATTN_STORE16(p,v) (*(u32x4*)(p)=(v))
#endif
template<int THRL> __device__ __forceinline__ void attn_unit(int qb,const bf16*Q,const bf16*__restrict__ K,const bf16*__restrict__ V,bf16*O,char*shm){
  int tid_=threadIdx.x; asm volatile("":"+v"(tid_)); const int tid=tid_,lane=tid&63,r32=lane&31,hi=lane>>5; const int wid=__builtin_amdgcn_readfirstlane(tid>>6);
  const int q0=qb*QB;
  const bf16*Qw=Q+(long)(q0+wid*QBLK)*DM;
  const bf16*Kh=K,*Vh=V;
  const unsigned lds0=(unsigned)(uintptr_t)shm;
  float*wsf=(float*)(shm+LDS_WS)+wid*64;
  const bf16*ksrc=Kh+(long)lane*DM+wid*8;
  const bf16*vsrc=Vh+(long)(16*(wid&3)+(lane>>2))*DM+(wid>>2)*32+(lane&3)*8;
  const unsigned kdst=lds0+LDS_K+wid*1024, vdst=lds0+LDS_V+wid*1024;
  #define DMA_K(t,slot) glds16(ksrc+(long)(t)*KVBLK*DM,(unsigned)__builtin_amdgcn_readfirstlane(kdst+(slot)))
  #define DMA_V(t,slot) glds16(vsrc+(long)(t)*KVBLK*DM,(unsigned)__builtin_amdgcn_readfirstlane(vdst+(slot)))
  const int vb0=(int)(lds0+LDS_V)+((lane>>4)&1)*32+(lane&3)*8+(4*hi+((lane&15)>>2))*64;
  const char*Kbase=shm+LDS_K; bf16x8 kf[8];
  const lds_cptr shm3=(lds_cptr)shm; const lds_cptr kp0=shm3+LDS_K+hi*1024+r32*16; const lds_cptr vp0=shm3+LDS_V+((lane>>4)&1)*32+(lane&3)*8+(4*hi+((lane&15)>>2))*64;
  const int NT=(q0+QB)/KVBLK;
  DMA_K(0,0);DMA_V(0,0);DMA_K(1,SLOTB);
  bf16x8 qr[4];
  #pragma unroll
  for(int d0=0;d0<4;++d0)qr[d0]=*reinterpret_cast<const bf16x8*>(&Qw[(long)r32*DM+d0*16+hi*8]);
  float mhat=0.f,l_reg=0.f;f32x16 o[2];o[0]=f32x16{};o[1]=f32x16{};f32x16 negm=f32x16{};asm volatile("":"+v"(negm));
  const int qrel=wid*QBLK+r32;
  #define CMASK(P0,P1,t) do{int jb_=(t)-(NT-4); if(jb_>=0)cmask(P0,P1,jb_,qrel,hi);}while(0)
  bool resc=false;
  #define START(P0,P1) do{ const float rm=rowmax(P0,P1); resc=false; \
    { const float dl=rm; mhat=fadd_s(mhat,dl); \
      _Pragma("unroll") for(int r=0;r<16;++r){P0[r]=fsub_s(P0[r],dl);P1[r]=fsub_s(P1[r],dl);} \
      _Pragma("unroll") for(int r=0;r<16;++r)negm[r]=-mhat; asm volatile("":"+v"(negm)); } \
    _Pragma("unroll") for(int r=0;r<16;++r)P0[r]=__builtin_amdgcn_exp2f(P0[r]); }while(0)
  #define RESC() do{ if(resc){ asm volatile("s_waitcnt lgkmcnt(0)":::"memory"); \
      _Pragma("unroll") for(int d_=0;d_<2;++d_) _Pragma("unroll") for(int r=0;r<16;++r)o[d_][r]*=wsf[crow(r,hi)]; } }while(0)
  f32x16 pA0,pA1,pB0,pB1;
  int sl_prev=0,sl_cur=0,sl_next=SLOTB;
  #define ROT() do{sl_prev=sl_cur;sl_cur=sl_next;sl_next=(sl_next==(NSLOT-1)*SLOTB)?0:sl_next+SLOTB;}while(0)
  DMA_K(2,2*SLOTB);
  WAIT_BAR(3);
  qkt(pA0,pA1,Kbase,qr,negm,r32,hi);asm volatile("s_nop 15\n\ts_nop 7":"+v"(pA0),"+v"(pA1));CMASK(pA0,pA1,0);
  START(pA0,pA1);
  _Pragma("unroll") for(int r=0;r<16;++r)pA1[r]=__builtin_amdgcn_exp2f(pA1[r]);
  WAIT_BAR(0);
  DMA_K(3,0);DMA_V(1,SLOTB);
  ROT();
  kload8(kf,kp0+sl_cur);
  WAIT_BAR(2);
  s16x4 vlo[8],vhi[8]; u32x4 pw0,pw1,pw2,pw3;
  #define PKW(P,B) cvtpk_s(P[B],P[B+1])
  #define PAF(k) __builtin_bit_cast(bf16x8,pw##k)
  #define VFR(i) (bf16x8){vlo[i][0],vlo[i][1],vlo[i][2],vlo[i][3],vhi[i][0],vhi[i][1],vhi[i][2],vhi[i][3]}
  #define PIN(x) asm volatile("":"+v"(x))
  #define MX3(a,b,c) __builtin_fmaxf(__builtin_fmaxf((a),(b)),(c))
  #define GAPA(MF,A0,A1,A2,A3,W0,W1,PW) do{ MF; sacc+=A0; sacc+=A1; sacc+=A2; sacc+=A3; PIN(sacc); W0; W1; PIN(PW); SBAR(); }while(0)
  #define EX(v) __builtin_amdgcn_exp2f(v)
  #define GAPB(MF,X,B) do{ MF; X[B]=EX(X[B]); X[B+1]=EX(X[B+1]); X[B+2]=EX(X[B+2]); X[B+3]=EX(X[B+3]); PIN(X); SBAR(); }while(0)
  #define VRD(i) do{ vlo[i]=vtr(vp_+(((i)>>2)*4096+((i)&3)*1024)); vhi[i]=vtr(vp_+(((i)>>2)*4096+((i)&3)*1024+512)); }while(0)
  #define KRD(G,j) do{ if(G){ kload2(kf,kp0+sl_next,j); SBAR(); } }while(0)
  #define STEP(C0,C1,P0,P1,t,GK,GV,GL) do{ SBAR(); \
    const lds_cptr vp_=vp0+sl_prev; \
    VRD(0); SBAR(); float sacc=(P0[0]+P0[1]); \
    GAPA(C0=__builtin_amdgcn_mfma_f32_32x32x16_bf16(kf[0],qr[0],negm,0,0,0), P0[2],P0[3],P0[4],P0[5],     pw0[0]=PKW(P0,0), pw0[1]=PKW(P0,2), pw0); \
    VRD(4); SBAR(); GAPA(C1=__builtin_amdgcn_mfma_f32_32x32x16_bf16(kf[1],qr[0],negm,0,0,0), P0[6],P0[7],P0[8],P0[9],     pw0[2]=PKW(P0,4), pw0[3]=PKW(P0,6), pw0); \
    VRD(1); SBAR(); GAPA(C0=__builtin_amdgcn_mfma_f32_32x32x16_bf16(kf[2],qr[1],C0,0,0,0),   P0[10],P0[11],P0[12],P0[13], pw1[0]=PKW(P0,8), pw1[1]=PKW(P0,10), pw1); \
    VRD(5); SBAR(); GAPA(C1=__builtin_amdgcn_mfma_f32_32x32x16_bf16(kf[3],qr[1],C1,0,0,0),   P0[14],P0[15],P1[0],P1[1],   pw1[2]=PKW(P0,12),pw1[3]=PKW(P0,14), pw1); \
    VRD(2); SBAR(); GAPA(C0=__builtin_amdgcn_mfma_f32_32x32x16_bf16(kf[4],qr[2],C0,0,0,0),   P1[2],P1[3],P1[4],P1[5],     pw2[0]=PKW(P1,0), pw2[1]=PKW(P1,2), pw2); \
    VRD(6); SBAR(); GAPA(C1=__builtin_amdgcn_mfma_f32_32x32x16_bf16(kf[5],qr[2],C1,0,0,0),   P1[6],P1[7],P1[8],P1[9],     pw2[2]=PKW(P1,4), pw2[3]=PKW(P1,6), pw2); \
    VRD(3); SBAR(); GAPA(C0=__builtin_amdgcn_mfma_f32_32x32x16_bf16(kf[6],qr[3],C0,0,0,0),   P1[10],P1[11],P1[12],P1[13], pw3[0]=PKW(P1,8), pw3[1]=PKW(P1,10), pw3); \
    VRD(7); SBAR(); GAPA(C1=__builtin_amdgcn_mfma_f32_32x32x16_bf16(kf[7],qr[3],C1,0,0,0),   P1[14],P1[15],0.f,0.f,       pw3[2]=PKW(P1,12),pw3[3]=PKW(P1,14), pw3); \
    l_reg+=sacc; \
    if(GK){DMA_K((t)+3,sl_cur);} if(GV){DMA_V((t)+1,sl_next);} \
    CMASK(C0,C1,t); \
    { float a=MX3(C0[0],C0[1],C1[0]),b=MX3(C0[2],C0[3],C1[1]); a=MX3(a,C1[2],C1[3]); \
      _Pragma("unroll") for(int r=4;r<16;r+=4){a=MX3(a,C0[r],C0[r+1]);b=MX3(b,C0[r+2],C0[r+3]);a=MX3(a,C1[r],C1[r+1]);b=MX3(b,C1[r+2],C1[r+3]);} \
      float rm=__builtin_fmaxf(a,b); { auto rr=__builtin_amdgcn_permlane32_swap(__float_as_uint(rm),__float_as_uint(rm),false,false); rm=__builtin_fmaxf(__uint_as_float(rr[0]),__uint_as_float(rr[1])); } \
      resc=false; \
      if(__builtin_expect(__any(rm>(float)THRL),0)){ const float dl=__builtin_fmaxf(rm,0.f); mhat+=dl; \
        _Pragma("unroll") for(int r=0;r<16;++r){C0[r]-=dl;C1[r]-=dl;} \
        _Pragma("unroll") for(int r=0;r<16;++r)negm[r]=-mhat; asm volatile("":"+v"(negm)); \
        const float f=__builtin_amdgcn_exp2f(-dl); l_reg*=f; if(hi==0)wsf[r32]=f; resc=true; } } \
    SBAR(); \
    GAPB(o[0]=__builtin_amdgcn_mfma_f32_32x32x16_bf16(PAF(0),VFR(0),o[0],0,0,0), C0,0); \
    GAPB(o[1]=__builtin_amdgcn_mfma_f32_32x32x16_bf16(PAF(0),VFR(4),o[1],0,0,0), C0,4); \
    KRD(GL,0); GAPB(o[0]=__builtin_amdgcn_mfma_f32_32x32x16_bf16(PAF(1),VFR(1),o[0],0,0,0), C0,8); \
    KRD(GL,1); GAPB(o[1]=__builtin_amdgcn_mfma_f32_32x32x16_bf16(PAF(1),VFR(5),o[1],0,0,0), C0,12); \
    KRD(GL,2); GAPB(o[0]=__builtin_amdgcn_mfma_f32_32x32x16_bf16(PAF(2),VFR(2),o[0],0,0,0), C1,0); \
    KRD(GL,3); GAPB(o[1]=__builtin_amdgcn_mfma_f32_32x32x16_bf16(PAF(2),VFR(6),o[1],0,0,0), C1,4); \
    GAPB(o[0]=__builtin_amdgcn_mfma_f32_32x32x16_bf16(PAF(3),VFR(3),o[0],0,0,0), C1,8); \
    GAPB(o[1]=__builtin_amdgcn_mfma_f32_32x32x16_bf16(PAF(3),VFR(7),o[1],0,0,0), C1,12); \
    }while(0)
  int t=1;
  #undef CMASK
  #define CMASK(P0,P1,t) do{}while(0)
  for(;t+5<NT;t+=2){
    STEP(pB0,pB1,pA0,pA1,t,true,true,true);     WAIT_BAR(2); RESC(); ROT();
    STEP(pA0,pA1,pB0,pB1,t+1,true,true,true);   WAIT_BAR(2); RESC(); ROT();
  }
  #undef CMASK
  #define CMASK(P0,P1,t) do{int jb_=(t)-(NT-4); if(jb_>=0)cmask(P0,P1,jb_,qrel,hi);}while(0)
  #define ENDW(tt) do{ if((tt)+3<NT){WAIT_BAR(2);} else if((tt)+2<NT){WAIT_BAR(1);} else {WAIT_BAR(0);} }while(0)
  for(;t+1<NT;t+=2){
    STEP(pB0,pB1,pA0,pA1,t,(t+3<NT),(t+1<NT),(t+1<NT));       ENDW(t);   RESC(); ROT();
    STEP(pA0,pA1,pB0,pB1,t+1,(t+4<NT),(t+2<NT),(t+2<NT));     ENDW(t+1); RESC(); ROT();
  }
  STEP(pB0,pB1,pA0,pA1,NT-1,false,false,false); RESC();
  { float sacc=pB0[0]+pB0[1]; _Pragma("unroll") for(int r=2;r<16;++r)sacc+=pB0[r]; _Pragma("unroll") for(int r=0;r<16;++r)sacc+=pB1[r]; l_reg+=sacc;
    pw0=(u32x4){PKW(pB0,0),PKW(pB0,2),PKW(pB0,4),PKW(pB0,6)};pw1=(u32x4){PKW(pB0,8),PKW(pB0,10),PKW(pB0,12),PKW(pB0,14)};pw2=(u32x4){PKW(pB1,0),PKW(pB1,2),PKW(pB1,4),PKW(pB1,6)};pw3=(u32x4){PKW(pB1,8),PKW(pB1,10),PKW(pB1,12),PKW(pB1,14)};
    SBAR(); pv(o,vb0+sl_cur,PAF(0),PAF(1),PAF(2),PAF(3)); }
  #undef PKW
  #undef PAF
  #undef VFR
  #undef PIN
  #undef MX3
  #undef GAPA
  #undef GAPB
  #undef EX
  #undef VRD
  #undef KRD
  #undef STEP
  #undef ENDW
  {auto rr=__builtin_amdgcn_permlane32_swap(__float_as_uint(l_reg),__float_as_uint(l_reg),false,false);l_reg=__uint_as_float(rr[0])+__uint_as_float(rr[1]);}
  if(hi==0)wsf[32+r32]=l_reg;asm volatile("s_waitcnt lgkmcnt(0)":::"memory");
  float rli[16];
  #pragma unroll
  for(int r=0;r<16;++r)rli[r]=__builtin_amdgcn_rcpf(wsf[32+crow(r,hi)]);
  bf16*Ow=O+(long)(q0+wid*QBLK)*OP;
  { bf16*stg=(bf16*)(shm+LDS_OST)+wid*2048;
    #pragma unroll
    for(int r=0;r<16;++r){const int orow=crow(r,hi);
      #pragma unroll
      for(int d0=0;d0<2;++d0)stg[orow*64+d0*32+r32]=__float2bfloat16(o[d0][r]*rli[r]);}
    asm volatile("s_waitcnt lgkmcnt(0)":::"memory");
    #pragma unroll
    for(int i=0;i<4;++i){const int row=i*8+(lane>>3),ch=lane&7; const u32x4 v=*(const u32x4*)(stg+row*64+ch*8); ATTN_STORE16(Ow+(long)row*OP+ch*8,v);} }
  asm volatile("s_waitcnt lgkmcnt(0)\n\ts_barrier":::"memory");
  #undef DMA_K
  #undef DMA_V
  #undef CMASK
  #undef START
  #undef RESC
  #undef ROT
}
constexpr int ATTN_LDS_BYTES=LDS_BYTES;
struct AttnTensors { const bf16* Q; const bf16* K; const bf16* V; bf16* O; };
struct AttnUnit { int bh; int qb; };
struct StaticOrder {
  int vcu;
  __device__ __forceinline__ explicit StaticOrder(int grid,int block):vcu((block%8)*(grid/8)+block/8){}
  __device__ __forceinline__ bool next(int i,AttnUnit&u)const{ if(i>=4)return false; const int s=vcu&7; u.bh=vcu>>3; u.qb=(i==0)?s:(i==1)?15-s:(i==2)?16+s:31-s; return true; }
  __device__ __forceinline__ void a_ready(const AttnUnit&)const{}
  __device__ __forceinline__ void done(const AttnUnit&)const{}
};
template<class Sched,int THRL=8> __device__ __forceinline__ void attn_phase(char*lds,const AttnTensors&T,const Sched&S){
  AttnUnit u;
  for(int i=0;S.next(i,u);++i){ S.a_ready(u); { const int p=u.bh;   attn_unit<THRL>(u.qb,T.Q+(p>>1)*64,T.K+(p>>1)*64,T.V+(p>>2)*128+(p&1)*64,T.O+((p>>1)&1)*1024+(p>>2)*128+(p&1)*64,lds); } S.done(u); }
}
#undef SBAR
#undef WAIT_BAR
}
constexpr int NWAVES = 8;
constexpr int M = 8192, D = 2048, FF = 5632, NIN = 6144, DEPTH = 4;
constexpr float EPS = 1e-5f;
__device__ const float INV_FREQ[8] = {1.0f, 0.1939227432012558f, 0.03760603070259094f, 0.007292664609849453f, 0.0014142135623842478f, 0.00027424818836152554f, 5.3182957344688475e-05f, 1.0313385246263351e-05f};
__device__ const float LAM_INIT[4] = {0.2f, 0.35550906759096934f, 0.4707130183435842f, 0.5560582041556406f};
constexpr size_t MiB = 1u << 20;
constexpr size_t WS_CTL = 0, CTL_ZERO_BYTES = 1 * MiB;
constexpr size_t WS_CS = 1 * MiB;
constexpr size_t WS_W = 2 * MiB;
constexpr size_t WO_GU1 = 0, WO_D1 = 44 * MiB, WO_IN = 66 * MiB, WO_OUT = 90 * MiB, WO_GU2 = 98 * MiB, WO_D2 = 142 * MiB, W_LAYER = 164 * MiB;
constexpr size_t WS_H = WS_W + DEPTH * W_LAYER;
constexpr size_t WS_ACT = WS_H + 32 * MiB;
constexpr size_t WS_Q = WS_ACT + 88 * MiB, WS_K = WS_Q + 16 * MiB, WS_V = WS_K + 16 * MiB, WS_GB = WS_V + 16 * MiB, WS_CU = WS_GB + 16 * MiB;
constexpr size_t WS_O = WS_CU + 16 * MiB;
constexpr size_t WS_MIX = WS_O + 32 * MiB;
constexpr size_t WS_END = WS_MIX + 32 * MiB;
static_assert((size_t)2 * FF * D * 2 == 44 * MiB && (size_t)FF * D * 2 == 22 * MiB && (size_t)NIN * D * 2 == 24 * MiB && (size_t)D * D * 2 == 8 * MiB && (size_t)M * FF * 2 == 88 * MiB, "d_ws map");
constexpr int CW_BAR = 4096;
constexpr int RING_OFF = 0, RING_BYTES = 131072;
constexpr int LDSCTL_OFF = RING_BYTES, MISC_OFF = LDSCTL_OFF + 320;
constexpr int LDS_BYTES = 147456;
static_assert(MISC_OFF + 128 <= LDS_BYTES, "LDS map");
#define GAS __attribute__((address_space(1)))
#define LAS __attribute__((address_space(3)))
typedef unsigned short bf16;
typedef unsigned v4u __attribute__((ext_vector_type(4)));
typedef float f32x4 __attribute__((ext_vector_type(4)));
typedef short bf16x8 __attribute__((ext_vector_type(8)));
typedef GAS unsigned gu32;
typedef GAS unsigned long long gu64;
#define RLX_AGENT __ATOMIC_RELAXED, __HIP_MEMORY_SCOPE_AGENT
#define LDS_WAIT() asm volatile("s_waitcnt lgkmcnt(0)" ::: "memory")
#define VM_WAIT() asm volatile("s_waitcnt vmcnt(0)" ::: "memory")
__device__ __forceinline__ unsigned long long rt() { return __builtin_amdgcn_s_memrealtime(); }
__device__ __forceinline__ unsigned f2bf(float f) { unsigned u = __builtin_bit_cast(unsigned, f); return (u + 0x7fffu + ((u >> 16) & 1u)) >> 16; }
__device__ __forceinline__ unsigned pk2(float lo, float hi) { return f2bf(lo) | (f2bf(hi) << 16); }

#define XB_TMO      128
#define XB_XCNT(j)  (256  + 64 * (j))
#define XB_XSUB(j)  (1280 + 64 * (j))
#define XB_XGEN(j)  (2304 + 64 * (j))
#define XB_TOP      3328
#define XB_TOPGEN   3392
#define XCD_BAR_WORDS 3456
#define XB_SPIN_CAP (1u << 18)

__device__ __forceinline__ unsigned xb_ld(unsigned* p)              { return __hip_atomic_load(p, __ATOMIC_RELAXED, __HIP_MEMORY_SCOPE_AGENT); }
__device__ __forceinline__ unsigned xb_add(unsigned* p, unsigned v) { return __hip_atomic_fetch_add(p, v, __ATOMIC_RELAXED, __HIP_MEMORY_SCOPE_AGENT); }
__device__ __forceinline__ unsigned xb_xcc_id() { return (unsigned)__builtin_amdgcn_s_getreg((3 << 11) | 20) & 0xFu; }
#define XB_SPIN(cond, bar) do { unsigned _sp = 0; while (cond) { __builtin_amdgcn_s_sleep(1); \
    if ((++_sp & 255u) == 0u) { if (xb_ld(&(bar)[XB_TMO])) break; if (_sp > XB_SPIN_CAP) { atomicAdd(&(bar)[XB_TMO], 1u); break; } } } } while (0)

struct XcdBarrier {
    unsigned* bar; unsigned x;
    volatile LAS unsigned* st;
};

__device__ __forceinline__ XcdBarrier xcd_barrier_post(unsigned* bar, volatile LAS unsigned* st) {
    XcdBarrier b; b.bar = bar; b.x = xb_xcc_id(); b.st = st;
    if (threadIdx.x == 0) (void)xb_add(&bar[XB_XCNT(b.x)], 1u);
    return b;
}
__device__ __forceinline__ void xcd_barrier_complete(unsigned* bar, unsigned x, unsigned& nloc, unsigned& nx) {
    const unsigned G = gridDim.x * gridDim.y * gridDim.z;
    unsigned sum, cnt, mine, sp = 0u;
    for (;;) {
        sum = 0u; cnt = 0u; mine = 0u;
#pragma unroll
        for (unsigned j = 0; j < 16; ++j) { const unsigned c = xb_ld(&bar[XB_XCNT(j)]); sum += c; cnt += (c > 0u) ? 1u : 0u; mine = (j == x) ? c : mine; }
        if (sum == G) break;
        __builtin_amdgcn_s_sleep(1);
        if ((++sp & 255u) == 0u) { if (xb_ld(&bar[XB_TMO])) break; if (sp > XB_SPIN_CAP) { atomicAdd(&bar[XB_TMO], 1u); break; } }
    }
    nloc = mine > 0u ? mine : 1u; nx = cnt > 0u ? cnt : 1u;
}

__device__ __forceinline__ void xcd_barrier(const XcdBarrier& b) {
    asm volatile("s_waitcnt vmcnt(0)" ::: "memory");
    __syncthreads();
    if (threadIdx.x == 0) {
        unsigned* bar = b.bar;
        __builtin_amdgcn_s_waitcnt(0);
        unsigned nloc = b.st[0], nx = b.st[1];
        if (nloc == 0u) { xcd_barrier_complete(bar, b.x, nloc, nx); b.st[0] = nloc; b.st[1] = nx; }
        const unsigned old = xb_add(&bar[XB_XSUB(b.x)], 1u);
        const unsigned gen = old / nloc;
        if (old + 1u == (gen + 1u) * nloc) {
            __builtin_amdgcn_fence(__ATOMIC_RELEASE, "agent");
            asm volatile("s_waitcnt vmcnt(0)" ::: "memory");
            const unsigned og = xb_add(&bar[XB_TOP], 1u);
            const unsigned tg = og / nx;
            if (og + 1u == (tg + 1u) * nx) xb_add(&bar[XB_TOPGEN], 1u);
            else XB_SPIN(xb_ld(&bar[XB_TOPGEN]) == tg, bar);
            __builtin_amdgcn_fence(__ATOMIC_ACQUIRE, "agent");
            xb_add(&bar[XB_XGEN(b.x)], 1u);
            asm volatile("s_waitcnt vmcnt(0)" ::: "memory");
        } else {
            XB_SPIN(xb_ld(&bar[XB_XGEN(b.x)]) == gen, bar);
            __builtin_amdgcn_fence(__ATOMIC_ACQUIRE, "agent");
            asm volatile("s_waitcnt vmcnt(0)" ::: "memory");
        }
    }
    __syncthreads();
}
struct Frame {
    LAS unsigned char* lds;
    volatile LAS unsigned* MISC;
    gu32* ctl;
    int tid, lane, wave;
    int vcu, G;
};

__device__ __forceinline__ float wave_sum(float v) {
#pragma unroll
    for (int o = 1; o < 64; o <<= 1) v += __shfl_xor(v, o);
    return v;
}
__device__ __forceinline__ float bflo(unsigned w) { return __uint_as_float(w << 16); }
__device__ __forceinline__ float bfhi(unsigned w) { return __uint_as_float(w & 0xffff0000u); }

__device__ __forceinline__ int dst_row(int kind, int ns) {
    if (kind == 0) return ns;
    if (kind == 1) return 256 * (ns >> 7) + (ns & 127);
    if (kind == 2) return 256 * (ns >> 7) + 128 + (ns & 127);
    if (ns < 2048) { const int d = ns & 63; const int c = d < 8 ? 2 * d : d < 16 ? 2 * (d - 8) + 1 : d; return (ns & ~63) + c; }
    if (ns < 4096) return ns;
    if (ns < 5120) { const int j = ns - 4096; return 4096 + 256 * (j >> 7) + (j & 127); }
    { const int j = ns - 5120; return 4096 + 256 * (j >> 7) + 128 + (j & 127); }
}
__device__ __forceinline__ void p0_transpose_item(const float* W, int K, int N, bf16* WT, int kind, LAS float* scr, int item, int lane) {
    const int nblk = N / 32, kb = item / nblk, nb = item % nblk, k0 = 64 * kb, n0 = 32 * nb;
    const float* src = W + (size_t)(k0 + (lane >> 5)) * N + n0 + (lane & 31);
    float t[32];
#pragma unroll
    for (int i = 0; i < 32; ++i) t[i] = src[(size_t)(2 * i) * N];
#pragma unroll
    for (int i = 0; i < 32; ++i) scr[(2 * i + (lane >> 5)) * 33 + (lane & 31)] = t[i];
    LDS_WAIT(); asm volatile("" ::: "memory");
    const int c = lane & 7;
#pragma unroll
    for (int j = 0; j < 4; ++j) { const int n = (lane >> 3) + 8 * j; const LAS float* s = scr + (8 * c) * 33 + n;
        v4u o; o.x = pk2(s[0 * 33], s[1 * 33]); o.y = pk2(s[2 * 33], s[3 * 33]); o.z = pk2(s[4 * 33], s[5 * 33]); o.w = pk2(s[6 * 33], s[7 * 33]);
        *(GAS v4u*)(WT + (size_t)dst_row(kind, n0 + n) * K + k0 + 8 * c) = o; }
    LDS_WAIT(); asm volatile("" ::: "memory");
}

__device__ __forceinline__ void norm_phase(Frame& F, const float* x, const float* g, bf16* H) {
    const int gw = F.vcu * NWAVES + F.wave, NGW = F.G * NWAVES;
    f32x4 gv[8];
#pragma unroll
    for (int j = 0; j < 4; ++j) { gv[2 * j] = *(const f32x4*)(g + 512 * j + 8 * F.lane); gv[2 * j + 1] = *(const f32x4*)(g + 512 * j + 8 * F.lane + 4); }
    for (int m = gw; m < M; m += NGW) {
        const float* xr = x + (size_t)m * D; f32x4 v[8]; float s = 0.f;
#pragma unroll
        for (int j = 0; j < 4; ++j) { v[2 * j] = *(const GAS f32x4*)(xr + 512 * j + 8 * F.lane); v[2 * j + 1] = *(const GAS f32x4*)(xr + 512 * j + 8 * F.lane + 4); }
#pragma unroll
        for (int j = 0; j < 8; ++j) s += (v[j].x * v[j].x + v[j].y * v[j].y) + (v[j].z * v[j].z + v[j].w * v[j].w);
        const float rstd = 1.0f / sqrtf(wave_sum(s) * (1.f / D) + EPS);
        bf16* hr = H + (size_t)m * D;
#pragma unroll
        for (int j = 0; j < 4; ++j) { const f32x4 a = v[2 * j] * rstd * gv[2 * j], b = v[2 * j + 1] * rstd * gv[2 * j + 1];
            v4u o; o.x = pk2(a.x, a.y); o.y = pk2(a.z, a.w); o.z = pk2(b.x, b.y); o.w = pk2(b.z, b.w);
            *(GAS v4u*)(hr + 512 * j + 8 * F.lane) = o; }
    }
}
__device__ __forceinline__ void final_norm_phase(Frame& F, const float* x, const float* g, float* out) {
    const int gw = F.vcu * NWAVES + F.wave, NGW = F.G * NWAVES;
    f32x4 gv[8];
#pragma unroll
    for (int j = 0; j < 8; ++j) gv[j] = *(const f32x4*)(g + 256 * j + 4 * F.lane);
    for (int m = gw; m < M; m += NGW) {
        const float* xr = x + (size_t)m * D; f32x4 v[8]; float s = 0.f;
#pragma unroll
        for (int j = 0; j < 8; ++j) v[j] = *(const GAS f32x4*)(xr + 256 * j + 4 * F.lane);
#pragma unroll
        for (int j = 0; j < 8; ++j) s += (v[j].x * v[j].x + v[j].y * v[j].y) + (v[j].z * v[j].z + v[j].w * v[j].w);
        const float rstd = 1.0f / sqrtf(wave_sum(s) * (1.f / D) + EPS);
        asm volatile("" ::: "memory");
        float* orow = out + (size_t)m * D;
#pragma unroll
        for (int j = 0; j < 8; ++j) *(GAS f32x4*)(orow + 256 * j + 4 * F.lane) = v[j] * rstd * gv[j];
    }
}
__device__ __forceinline__ void fin_phase(Frame& F, const bf16* O, const bf16* GB, const bf16* CU, bf16* MIX, const float* lq1, const float* lk1, const float* lq2, const float* lk2,
                                          const float* subw, const float* convw, float lam_init) {
    const int gw = F.vcu * NWAVES + F.wave, NGW = F.G * NWAVES, lane = F.lane;
    const float lam = expf(wave_sum(lq1[lane] * lk1[lane])) - expf(wave_sum(lq2[lane] * lk2[lane])) + lam_init;
    const float om = 1.0f - lam_init;
    const int c0 = 16 * lane;
    float sw[16], w0[16], w1[16], w2[16];
#pragma unroll
    for (int j = 0; j < 16; ++j) { sw[j] = subw[(c0 & 127) + j] * om; w0[j] = convw[c0 + j]; w1[j] = convw[1024 + c0 + j]; w2[j] = convw[2048 + c0 + j]; }
    for (int m = gw; m < M; m += NGW) {
        const v4u a0 = *(const GAS v4u*)(O + (size_t)m * 2048 + c0), a1 = *(const GAS v4u*)(O + (size_t)m * 2048 + c0 + 8);
        const v4u b0 = *(const GAS v4u*)(O + (size_t)m * 2048 + 1024 + c0), b1 = *(const GAS v4u*)(O + (size_t)m * 2048 + 1024 + c0 + 8);
        const v4u g0 = *(const GAS v4u*)(GB + (size_t)m * 1024 + c0), g1 = *(const GAS v4u*)(GB + (size_t)m * 1024 + c0 + 8);
        const v4u z = (v4u){0u, 0u, 0u, 0u};
        const v4u x0 = *(const GAS v4u*)(CU + (size_t)m * 1024 + c0), x1 = *(const GAS v4u*)(CU + (size_t)m * 1024 + c0 + 8);
        const v4u y0 = m >= 1 ? *(const GAS v4u*)(CU + (size_t)(m - 1) * 1024 + c0) : z, y1 = m >= 1 ? *(const GAS v4u*)(CU + (size_t)(m - 1) * 1024 + c0 + 8) : z;
        const v4u u0 = m >= 2 ? *(const GAS v4u*)(CU + (size_t)(m - 2) * 1024 + c0) : z, u1 = m >= 2 ? *(const GAS v4u*)(CU + (size_t)(m - 2) * 1024 + c0 + 8) : z;
        float d[16]; float ss = 0.f;
#pragma unroll
        for (int q = 0; q < 4; ++q) { d[2 * q] = bflo(a0[q]) - lam * bflo(b0[q]); d[2 * q + 1] = bfhi(a0[q]) - lam * bfhi(b0[q]); d[8 + 2 * q] = bflo(a1[q]) - lam * bflo(b1[q]); d[8 + 2 * q + 1] = bfhi(a1[q]) - lam * bfhi(b1[q]); }
#pragma unroll
        for (int j = 0; j < 16; ++j) ss += d[j] * d[j];
        ss += __shfl_xor(ss, 1); ss += __shfl_xor(ss, 2); ss += __shfl_xor(ss, 4);
        const float rs = 1.0f / sqrtf(ss * (1.f / 128.f) + EPS);
        v4u o0, o1;
#pragma unroll
        for (int q = 0; q < 4; ++q) { o0[q] = pk2(d[2 * q] * rs * sw[2 * q], d[2 * q + 1] * rs * sw[2 * q + 1]); o1[q] = pk2(d[8 + 2 * q] * rs * sw[8 + 2 * q], d[8 + 2 * q + 1] * rs * sw[8 + 2 * q + 1]); }
        *(GAS v4u*)(MIX + (size_t)m * 2048 + c0) = o0; *(GAS v4u*)(MIX + (size_t)m * 2048 + c0 + 8) = o1;
        v4u p0, p1;
#pragma unroll
        for (int q = 0; q < 4; ++q) {
            const float e0 = bflo(g0[q]) * (w0[2 * q] * bflo(u0[q]) + w1[2 * q] * bflo(y0[q]) + w2[2 * q] * bflo(x0[q]));
            const float e1 = bfhi(g0[q]) * (w0[2 * q + 1] * bfhi(u0[q]) + w1[2 * q + 1] * bfhi(y0[q]) + w2[2 * q + 1] * bfhi(x0[q]));
            const float e2 = bflo(g1[q]) * (w0[8 + 2 * q] * bflo(u1[q]) + w1[8 + 2 * q] * bflo(y1[q]) + w2[8 + 2 * q] * bflo(x1[q]));
            const float e3 = bfhi(g1[q]) * (w0[8 + 2 * q + 1] * bfhi(u1[q]) + w1[8 + 2 * q + 1] * bfhi(y1[q]) + w2[8 + 2 * q + 1] * bfhi(x1[q]));
            p0[q] = pk2(e0, e1); p1[q] = pk2(e2, e3); }
        *(GAS v4u*)(MIX + (size_t)m * 2048 + 1024 + c0) = p0; *(GAS v4u*)(MIX + (size_t)m * 2048 + 1024 + c0 + 8) = p1;
    }
}

struct Args { const float* in[19]; float* out; unsigned char* ws; };
typedef const __attribute__((address_space(4))) Args* cargs_t;
__device__ __forceinline__ cargs_t get_args() { cargs_t p = (cargs_t)__builtin_amdgcn_kernarg_segment_ptr(); asm volatile("" : "+s"(p)); return p; }
__device__ __forceinline__ void make_frame(Frame& F, unsigned char* lds) {
    F.lds = (LAS unsigned char*)lds; F.MISC = (volatile LAS unsigned*)(F.lds + MISC_OFF);
    { int t_ = threadIdx.x; asm volatile("" : "+v"(t_)); F.tid = t_; } F.lane = F.tid & 63; F.wave = __builtin_amdgcn_readfirstlane(F.tid >> 6);
    F.G = gridDim.x; { const int bx = blockIdx.x; F.vcu = (F.G % 8 == 0) ? (bx % 8) * (F.G / 8) + bx / 8 : bx; }
    F.ctl = (gu32*)(get_args()->ws + WS_CTL);
}
__device__ __forceinline__ void grid_bar(unsigned char* lds) {
    XcdBarrier b; b.bar = (unsigned*)(get_args()->ws + WS_CTL) + CW_BAR; b.x = xb_xcc_id(); b.st = (volatile LAS unsigned*)((LAS unsigned char*)lds + MISC_OFF) + 8;
    xcd_barrier(b);
}
__device__ __forceinline__ unsigned char* wlayer(cargs_t a, int l) { return a->ws + WS_W + (size_t)l * W_LAYER; }

__device__ __forceinline__ void ph_prologue(unsigned char* lds) {
    Frame F; make_frame(F, lds); cargs_t a = get_args(); unsigned char* ws = a->ws;
    LAS float* scr = (LAS float*)(F.lds + RING_OFF + F.wave * 16384);
    const int gw = F.vcu * NWAVES + F.wave, NGW = F.G * NWAVES;
    constexpr int I_G = (D / 64) * (FF / 32), I_D = (FF / 64) * (D / 32), I_IN = (D / 64) * (NIN / 32), I_OUT = (D / 64) * (D / 32);
    constexpr int I_LAYER = 4 * I_G + 2 * I_D + I_IN + I_OUT, NITEMS = DEPTH * I_LAYER;
    for (int it = gw; it < NITEMS; it += NGW) {
        const int l = it / I_LAYER; int r = it % I_LAYER;
        unsigned char* wl = ws + WS_W + (size_t)l * W_LAYER;
        if (r < I_G) { p0_transpose_item(a->in[2] + (size_t)l * D * FF, D, FF, (bf16*)(wl + WO_GU1), 1, scr, r, F.lane); continue; } r -= I_G;
        if (r < I_G) { p0_transpose_item(a->in[3] + (size_t)l * D * FF, D, FF, (bf16*)(wl + WO_GU1), 2, scr, r, F.lane); continue; } r -= I_G;
        if (r < I_D) { p0_transpose_item(a->in[4] + (size_t)l * FF * D, FF, D, (bf16*)(wl + WO_D1), 0, scr, r, F.lane); continue; } r -= I_D;
        if (r < I_IN) { p0_transpose_item(a->in[6] + (size_t)l * D * NIN, D, NIN, (bf16*)(wl + WO_IN), 3, scr, r, F.lane); continue; } r -= I_IN;
        if (r < I_OUT) { p0_transpose_item(a->in[13] + (size_t)l * D * D, D, D, (bf16*)(wl + WO_OUT), 0, scr, r, F.lane); continue; } r -= I_OUT;
        if (r < I_G) { p0_transpose_item(a->in[15] + (size_t)l * D * FF, D, FF, (bf16*)(wl + WO_GU2), 1, scr, r, F.lane); continue; } r -= I_G;
        if (r < I_G) { p0_transpose_item(a->in[16] + (size_t)l * D * FF, D, FF, (bf16*)(wl + WO_GU2), 2, scr, r, F.lane); continue; } r -= I_G;
        p0_transpose_item(a->in[17] + (size_t)l * FF * D, FF, D, (bf16*)(wl + WO_D2), 0, scr, r, F.lane);
    }
    float* CS = (float*)(ws + WS_CS);
    for (int i = blockIdx.x * (NWAVES * 64) + F.tid; i < M * 8; i += F.G * NWAVES * 64) {
        const int pos = i >> 3, fi = i & 7; const float ang = (float)pos * INV_FREQ[fi];
        CS[(size_t)pos * 16 + fi] = cosf(ang); CS[(size_t)pos * 16 + 8 + fi] = sinf(ang); }
}
__device__ __forceinline__ void ph_norm(unsigned char* lds, int l, int which) {
    Frame F; make_frame(F, lds); cargs_t a = get_args();
    const float* g = (which == 0 ? a->in[1] : which == 1 ? a->in[5] : a->in[14]) + (size_t)l * D;
    const float* x = (which == 0 && l == 0) ? a->in[0] : a->out;
    norm_phase(F, x, g, (bf16*)(a->ws + WS_H));
}
__device__ __forceinline__ void ph_gateup(unsigned char* lds, int l, int second) {
    cargs_t a = get_args(); unsigned char* ws = a->ws;
    pg8::Gemm g{(const bf16*)(ws + WS_H), (const bf16*)(wlayer(a, l) + (second ? WO_GU2 : WO_GU1)), M, 2 * FF, D}; pg8::StaticOrder S; S.init(M, 2 * FF, (int)gridDim.x, (int)blockIdx.x);
    pg8::EpiSwiGLU E{(bf16*)(ws + WS_ACT), FF};
    pg8::gemm_phase<pg8::EpiSwiGLU, pg8::StaticOrder, PG8_ALIGN, PG8_SP2>((LAS unsigned char*)lds + RING_OFF, g, S, E);
}
__device__ __forceinline__ void ph_down(unsigned char* lds, int l, int second) {
    cargs_t a = get_args(); unsigned char* ws = a->ws;
    pg8::Gemm g{(const bf16*)(ws + WS_ACT), (const bf16*)(wlayer(a, l) + (second ? WO_D2 : WO_D1)), M, D, FF}; pg8::StaticOrder S; S.init(M, D, (int)gridDim.x, (int)blockIdx.x);
    pg8::EpiResidual E{(l == 0 && !second) ? a->in[0] : a->out, a->out, D, 0.5f};
    pg8::gemm_phase<pg8::EpiResidual, pg8::StaticOrder, PG8_ALIGN, PG8_SP2>((LAS unsigned char*)lds + RING_OFF, g, S, E);
}
__device__ __forceinline__ void ph_win(unsigned char* lds, int l) {
    cargs_t a = get_args(); unsigned char* ws = a->ws;
    pg8::Gemm g{(const bf16*)(ws + WS_H), (const bf16*)(wlayer(a, l) + WO_IN), M, NIN, D}; pg8::StaticOrder S; S.init(M, NIN, (int)gridDim.x, (int)blockIdx.x);
    pg8::EpiWin E{(bf16*)(ws + WS_Q), (bf16*)(ws + WS_K), (bf16*)(ws + WS_V), (bf16*)(ws + WS_GB), (bf16*)(ws + WS_CU), (const float*)(ws + WS_CS), attn_body::C2};
    pg8::gemm_phase<pg8::EpiWin, pg8::StaticOrder, PG8_ALIGN, PG8_SP2>((LAS unsigned char*)lds + RING_OFF, g, S, E);
}
__device__ __forceinline__ void ph_attn(unsigned char* lds) {
    unsigned char* ws = get_args()->ws;
    const attn_body::AttnTensors AT{(const attn_body::bf16*)(ws + WS_Q), (const attn_body::bf16*)(ws + WS_K), (const attn_body::bf16*)(ws + WS_V), (attn_body::bf16*)(ws + WS_O)};
    const attn_body::StaticOrder S((int)gridDim.x, (int)blockIdx.x);
    attn_body::attn_phase<attn_body::StaticOrder>((char*)lds + RING_OFF, AT, S);
}
__device__ __forceinline__ void ph_fin(unsigned char* lds, int l) {
    Frame F; make_frame(F, lds); cargs_t a = get_args(); unsigned char* ws = a->ws;
    fin_phase(F, (const bf16*)(ws + WS_O), (const bf16*)(ws + WS_GB), (const bf16*)(ws + WS_CU), (bf16*)(ws + WS_MIX), a->in[8] + l * 64, a->in[9] + l * 64, a->in[10] + l * 64, a->in[11] + l * 64,
              a->in[12] + l * 128, a->in[7] + (size_t)l * 3 * 1024, LAM_INIT[l]);
}
__device__ __forceinline__ void ph_wout(unsigned char* lds, int l) {
    cargs_t a = get_args(); unsigned char* ws = a->ws;
    pg8::Gemm g{(const bf16*)(ws + WS_MIX), (const bf16*)(wlayer(a, l) + WO_OUT), M, D, D}; pg8::StaticOrder S; S.init(M, D, (int)gridDim.x, (int)blockIdx.x);
    pg8::EpiResidual E{a->out, a->out, D, 1.0f};
    pg8::gemm_phase<pg8::EpiResidual, pg8::StaticOrder, PG8_ALIGN, PG8_SP2>((LAS unsigned char*)lds + RING_OFF, g, S, E);
}
__device__ __forceinline__ void ph_final(unsigned char* lds) {
    Frame F; make_frame(F, lds); cargs_t a = get_args();
    final_norm_phase(F, a->out, a->in[18], a->out);
}

__global__ void __launch_bounds__(NWAVES * 64, 2) mk_fwd(Args args) {
    extern __shared__ __attribute__((aligned(16))) unsigned char lds[];
    for (int u = threadIdx.x; u < (LDS_BYTES - LDSCTL_OFF) / 4; u += NWAVES * 64) ((LAS unsigned*)((LAS unsigned char*)lds + LDSCTL_OFF))[u] = 0u;
    __syncthreads();
    (void)xcd_barrier_post((unsigned*)(get_args()->ws + WS_CTL) + CW_BAR, (volatile LAS unsigned*)((LAS unsigned char*)lds + MISC_OFF) + 8);
    ph_prologue(lds);
    ph_norm(lds, 0, 0);
    grid_bar(lds);
#pragma unroll 1
    for (int l = 0; l < DEPTH; ++l) {
        ph_gateup(lds, l, 0); grid_bar(lds);
        ph_down(lds, l, 0); grid_bar(lds);
        ph_norm(lds, l, 1); grid_bar(lds);
        ph_win(lds, l); grid_bar(lds);
        ph_attn(lds); grid_bar(lds);
        ph_fin(lds, l); grid_bar(lds);
        ph_wout(lds, l); grid_bar(lds);
        ph_norm(lds, l, 2); grid_bar(lds);
        ph_gateup(lds, l, 1); grid_bar(lds);
        ph_down(lds, l, 1); grid_bar(lds);
        if (l + 1 < DEPTH) { ph_norm(lds, l + 1, 0); grid_bar(lds); }
    }
    ph_final(lds);
}

extern "C" void kernel_launch(void* const* d_in, const int* in_sizes, int n_in, void* d_out, int out_size, void* d_ws, size_t ws_size, hipStream_t stream) {
    static int grid = 0;
    if (grid == 0) {
        if (n_in != 19 || in_sizes[0] != M * D || out_size != M * D || ws_size < WS_END) { fprintf(stderr, "kernel_launch: built for 19 inputs, x and out of %d floats, >= %zu bytes of workspace; got n_in %d, in0 %d, out %d, ws %zu; nothing launched\n", M * D, (size_t)WS_END, n_in, n_in > 0 ? in_sizes[0] : -1, out_size, ws_size); grid = -1; return; }
        int dev = 0, cus = 0, per_cu = 0;
        if (hipGetDevice(&dev) != hipSuccess || hipDeviceGetAttribute(&cus, hipDeviceAttributeMultiprocessorCount, dev) != hipSuccess) { fprintf(stderr, "kernel_launch: hipGetDevice / hipDeviceGetAttribute failed; nothing launched\n"); grid = -1; return; }
        if (hipFuncSetAttribute((const void*)mk_fwd, hipFuncAttributeMaxDynamicSharedMemorySize, LDS_BYTES) != hipSuccess) { fprintf(stderr, "kernel_launch: hipFuncSetAttribute failed\n"); grid = -1; return; }
        if (hipOccupancyMaxActiveBlocksPerMultiprocessor(&per_cu, (const void*)mk_fwd, NWAVES * 64, LDS_BYTES) != hipSuccess || per_cu < 1)
            fprintf(stderr, "kernel_launch: note: the occupancy query reports %d workgroups per CU\n", per_cu);
        (void)hipGetLastError();
        grid = 256;
        if (cus != 256) fprintf(stderr, "kernel_launch: device has %d CUs; this kernel is built for 256\n", cus);
    }
    if (grid < 0) return;
    if (hipMemsetAsync((char*)d_ws + WS_CTL, 0, CTL_ZERO_BYTES, stream) != hipSuccess) { fprintf(stderr, "kernel_launch: hipMemsetAsync of the control words failed; nothing launched\n"); return; }
    Args a{};
    for (int i = 0; i < 19; ++i) a.in[i] = (const float*)d_in[i];
    a.out = (float*)d_out; a.ws = (unsigned char*)d_ws;
    hipLaunchKernelGGL(mk_fwd, dim3(grid), dim3(NWAVES * 64), LDS_BYTES, stream, a);
    const hipError_t le = hipPeekAtLastError();
    if (le != hipSuccess) fprintf(stderr, "kernel_launch: launch failed: %s\n", hipGetErrorName(le));
}
```

```cpp
#include <hip/hip_runtime.h>
#include <cstdio>
#include <cstdint>
#ifndef PG8_WGM
#define PG8_WGM 4
#endif
namespace pg8 {
#define PG8_LAS __attribute__((address_space(3)))
typedef unsigned short bf16_t;
typedef short bf16x8 __attribute__((ext_vector_type(8)));
typedef float f32x4 __attribute__((ext_vector_type(4)));
typedef unsigned u32x4 __attribute__((ext_vector_type(4)));
constexpr int BM = 256, BK = 64, HALF = 128, HTB = HALF * BK * 2  , STAGE_BYTES = 8 * HTB, NXCD = 8, WGM = PG8_WGM;

__host__ __device__ __forceinline__ int lds_byte(int r, int c) { const int st = (r >> 4) * 2 + (c >> 5), rr = r & 15, cc = c & 31, ob = rr * 64 + cc * 2; return st * 1024 + (ob ^ (((ob >> 9) & 1) << 5)); }
__host__ __device__ __forceinline__ void stage_rc(int b, int& R, int& C) { const int st = b / 1024, sb = b % 1024, swz = sb ^ (((sb >> 9) & 1) << 5); R = (st >> 1) * 16 + swz / 64; C = (st & 1) * 32 + (swz % 64) / 2; }
__host__ __device__ __forceinline__ int perm32(int rho) { const int n = rho >> 4, i = rho & 15; return 8 * (i >> 2) + 4 * n + (i & 3); }

struct Unit { int pm, pn; };
struct Gemm { const bf16_t* A; const bf16_t* Bt; int M, N, K; };

struct StaticOrder {
    int nM, nN, nwg, G, c;
    __host__ __device__ void init(int M, int N, int G_, int c_) { nM = M / BM; nN = N / BM; nwg = nM * nN; G = G_; c = c_; }
    __host__ __device__ bool next(int i, Unit& u) const {
        const long L = (long)i * G + c; if (L >= nwg) return false;
        int wgid = (int)L; { const int q = nwg / NXCD, r = nwg % NXCD, xcd = wgid % NXCD, off = wgid / NXCD; wgid = (xcd < r ? xcd * (q + 1) : r * (q + 1) + (xcd - r) * q) + off; }
        const int nig = WGM * nN, gid = wgid / nig, fm = gid * WGM, gsz = (nM - fm) < WGM ? (nM - fm) : WGM;
        u.pm = fm + ((wgid % nig) % gsz); u.pn = (wgid % nig) / gsz; return true;
    }
    __device__ __forceinline__ void a_ready(const Unit&) const {}
    __device__ __forceinline__ void done(const Unit&) const {}
};

__device__ __forceinline__ unsigned cvt_pk_bf16(float lo, float hi) { unsigned r; asm volatile("v_cvt_pk_bf16_f32 %0, %1, %2" : "=v"(r) : "v"(lo), "v"(hi)); return r; }
typedef float f32x2 __attribute__((ext_vector_type(2)));
#define PG8_GAS __attribute__((address_space(1)))
__device__ __forceinline__ int lane_now() { int l; asm volatile("v_mbcnt_lo_u32_b32 %0, -1, 0\n\tv_mbcnt_hi_u32_b32 %0, -1, %0" : "=v"(l)); return l; }
__device__ __forceinline__ float sum_fq(float s, int fr, int fq) { const int l4 = (fr + 16 * fq) << 2;
    s += __int_as_float(__builtin_amdgcn_ds_bpermute(l4 ^ 64, __float_as_int(s))); s += __int_as_float(__builtin_amdgcn_ds_bpermute(l4 ^ 128, __float_as_int(s))); return s; }
__device__ __forceinline__ float silu_f(float g) { const float e = __builtin_amdgcn_exp2f(g * -1.4426950408889634f); return g * __builtin_amdgcn_rcpf(1.0f + e); }

__device__ __forceinline__ void row_rstd(const unsigned long long* ssq, int row0, float (&rs)[2][4]) {
#pragma unroll
    for (int ai = 0; ai < 2; ++ai)
#pragma unroll
        for (int m = 0; m < 4; ++m) { const unsigned long long v = *(const PG8_GAS unsigned long long*)(ssq + (unsigned)(row0 + ai * HALF + m * 16));
            const float s = (float)(unsigned)(v >> 24) + (float)((unsigned)v & 0xffffffu) * (1.0f / 16777216.0f);
            rs[ai][m] = __builtin_amdgcn_rsqf(s * (1.0f / 2048.0f) + 1e-5f); }
}
constexpr int RSTD_OFF = 131072 + 1024;
__device__ __forceinline__ unsigned long long rstd_fetch(const unsigned long long* ssq, int row) { return *(const PG8_GAS unsigned long long*)(ssq + (unsigned)row); }
__device__ __forceinline__ void rstd_put(unsigned long long v, int slot) {
    const float s = (float)(unsigned)(v >> 24) + (float)((unsigned)v & 0xffffffu) * (1.0f / 16777216.0f);
    *(PG8_LAS float*)(size_t)(RSTD_OFF + 4 * slot) = __builtin_amdgcn_rsqf(s * (1.0f / 2048.0f) + 1e-5f);
}
__device__ __forceinline__ void row_rstd_tab(int rl0, float (&rs)[2][4]) {
#pragma unroll
    for (int ai = 0; ai < 2; ++ai)
#pragma unroll
        for (int m = 0; m < 4; ++m) rs[ai][m] = *(const PG8_LAS float*)(size_t)(RSTD_OFF + 4 * (rl0 + ai * HALF + m * 16));
}
__device__ __forceinline__ void pin_acc(f32x4 (&acc)[2][2][4][2]) {
#pragma unroll
    for (int ai = 0; ai < 2; ++ai)
#pragma unroll
        for (int m = 0; m < 4; ++m) asm volatile("" : "+v"(acc[ai][0][m][0]), "+v"(acc[ai][0][m][1]), "+v"(acc[ai][1][m][0]), "+v"(acc[ai][1][m][1]));
}
struct EpiSwiGLU {
    static constexpr bool PERM = true, AFTER_DRAIN = false, RSTD = true;
    bf16_t* O; int ldc; const unsigned long long* ssq;
    __device__ __forceinline__ void operator()(f32x4 (&acc)[2][2][4][2], const Unit& u, int wr, int wc, int fr, int fq, int pm_tab) const {
        const int row0 = u.pm * BM + wr * 64 + fr, col0 = u.pn * HALF + wc * 32 + 8 * fq;
        float rs[2][4]; if (u.pm == pm_tab) row_rstd_tab(wr * 64 + fr, rs); else row_rstd(ssq, row0, rs);
#pragma unroll
        for (int ai = 0; ai < 2; ++ai)
#pragma unroll
            for (int m = 0; m < 4; ++m) { bf16_t* rowp = O + (unsigned)((row0 + ai * HALF + m * 16) * ldc + col0);
                const float r_ = rs[ai][m]; const f32x2 ce = (f32x2){r_, r_} * -1.4426950408889634f, r2 = (f32x2){r_, r_} * (f32x2){r_, r_};
                u32x4 w;
#pragma unroll
                for (int h = 0; h < 4; ++h) { const f32x4 gq = acc[ai][0][m][h >> 1], uq = acc[ai][1][m][h >> 1];
                    const f32x2 g = (h & 1) ? (f32x2){gq[2], gq[3]} : (f32x2){gq[0], gq[1]}, u2 = (h & 1) ? (f32x2){uq[2], uq[3]} : (f32x2){uq[0], uq[1]};
                    f32x2 e = g * ce; e = (f32x2){__builtin_amdgcn_exp2f(e[0]), __builtin_amdgcn_exp2f(e[1])} + 1.0f; e = (f32x2){__builtin_amdgcn_rcpf(e[0]), __builtin_amdgcn_rcpf(e[1])};
                    const f32x2 o = (g * u2) * (r2 * e); w[h] = cvt_pk_bf16(o[0], o[1]); }
                *(PG8_GAS u32x4*)rowp = w; __builtin_amdgcn_sched_barrier(0); }
    }
};
struct EpiResidual {
    static constexpr bool PERM = true, AFTER_DRAIN = false, RSTD = false;
    bf16_t* xb; int ldc; float scale; unsigned long long* ssq;
    __device__ __forceinline__ void operator()(f32x4 (&acc)[2][2][4][2], const Unit& u, int wr, int wc, int fr, int fq, int pm_tab) const {
        const int row0 = u.pm * BM + wr * 64 + fr, col0 = u.pn * BM + wc * 32 + 8 * fq;
        u32x4 nb[2][2];
#pragma unroll
        for (int p = 0; p < 2; ++p)
#pragma unroll
            for (int bj = 0; bj < 2; ++bj) nb[p][bj] = *(const PG8_GAS u32x4*)(xb + (unsigned)((row0 + p * 16) * ldc + col0 + bj * HALF));
#pragma unroll
        for (int g = 0; g < 8; ++g) { const int ai = g >> 2, m = g & 3;
            u32x4 cb[2];
#pragma unroll
            for (int bj = 0; bj < 2; ++bj) cb[bj] = nb[g & 1][bj];
            asm volatile("" ::: "memory");
            if (g < 6) { const unsigned off = (unsigned)((row0 + ((g + 2) >> 2) * HALF + ((g + 2) & 3) * 16) * ldc + col0);
#pragma unroll
                for (int bj = 0; bj < 2; ++bj) nb[g & 1][bj] = *(const PG8_GAS u32x4*)(xb + (off + bj * HALF)); }
#pragma unroll
            for (int bj = 0; bj < 2; ++bj) { const u32x4 x = cb[bj];
                acc[ai][bj][m][0] = (f32x4){__uint_as_float(x.x << 16), __uint_as_float(x.x & 0xffff0000u), __uint_as_float(x.y << 16), __uint_as_float(x.y & 0xffff0000u)} + acc[ai][bj][m][0] * scale;
                acc[ai][bj][m][1] = (f32x4){__uint_as_float(x.z << 16), __uint_as_float(x.z & 0xffff0000u), __uint_as_float(x.w << 16), __uint_as_float(x.w & 0xffff0000u)} + acc[ai][bj][m][1] * scale; }
            asm volatile("" : "+v"(acc[ai][0][m][0]), "+v"(acc[ai][0][m][1]), "+v"(acc[ai][1][m][0]), "+v"(acc[ai][1][m][1])); }
        asm volatile("" ::: "memory");
#pragma unroll
        for (int ai = 0; ai < 2; ++ai)
#pragma unroll
            for (int m = 0; m < 4; ++m) { const int row = row0 + ai * HALF + m * 16; const unsigned off = (unsigned)(row * ldc + col0); float s = 0.f;
#pragma unroll
                for (int bj = 0; bj < 2; ++bj) { const f32x4 a0 = acc[ai][bj][m][0], a1 = acc[ai][bj][m][1];
                    u32x4 w; w.x = cvt_pk_bf16(a0[0], a0[1]); w.y = cvt_pk_bf16(a0[2], a0[3]); w.z = cvt_pk_bf16(a1[0], a1[1]); w.w = cvt_pk_bf16(a1[2], a1[3]);
                    *(PG8_GAS u32x4*)(xb + (off + bj * HALF)) = w;
#pragma unroll
                    for (int q = 0; q < 4; ++q) { const float lo = __uint_as_float(w[q] << 16), hi = __uint_as_float(w[q] & 0xffff0000u); s += lo * lo + hi * hi; } }
                s = sum_fq(s, fr, fq);
                if (fq == 0) (void)__hip_atomic_fetch_add(ssq + (unsigned)row, (unsigned long long)(s * 16777216.0f), __ATOMIC_RELAXED, __HIP_MEMORY_SCOPE_AGENT); }
    }
};
template <int MODE> struct EpiWin {
    static constexpr bool PERM = true, AFTER_DRAIN = false, RSTD = true;
    bf16_t *O0, *O1; const float* cs; float qscale; const unsigned long long* ssq;
    __device__ __forceinline__ void operator()(f32x4 (&acc)[2][2][4][2], const Unit& u, int wr, int wc, int fr, int fq, int pm_tab) const {
        const int row0 = u.pm * BM + wr * 64 + fr; const int pn = u.pn;
        float rs[2][4]; if (u.pm == pm_tab) row_rstd_tab(wr * 64 + fr, rs); else row_rstd(ssq, row0, rs);
        if constexpr (MODE == 2) {
            const int col0 = pn * HALF + wc * 32 + 8 * fq;
#pragma unroll
            for (int ai = 0; ai < 2; ++ai)
#pragma unroll
                for (int m = 0; m < 4; ++m) { bf16_t* rowp = O0 + (unsigned)((row0 + ai * HALF + m * 16) * 1024 + col0);
                    const float r2 = rs[ai][m] * rs[ai][m]; const f32x4 a0 = acc[ai][0][m][0] * acc[ai][1][m][0] * r2, a1 = acc[ai][0][m][1] * acc[ai][1][m][1] * r2;
                    u32x4 w; w.x = cvt_pk_bf16(a0[0], a0[1]); w.y = cvt_pk_bf16(a0[2], a0[3]); w.z = cvt_pk_bf16(a1[0], a1[1]); w.w = cvt_pk_bf16(a1[2], a1[3]);
                    *(PG8_GAS u32x4*)rowp = w; }
        } else {
            const int col0 = (pn & 3) * BM + wc * 32 + 8 * fq;
            bf16_t* base = pn < 4 ? O0 : O1; const float sc = (MODE == 0 && pn < 4) ? qscale : 1.0f;
            if constexpr (MODE == 0) {
                const bool rope = ((wc & 1) == 0) && (fq < 2); const int fo = 4 * (fq & 1);
#pragma unroll
                for (int ai = 0; ai < 2; ++ai) { f32x4 c[4], s[4];
#pragma unroll
                    for (int m = 0; m < 4; ++m) { const int row = row0 + ai * HALF + m * 16; c[m] = *(const PG8_GAS f32x4*)(cs + (unsigned)(row * 16 + fo)); s[m] = *(const PG8_GAS f32x4*)(cs + (unsigned)(row * 16 + 8 + fo));
                        if (!rope) { c[m] = (f32x4){1.f, 1.f, 1.f, 1.f}; s[m] = (f32x4){0.f, 0.f, 0.f, 0.f}; } }
#pragma unroll
                    for (int m = 0; m < 4; ++m) {
#pragma unroll
                        for (int bj = 0; bj < 2; ++bj) { const f32x4 v0 = acc[ai][bj][m][0], v1 = acc[ai][bj][m][1], cc = c[m], ss = s[m]; f32x4 o0, o1;
                            o0[0] = v0[0] * cc[0] - v0[1] * ss[0]; o0[1] = v0[1] * cc[0] + v0[0] * ss[0]; o0[2] = v0[2] * cc[1] - v0[3] * ss[1]; o0[3] = v0[3] * cc[1] + v0[2] * ss[1];
                            o1[0] = v1[0] * cc[2] - v1[1] * ss[2]; o1[1] = v1[1] * cc[2] + v1[0] * ss[2]; o1[2] = v1[2] * cc[3] - v1[3] * ss[3]; o1[3] = v1[3] * cc[3] + v1[2] * ss[3];
                            acc[ai][bj][m][0] = o0; acc[ai][bj][m][1] = o1; }
                        asm volatile("" : "+v"(acc[ai][0][m][0]), "+v"(acc[ai][0][m][1]), "+v"(acc[ai][1][m][0]), "+v"(acc[ai][1][m][1])); }
                    asm volatile("" ::: "memory"); }
            }
#pragma unroll
            for (int ai = 0; ai < 2; ++ai)
#pragma unroll
                for (int m = 0; m < 4; ++m) { const int row = row0 + ai * HALF + m * 16; bf16_t* rowp = base + (unsigned)(row * 1024 + col0); const float f = sc * rs[ai][m];
#pragma unroll
                    for (int bj = 0; bj < 2; ++bj) { const f32x4 o0 = acc[ai][bj][m][0] * f, o1 = acc[ai][bj][m][1] * f;
                        u32x4 w; w.x = cvt_pk_bf16(o0[0], o0[1]); w.y = cvt_pk_bf16(o0[2], o0[3]); w.z = cvt_pk_bf16(o1[0], o1[1]); w.w = cvt_pk_bf16(o1[2], o1[3]);
                        *(PG8_GAS u32x4*)(rowp + bj * HALF) = w; } }
        }
    }
};

__device__ __forceinline__ void glds16_s(const void* gbase, unsigned voff, unsigned lds_dst) {
    asm volatile("s_mov_b32 m0, %2\n\ts_nop 0\n\tglobal_load_lds_dwordx4 %0, %1" :: "v"(voff), "s"(gbase), "s"(lds_dst) : "memory", "m0");
}
template <bool B> struct ZTag { static constexpr bool value = B; };
template <class Epi, class Sched, bool ALIGN_EPI = false, bool SP2 = false>
__device__ __forceinline__ void gemm_phase(PG8_LAS unsigned char* lds, const Gemm g, const Sched& S, const Epi& E) {
    int tid_ = threadIdx.x; asm volatile("" : "+v"(tid_));
    const int tid = tid_, wid = __builtin_amdgcn_readfirstlane(tid >> 6), lane = tid & 63, wr = wid >> 2, wc = wid & 3, fr = lane & 15, fq = lane >> 4;
    constexpr bool RSTD_ = Epi::RSTD; const unsigned long long* SSQ_ = nullptr; if constexpr (RSTD_) SSQ_ = E.ssq;
    const int K = g.K, nt = K / BK;
    unsigned voffA[2], voffB[2];
#pragma unroll
    for (int i = 0; i < 2; ++i) { int R, C; stage_rc(tid * 16 + i * 8192, R, C); const int Rb = Epi::PERM ? ((R & ~31) + perm32(R & 31)) : R;
        voffA[i] = (unsigned)(R * K + C) * 2u; voffB[i] = (unsigned)(Rb * K + C) * 2u; }
    const size_t kstep = (size_t)(BK * 2);
    const size_t hstep = (size_t)HALF * K * 2;
    const size_t tstep = 2 * hstep;
    const unsigned ldsw = (unsigned)wid * 1024u;
    const unsigned ldsb = (unsigned)__builtin_amdgcn_readfirstlane((int)((unsigned)(size_t)lds + ldsw));
    const int aoff = lds_byte(wr * 64 + fr, fq * 8); int boff = lds_byte(wc * 32 + fr, fq * 8) + 4 * HTB;
    asm volatile("" : "+v"(boff));
#define PG8_SA(b, h) (((b) * 2 + (h)) * HTB)
#define PG8_SB(b, h) ((4 + (b) * 2 + (h)) * HTB)
#define PG8_SBR(b, h) (((b) * 2 + (h)) * HTB)
#define PG8_STAGE(bufoff, gbase, voff) do { _Pragma("unroll") for (int _i = 0; _i < 2; ++_i) \
        glds16_s((gbase), (voff)[_i], ldsb + (unsigned)((bufoff) + _i * 8192)); } while (0)
#define PG8_LDA(dst, b, h) do { _Pragma("unroll") for (int m = 0; m < 4; ++m) _Pragma("unroll") for (int k = 0; k < 2; ++k) dst[m][k] = *(const PG8_LAS bf16x8*)(lds + PG8_SA(b, h) + aoff + m * 2048 + k * 1024); } while (0)
#define PG8_LDB(dst, b, h) do { _Pragma("unroll") for (int n = 0; n < 2; ++n) _Pragma("unroll") for (int k = 0; k < 2; ++k) dst[n][k] = *(const PG8_LAS bf16x8*)(lds + PG8_SBR(b, h) + boff + n * 2048 + k * 1024); } while (0)
#define PG8_MMA(ai, bj, At, Bt) do { __builtin_amdgcn_s_setprio(1); _Pragma("unroll") for (int m = 0; m < 4; ++m) _Pragma("unroll") for (int n = 0; n < 2; ++n) _Pragma("unroll") for (int k = 0; k < 2; ++k) \
        acc[ai][bj][m][n] = __builtin_amdgcn_mfma_f32_16x16x32_bf16(Bt[n][k], At[m][k], acc[ai][bj][m][n], 0, 0, 0); __builtin_amdgcn_s_setprio(0); } while (0)
#define PG8_MMAZ(Z, ai, bj, At, Bt) do { if constexpr (Z) { __builtin_amdgcn_s_setprio(1); _Pragma("unroll") for (int m = 0; m < 4; ++m) _Pragma("unroll") for (int n = 0; n < 2; ++n) { \
        acc[ai][bj][m][n] = __builtin_amdgcn_mfma_f32_16x16x32_bf16(Bt[n][0], At[m][0], (f32x4){0.f, 0.f, 0.f, 0.f}, 0, 0, 0); acc[ai][bj][m][n] = __builtin_amdgcn_mfma_f32_16x16x32_bf16(Bt[n][1], At[m][1], acc[ai][bj][m][n], 0, 0, 0); } \
        __builtin_amdgcn_s_setprio(0); } else PG8_MMA(ai, bj, At, Bt); } while (0)
#define PG8_WAIT_V(n) asm volatile("s_waitcnt vmcnt(" #n ")" ::: "memory")
#define PG8_WAIT_L(n) asm volatile("s_waitcnt lgkmcnt(" #n ")" ::: "memory")
#define PG8_BAR __builtin_amdgcn_s_barrier()
#define PG8_SCHED __builtin_amdgcn_sched_barrier(0)
    Unit cur, nxt; int ui = 0;
    if (!S.next(0, cur)) return;
    f32x4 acc[2][2][4][2];
    bf16x8 At[4][2], B0[2][2], B1[2][2];
    const char* cA = (const char*)g.A + (size_t)cur.pm * tstep; const char* cB = (const char*)g.Bt + (size_t)cur.pn * tstep;
    S.a_ready(cur);
    const int pm0 = cur.pm;
    unsigned long long sv_ = 0ull; if constexpr (RSTD_) sv_ = rstd_fetch(SSQ_, pm0 * BM + (tid & 255));
    if constexpr (SP2) {
        PG8_STAGE(PG8_SB(0, 0), cB, voffB); PG8_STAGE(PG8_SB(0, 1), cB + hstep, voffB); PG8_STAGE(PG8_SA(0, 0), cA, voffA); PG8_STAGE(PG8_SA(0, 1), cA + hstep, voffA);
        if (wr == 1) PG8_BAR;
        PG8_WAIT_V(2); PG8_BAR;
        if constexpr (RSTD_) { if (tid < 256) rstd_put(sv_, tid); }
        PG8_STAGE(PG8_SB(1, 0), cB + kstep, voffB); PG8_STAGE(PG8_SA(1, 0), cA + kstep, voffA); PG8_STAGE(PG8_SB(1, 1), cB + hstep + kstep, voffB);
        PG8_WAIT_V(6); PG8_BAR;
    } else {
        PG8_STAGE(PG8_SB(0, 0), cB, voffB); PG8_STAGE(PG8_SA(0, 0), cA, voffA); PG8_STAGE(PG8_SB(0, 1), cB + hstep, voffB); PG8_STAGE(PG8_SA(0, 1), cA + hstep, voffA);
        if (wr == 1) PG8_BAR;
        PG8_WAIT_V(4); PG8_BAR;
        if constexpr (RSTD_) { if (tid < 256) rstd_put(sv_, tid); }
        PG8_STAGE(PG8_SB(1, 0), cB + kstep, voffB); PG8_STAGE(PG8_SA(1, 0), cA + kstep, voffA); PG8_STAGE(PG8_SB(1, 1), cB + hstep + kstep, voffB);
        PG8_WAIT_V(6); PG8_BAR;
    }
    for (;;) {
        const bool has_next = S.next(ui + 1, nxt);
        const char* nA = has_next ? (const char*)g.A + (size_t)nxt.pm * tstep : cA; const char* nB = has_next ? (const char*)g.Bt + (size_t)nxt.pn * tstep : cB;
        auto kpair = [&](auto ztag, const int t) __attribute__((always_inline)) {
            constexpr bool Z = decltype(ztag)::value;
            const bool last = (t == nt - 2);
            const char* a1 = cA + (size_t)(t + 1) * kstep;
            const char* a2 = last ? nA : cA + (size_t)(t + 2) * kstep; const char* b2 = last ? nB : cB + (size_t)(t + 2) * kstep;
            const char* a3 = a2 + kstep; const char* b3 = b2 + kstep;
            if (last && has_next) S.a_ready(nxt);
            if constexpr (SP2) {
            PG8_LDB(B0, 0, 0); PG8_LDB(B1, 0, 1); PG8_SCHED; PG8_LDA(At, 0, 0); PG8_STAGE(PG8_SA(1, 1), a1 + hstep, voffA);
            PG8_WAIT_V(8); PG8_WAIT_L(0); PG8_BAR; PG8_MMAZ(Z, 0, 0, At, B0); PG8_MMAZ(Z, 0, 1, At, B1); PG8_BAR; PG8_SCHED;
            PG8_LDA(At, 0, 1); PG8_STAGE(PG8_SB(0, 0), b2, voffB); PG8_STAGE(PG8_SB(0, 1), b2 + hstep, voffB); PG8_STAGE(PG8_SA(0, 0), a2, voffA);
            PG8_WAIT_V(8); PG8_WAIT_L(0); PG8_BAR; PG8_MMAZ(Z, 1, 0, At, B0); PG8_MMAZ(Z, 1, 1, At, B1); PG8_BAR; PG8_SCHED;
            PG8_LDB(B0, 1, 0); PG8_LDB(B1, 1, 1); PG8_SCHED; PG8_LDA(At, 1, 0); PG8_STAGE(PG8_SA(0, 1), a2 + hstep, voffA);
            PG8_WAIT_V(8); PG8_WAIT_L(0); PG8_BAR; PG8_MMA(0, 0, At, B0); PG8_MMA(0, 1, At, B1); PG8_BAR; PG8_SCHED;
            PG8_LDA(At, 1, 1); PG8_STAGE(PG8_SB(1, 0), b3, voffB); PG8_STAGE(PG8_SB(1, 1), b3 + hstep, voffB); PG8_STAGE(PG8_SA(1, 0), a3, voffA);
            PG8_WAIT_V(8); PG8_WAIT_L(0); PG8_BAR; PG8_MMA(1, 0, At, B0); PG8_MMA(1, 1, At, B1); PG8_BAR; PG8_SCHED;
            } else {
            PG8_LDB(B0, 0, 0); PG8_SCHED; PG8_LDA(At, 0, 0); PG8_STAGE(PG8_SA(1, 1), a1 + hstep, voffA);
            PG8_WAIT_L(8); PG8_BAR; PG8_WAIT_L(0); PG8_MMAZ(Z, 0, 0, At, B0); PG8_BAR; PG8_SCHED;
            PG8_LDB(B1, 0, 1); PG8_STAGE(PG8_SB(0, 0), b2, voffB);
            PG8_BAR; PG8_WAIT_L(0); PG8_MMAZ(Z, 0, 1, At, B1); PG8_BAR;
            PG8_LDA(At, 0, 1); PG8_STAGE(PG8_SA(0, 0), a2, voffA);
            PG8_BAR; PG8_WAIT_L(0); PG8_MMAZ(Z, 1, 0, At, B0); PG8_BAR; PG8_SCHED;
            PG8_STAGE(PG8_SB(0, 1), b2 + hstep, voffB);
            PG8_WAIT_V(6); PG8_BAR; PG8_MMAZ(Z, 1, 1, At, B1); PG8_BAR;
            PG8_LDB(B0, 1, 0); PG8_SCHED; PG8_LDA(At, 1, 0); PG8_STAGE(PG8_SA(0, 1), a2 + hstep, voffA);
            PG8_WAIT_L(8); PG8_BAR; PG8_WAIT_L(0); PG8_MMA(0, 0, At, B0); PG8_BAR; PG8_SCHED;
            PG8_LDB(B1, 1, 1); PG8_STAGE(PG8_SB(1, 0), b3, voffB);
            PG8_BAR; PG8_WAIT_L(0); PG8_MMA(0, 1, At, B1); PG8_BAR;
            PG8_LDA(At, 1, 1); PG8_STAGE(PG8_SA(1, 0), a3, voffA);
            PG8_BAR; PG8_WAIT_L(0); PG8_MMA(1, 0, At, B0); PG8_BAR; PG8_SCHED;
            PG8_STAGE(PG8_SB(1, 1), b3 + hstep, voffB);
            PG8_WAIT_V(6); PG8_BAR; PG8_MMA(1, 1, At, B1); PG8_BAR;
            }
        };
        kpair(ZTag<true>{}, 0);
        for (int t = 2; t < nt; t += 2) kpair(ZTag<false>{}, t);
        if constexpr (ALIGN_EPI) { if (has_next && wr == 0) PG8_BAR; }
        if constexpr (!Epi::AFTER_DRAIN) { E(acc, cur, wr, wc, fr, fq, pm0); S.done(cur); }
        if (!has_next) break;
        cur = nxt; cA = nA; cB = nB; ++ui;
        if constexpr (ALIGN_EPI) { if (wr == 1) PG8_BAR; }
    }
    PG8_WAIT_V(0);
    if (wr == 0) PG8_BAR;
    PG8_BAR;
    if constexpr (Epi::AFTER_DRAIN) { E.fused(acc, cur, wr, wc, fr, fq, lds, wid, lane); S.done(cur); }
#undef PG8_SA
#undef PG8_SB
#undef PG8_SBR
#undef PG8_STAGE
#undef PG8_LDA
#undef PG8_LDB
#undef PG8_MMA
#undef PG8_MMAZ
#undef PG8_WAIT_V
#undef PG8_WAIT_L
#undef PG8_BAR
#undef PG8_SCHED
}
template <class E0, class E1, class E2, class Sched, bool ALIGN_EPI = false, bool SP2 = false>
__device__ __forceinline__ void gemm_phase3(PG8_LAS unsigned char* lds, const Gemm g, const bf16_t* Bt1, const bf16_t* Bt2, const Sched& S, const E0& e0, const E1& e1, const E2& e2) {
    int tid_ = threadIdx.x; asm volatile("" : "+v"(tid_));
    const int tid = tid_, wid = __builtin_amdgcn_readfirstlane(tid >> 6), lane = tid & 63, wr = wid >> 2, wc = wid & 3, fr = lane & 15, fq = lane >> 4;
    constexpr bool RSTD_ = E0::RSTD; static_assert(E0::RSTD == E1::RSTD && E1::RSTD == E2::RSTD, "one rstd table"); const unsigned long long* SSQ_ = nullptr; if constexpr (RSTD_) SSQ_ = e0.ssq;
    const int K = g.K, nt = K / BK;
    unsigned voffA[2], voffB[2];
#pragma unroll
    for (int i = 0; i < 2; ++i) { int R, C; stage_rc(tid * 16 + i * 8192, R, C); const int Rb = E0::PERM ? ((R & ~31) + perm32(R & 31)) : R;
        voffA[i] = (unsigned)(R * K + C) * 2u; voffB[i] = (unsigned)(Rb * K + C) * 2u; }
    const size_t kstep = (size_t)(BK * 2);
    const size_t hstep = (size_t)HALF * K * 2;
    const size_t tstep = 2 * hstep;
    const unsigned ldsw = (unsigned)wid * 1024u;
    const unsigned ldsb = (unsigned)__builtin_amdgcn_readfirstlane((int)((unsigned)(size_t)lds + ldsw));
    const int aoff = lds_byte(wr * 64 + fr, fq * 8); int boff = lds_byte(wc * 32 + fr, fq * 8) + 4 * HTB;
    asm volatile("" : "+v"(boff));
#define PG8_SA(b, h) (((b) * 2 + (h)) * HTB)
#define PG8_SB(b, h) ((4 + (b) * 2 + (h)) * HTB)
#define PG8_SBR(b, h) (((b) * 2 + (h)) * HTB)
#define PG8_STAGE(bufoff, gbase, voff) do { _Pragma("unroll") for (int _i = 0; _i < 2; ++_i) \
        glds16_s((gbase), (voff)[_i], ldsb + (unsigned)((bufoff) + _i * 8192)); } while (0)
#define PG8_LDA(dst, b, h) do { _Pragma("unroll") for (int m = 0; m < 4; ++m) _Pragma("unroll") for (int k = 0; k < 2; ++k) dst[m][k] = *(const PG8_LAS bf16x8*)(lds + PG8_SA(b, h) + aoff + m * 2048 + k * 1024); } while (0)
#define PG8_LDB(dst, b, h) do { _Pragma("unroll") for (int n = 0; n < 2; ++n) _Pragma("unroll") for (int k = 0; k < 2; ++k) dst[n][k] = *(const PG8_LAS bf16x8*)(lds + PG8_SBR(b, h) + boff + n * 2048 + k * 1024); } while (0)
#define PG8_MMA(ai, bj, At, Bt) do { __builtin_amdgcn_s_setprio(1); _Pragma("unroll") for (int m = 0; m < 4; ++m) _Pragma("unroll") for (int n = 0; n < 2; ++n) _Pragma("unroll") for (int k = 0; k < 2; ++k) \
        acc[ai][bj][m][n] = __builtin_amdgcn_mfma_f32_16x16x32_bf16(Bt[n][k], At[m][k], acc[ai][bj][m][n], 0, 0, 0); __builtin_amdgcn_s_setprio(0); } while (0)
#define PG8_MMAZ(Z, ai, bj, At, Bt) do { if constexpr (Z) { __builtin_amdgcn_s_setprio(1); _Pragma("unroll") for (int m = 0; m < 4; ++m) _Pragma("unroll") for (int n = 0; n < 2; ++n) { \
        acc[ai][bj][m][n] = __builtin_amdgcn_mfma_f32_16x16x32_bf16(Bt[n][0], At[m][0], (f32x4){0.f, 0.f, 0.f, 0.f}, 0, 0, 0); acc[ai][bj][m][n] = __builtin_amdgcn_mfma_f32_16x16x32_bf16(Bt[n][1], At[m][1], acc[ai][bj][m][n], 0, 0, 0); } \
        __builtin_amdgcn_s_setprio(0); } else PG8_MMA(ai, bj, At, Bt); } while (0)
#define PG8_WAIT_V(n) asm volatile("s_waitcnt vmcnt(" #n ")" ::: "memory")
#define PG8_WAIT_L(n) asm volatile("s_waitcnt lgkmcnt(" #n ")" ::: "memory")
#define PG8_BAR __builtin_amdgcn_s_barrier()
#define PG8_SCHED __builtin_amdgcn_sched_barrier(0)
    Unit cur, nxt; int ui = 0;
    if (!S.next(0, cur)) return;
    f32x4 acc[2][2][4][2];
#pragma unroll
    for (int a = 0; a < 2; ++a)
#pragma unroll
        for (int b = 0; b < 2; ++b)
#pragma unroll
            for (int m = 0; m < 4; ++m)
#pragma unroll
                for (int n = 0; n < 2; ++n) acc[a][b][m][n] = (f32x4){0.f, 0.f, 0.f, 0.f};
    bf16x8 At[4][2], B0[2][2], B1[2][2];
    const char* cA = (const char*)g.A + (size_t)cur.pm * tstep; const char* cB = (const char*)g.Bt + (size_t)cur.pn * tstep;
    S.a_ready(cur);
    const int pm0 = cur.pm;
    unsigned long long sv_ = 0ull; if constexpr (RSTD_) sv_ = rstd_fetch(SSQ_, pm0 * BM + (tid & 255));
    if constexpr (SP2) {
        PG8_STAGE(PG8_SB(0, 0), cB, voffB); PG8_STAGE(PG8_SB(0, 1), cB + hstep, voffB); PG8_STAGE(PG8_SA(0, 0), cA, voffA); PG8_STAGE(PG8_SA(0, 1), cA + hstep, voffA);
        if (wr == 1) PG8_BAR;
        PG8_WAIT_V(2); PG8_BAR;
        if constexpr (RSTD_) { if (tid < 256) rstd_put(sv_, tid); }
        PG8_STAGE(PG8_SB(1, 0), cB + kstep, voffB); PG8_STAGE(PG8_SA(1, 0), cA + kstep, voffA); PG8_STAGE(PG8_SB(1, 1), cB + hstep + kstep, voffB);
        PG8_WAIT_V(6); PG8_BAR;
    } else {
        PG8_STAGE(PG8_SB(0, 0), cB, voffB); PG8_STAGE(PG8_SA(0, 0), cA, voffA); PG8_STAGE(PG8_SB(0, 1), cB + hstep, voffB); PG8_STAGE(PG8_SA(0, 1), cA + hstep, voffA);
        if (wr == 1) PG8_BAR;
        PG8_WAIT_V(4); PG8_BAR;
        if constexpr (RSTD_) { if (tid < 256) rstd_put(sv_, tid); }
        PG8_STAGE(PG8_SB(1, 0), cB + kstep, voffB); PG8_STAGE(PG8_SA(1, 0), cA + kstep, voffA); PG8_STAGE(PG8_SB(1, 1), cB + hstep + kstep, voffB);
        PG8_WAIT_V(6); PG8_BAR;
    }
    static_assert(E0::PERM == E1::PERM && E1::PERM == E2::PERM && !E0::AFTER_DRAIN && !E1::AFTER_DRAIN && !E2::AFTER_DRAIN, "gemm_phase3: one staging order, in-loop epilogues");
    const char* cB1 = (const char*)Bt1 + (size_t)cur.pn * tstep; const char* cB2 = (const char*)Bt2 + (size_t)cur.pn * tstep;
    auto unit = [&](const auto& E, const char* nA, const char* nB, const bool has_next) __attribute__((always_inline)) {
            auto kpair = [&](auto ztag, const int t) __attribute__((always_inline)) {
                constexpr bool Z = decltype(ztag)::value;
                const bool last = (t == nt - 2);
                const char* a1 = cA + (size_t)(t + 1) * kstep;
                const char* a2 = last ? nA : cA + (size_t)(t + 2) * kstep; const char* b2 = last ? nB : cB + (size_t)(t + 2) * kstep;
                const char* a3 = a2 + kstep; const char* b3 = b2 + kstep;

                if constexpr (SP2) {
                PG8_LDB(B0, 0, 0); PG8_LDB(B1, 0, 1); PG8_SCHED; PG8_LDA(At, 0, 0); PG8_STAGE(PG8_SA(1, 1), a1 + hstep, voffA);
                PG8_WAIT_V(8); PG8_WAIT_L(0); PG8_BAR; PG8_MMAZ(Z, 0, 0, At, B0); PG8_MMAZ(Z, 0, 1, At, B1); PG8_BAR; PG8_SCHED;
                PG8_LDA(At, 0, 1); PG8_STAGE(PG8_SB(0, 0), b2, voffB); PG8_STAGE(PG8_SB(0, 1), b2 + hstep, voffB); PG8_STAGE(PG8_SA(0, 0), a2, voffA);
                PG8_WAIT_V(8); PG8_WAIT_L(0); PG8_BAR; PG8_MMAZ(Z, 1, 0, At, B0); PG8_MMAZ(Z, 1, 1, At, B1); PG8_BAR; PG8_SCHED;
                PG8_LDB(B0, 1, 0); PG8_LDB(B1, 1, 1); PG8_SCHED; PG8_LDA(At, 1, 0); PG8_STAGE(PG8_SA(0, 1), a2 + hstep, voffA);
                PG8_WAIT_V(8); PG8_WAIT_L(0); PG8_BAR; PG8_MMA(0, 0, At, B0); PG8_MMA(0, 1, At, B1); PG8_BAR; PG8_SCHED;
                PG8_LDA(At, 1, 1); PG8_STAGE(PG8_SB(1, 0), b3, voffB); PG8_STAGE(PG8_SB(1, 1), b3 + hstep, voffB); PG8_STAGE(PG8_SA(1, 0), a3, voffA);
                PG8_WAIT_V(8); PG8_WAIT_L(0); PG8_BAR; PG8_MMA(1, 0, At, B0); PG8_MMA(1, 1, At, B1); PG8_BAR; PG8_SCHED;
                } else {
                PG8_LDB(B0, 0, 0); PG8_SCHED; PG8_LDA(At, 0, 0); PG8_STAGE(PG8_SA(1, 1), a1 + hstep, voffA);
                PG8_WAIT_L(8); PG8_BAR; PG8_WAIT_L(0); PG8_MMAZ(Z, 0, 0, At, B0); PG8_BAR; PG8_SCHED;
                PG8_LDB(B1, 0, 1); PG8_STAGE(PG8_SB(0, 0), b2, voffB);
                PG8_BAR; PG8_WAIT_L(0); PG8_MMAZ(Z, 0, 1, At, B1); PG8_BAR;
                PG8_LDA(At, 0, 1); PG8_STAGE(PG8_SA(0, 0), a2, voffA);
                PG8_BAR; PG8_WAIT_L(0); PG8_MMAZ(Z, 1, 0, At, B0); PG8_BAR; PG8_SCHED;
                PG8_STAGE(PG8_SB(0, 1), b2 + hstep, voffB);
                PG8_WAIT_V(6); PG8_BAR; PG8_MMAZ(Z, 1, 1, At, B1); PG8_BAR;
                PG8_LDB(B0, 1, 0); PG8_SCHED; PG8_LDA(At, 1, 0); PG8_STAGE(PG8_SA(0, 1), a2 + hstep, voffA);
                PG8_WAIT_L(8); PG8_BAR; PG8_WAIT_L(0); PG8_MMA(0, 0, At, B0); PG8_BAR; PG8_SCHED;
                PG8_LDB(B1, 1, 1); PG8_STAGE(PG8_SB(1, 0), b3, voffB);
                PG8_BAR; PG8_WAIT_L(0); PG8_MMA(0, 1, At, B1); PG8_BAR;
                PG8_LDA(At, 1, 1); PG8_STAGE(PG8_SA(1, 0), a3, voffA);
                PG8_BAR; PG8_WAIT_L(0); PG8_MMA(1, 0, At, B0); PG8_BAR; PG8_SCHED;
                PG8_STAGE(PG8_SB(1, 1), b3 + hstep, voffB);
                PG8_WAIT_V(6); PG8_BAR; PG8_MMA(1, 1, At, B1); PG8_BAR;
                }
            };
            for (int t = 0; t < nt; t += 2) kpair(ZTag<false>{}, t);
            if constexpr (ALIGN_EPI) { if (has_next && wr == 0) PG8_BAR; }
            { const int ln_ = lane_now();
              E(acc, cur, wr, wc, ln_ & 15, ln_ >> 4, pm0); }
            if (!has_next) return;
    #pragma unroll
            for (int a = 0; a < 2; ++a)
    #pragma unroll
                for (int b = 0; b < 2; ++b)
    #pragma unroll
                    for (int m = 0; m < 4; ++m)
    #pragma unroll
                        for (int n = 0; n < 2; ++n) acc[a][b][m][n] = (f32x4){0.f, 0.f, 0.f, 0.f};
            cA = nA; cB = nB;
            if constexpr (ALIGN_EPI) { if (wr == 1) PG8_BAR; }
    };
    const char* cA1 = cA; const char* cA2 = cA; asm volatile("" : "+s"(cA1), "+s"(cA2));
    unit(e0, cA1, cB1, true); unit(e1, cA2, cB2, true); unit(e2, cA, cB, false);
    PG8_WAIT_V(0);
    if (wr == 0) PG8_BAR;
    PG8_BAR;
#undef PG8_SA
#undef PG8_SB
#undef PG8_SBR
#undef PG8_STAGE
#undef PG8_LDA
#undef PG8_LDB
#undef PG8_MMA
#undef PG8_MMAZ
#undef PG8_WAIT_V
#undef PG8_WAIT_L
#undef PG8_BAR
#undef PG8_SCHED
}
}

#ifndef PG8_SP2
#define PG8_SP2 true
#endif
#ifndef PG8_ALIGN1
#define PG8_ALIGN1 true
#endif
#ifndef PG8_ALIGN
#define PG8_ALIGN true
#endif
#include <hip/hip_bf16.h>
#include <cmath>
namespace attn_body {
using bf16=__hip_bfloat16;
using bf16x8=__attribute__((ext_vector_type(8)))short;
using s16x4=__attribute__((ext_vector_type(4)))short;
using f32x16=__attribute__((ext_vector_type(16)))float;
using u32x4=__attribute__((ext_vector_type(4)))unsigned;
constexpr int BATCH=1,NHEAD=32,SEQ=8192,D=64,DM=1024,OP=2048;
constexpr int NW=8,QBLK=32,QB=QBLK*NW,KVBLK=64,NQB=SEQ/QB;
constexpr int ATTN_PITCH=DM, ATTN_UNIT_ROWS=QB;
__device__ __forceinline__ int crow(int r,int hi){return (r&3)+8*(r>>2)+4*hi;}
#define SBAR() __builtin_amdgcn_sched_barrier(0)
__device__ __forceinline__ void cmask(f32x16&p0,f32x16&p1,int jb,int qrel,int hi){
  const float NEG=-INFINITY; int kb=64*jb+4*hi;
  #pragma unroll
  for(int r=0;r<16;++r){int kv=kb+(r&3)+8*(r>>2); if(kv>qrel)p0[r]=NEG; if(kv+32>qrel)p1[r]=NEG;}
}

constexpr int NSLOT=3, SLOTB=8192;
constexpr int LDS_K=0, LDS_V=NSLOT*SLOTB, LDS_WS=3*NSLOT*SLOTB, LDS_OST=LDS_WS+NW*64*4, LDS_BYTES=LDS_OST+NW*4096;
constexpr float C2=0.125f*1.4426950408889634f;
__device__ __forceinline__ void glds16(const void*gsrc,unsigned lds_dst){
  asm volatile("s_mov_b32 m0, %1\n\ts_nop 0\n\tglobal_load_lds_dwordx4 %0, off"::"v"(gsrc),"s"(lds_dst):"memory","m0");}
__device__ __forceinline__ float max3f(float a,float b,float c){float r;asm("v_max3_f32 %0, %1, %2, %3":"=v"(r):"v"(a),"v"(b),"v"(c));return r;}
__device__ __forceinline__ float max2f(float a,float b){float r;asm("v_max_f32_e32 %0, %1, %2":"=v"(r):"v"(a),"v"(b));return r;}
__device__ __forceinline__ float fadd_s(float a,float b){float r;asm("v_add_f32_e32 %0, %1, %2":"=v"(r):"v"(a),"v"(b));return r;}
__device__ __forceinline__ float fsub_s(float a,float b){float r;asm("v_sub_f32_e32 %0, %1, %2":"=v"(r):"v"(a),"v"(b));return r;}
typedef float f32x2_t __attribute__((ext_vector_type(2))); typedef __bf16 bf16x2_t __attribute__((ext_vector_type(2)));
__device__ __forceinline__ unsigned cvtpk_s(float lo,float hi){f32x2_t v={lo,hi};bf16x2_t b=__builtin_convertvector(v,bf16x2_t);return __builtin_bit_cast(unsigned,b);}
#define WAIT_BAR(N) asm volatile("s_waitcnt vmcnt(" #N ") lgkmcnt(0)\n\ts_barrier":::"memory")

__device__ __forceinline__ void qkt(f32x16&p0,f32x16&p1,const char*Kslot,const bf16x8*qr,const f32x16&negm,int r32,int hi){
  const char*kb=Kslot+hi*1024+r32*16;
  #pragma unroll
  for(int d0=0;d0<4;++d0){
    const bf16x8 b0=*reinterpret_cast<const bf16x8*>(kb+d0*2048);
    const bf16x8 b1=*reinterpret_cast<const bf16x8*>(kb+d0*2048+512);
    if(d0==0){p0=__builtin_amdgcn_mfma_f32_32x32x16_bf16(b0,qr[0],negm,0,0,0);p1=__builtin_amdgcn_mfma_f32_32x32x16_bf16(b1,qr[0],negm,0,0,0);}
    else{p0=__builtin_amdgcn_mfma_f32_32x32x16_bf16(b0,qr[d0],p0,0,0,0);p1=__builtin_amdgcn_mfma_f32_32x32x16_bf16(b1,qr[d0],p1,0,0,0);}}
}
typedef __attribute__((address_space(3))) const char* lds_cptr;
typedef short v4i16_t __attribute__((ext_vector_type(4)));
__device__ __forceinline__ void kload8(bf16x8*kf,lds_cptr kp){
  kf[0]=*(const __attribute__((address_space(3))) bf16x8*)(kp);      kf[1]=*(const __attribute__((address_space(3))) bf16x8*)(kp+512);
  kf[2]=*(const __attribute__((address_space(3))) bf16x8*)(kp+2048); kf[3]=*(const __attribute__((address_space(3))) bf16x8*)(kp+2560);
  kf[4]=*(const __attribute__((address_space(3))) bf16x8*)(kp+4096); kf[5]=*(const __attribute__((address_space(3))) bf16x8*)(kp+4608);
  kf[6]=*(const __attribute__((address_space(3))) bf16x8*)(kp+6144); kf[7]=*(const __attribute__((address_space(3))) bf16x8*)(kp+6656);
}
__device__ __forceinline__ void kload2(bf16x8*kf,lds_cptr kp,int j){ kf[2*j]=*(const __attribute__((address_space(3))) bf16x8*)(kp+j*2048); kf[2*j+1]=*(const __attribute__((address_space(3))) bf16x8*)(kp+j*2048+512); }
__device__ __forceinline__ s16x4 vtr(lds_cptr p){ return __builtin_bit_cast(s16x4,__builtin_amdgcn_ds_read_tr16_b64_v4i16((__attribute__((address_space(3))) v4i16_t*)p)); }
__device__ __forceinline__ float rowmax(const f32x16&p0,const f32x16&p1){
  float a=max3f(p0[0],p0[1],p1[0]),b=max3f(p0[2],p0[3],p1[1]);a=max3f(a,p1[2],p1[3]);
  #pragma unroll
  for(int r=4;r<16;r+=4){a=max3f(a,p0[r],p0[r+1]);b=max3f(b,p0[r+2],p0[r+3]);a=max3f(a,p1[r],p1[r+1]);b=max3f(b,p1[r+2],p1[r+3]);}
  const float m=max2f(a,b);
  auto rr=__builtin_amdgcn_permlane32_swap(__float_as_uint(m),__float_as_uint(m),false,false);
  return max2f(__uint_as_float(rr[0]),__uint_as_float(rr[1]));
}
__device__ __forceinline__ void pv(f32x16*o,int vb,bf16x8 pa0,bf16x8 pa1,bf16x8 pa2,bf16x8 pa3){
  #pragma unroll
  for(int d0=0;d0<4;++d0){s16x4 lo[4],hi[4];
    #pragma unroll
    for(int ks=0;ks<4;++ks){
      asm volatile("ds_read_b64_tr_b16 %0,%1 offset:%c2":"=&v"(lo[ks]):"v"(vb),"i"(d0*4096+ks*1024):"memory");
      asm volatile("ds_read_b64_tr_b16 %0,%1 offset:%c2":"=&v"(hi[ks]):"v"(vb),"i"(d0*4096+ks*1024+512):"memory");}
    asm volatile("s_waitcnt lgkmcnt(0)":::"memory");SBAR();
    #define PK(k) (bf16x8){lo[k][0],lo[k][1],lo[k][2],lo[k][3],hi[k][0],hi[k][1],hi[k][2],hi[k][3]}
    o[d0]=__builtin_amdgcn_mfma_f32_32x32x16_bf16(pa0,PK(0),o[d0],0,0,0);
    o[d0]=__builtin_amdgcn_mfma_f32_32x32x16_bf16(pa1,PK(1),o[d0],0,0,0);
    o[d0]=__builtin_amdgcn_mfma_f32_32x32x16_bf16(pa2,PK(2),o[d0],0,0,0);
    o[d0]=__builtin_amdgcn_mfma_f32_32x32x16_bf16(pa3,PK(3),o[d0],0,0,0);
    #undef PK
  }
}

#ifndef ATTN_STORE16
#define ATTN_STORE16(p,v) (*(u32x4*)(p)=(v))
#endif
template<int THRL> __device__ __forceinline__ void attn_unit(int qb,const bf16*Q,const bf16*__restrict__ K,const bf16*__restrict__ V,bf16*O,char*shm){
  int tid_=threadIdx.x; asm volatile("":"+v"(tid_)); const int tid=tid_,lane=tid&63,r32=lane&31,hi=lane>>5; const int wid=__builtin_amdgcn_readfirstlane(tid>>6);
  const int q0=qb*QB;
  const bf16*Qw=Q+(long)(q0+wid*QBLK)*DM;
  const bf16*Kh=K,*Vh=V;
  const unsigned lds0=(unsigned)(uintptr_t)shm;
  float*wsf=(float*)(shm+LDS_WS)+wid*64;
  const bf16*ksrc=Kh+(long)lane*DM+wid*8;
  const bf16*vsrc=Vh+(long)(16*(wid&3)+(lane>>2))*DM+(wid>>2)*32+(lane&3)*8;
  const unsigned kdst=lds0+LDS_K+wid*1024, vdst=lds0+LDS_V+wid*1024;
  #define DMA_K(t,slot) glds16(ksrc+(long)(t)*KVBLK*DM,(unsigned)__builtin_amdgcn_readfirstlane(kdst+(slot)))
  #define DMA_V(t,slot) do{ glds16(vsrc+(long)(t)*KVBLK*DM,(unsigned)__builtin_amdgcn_readfirstlane(vdst+2*(slot))); glds16(vsrc+(long)(t)*KVBLK*DM+64,(unsigned)__builtin_amdgcn_readfirstlane(vdst+2*(slot)+8192)); }while(0)
  const int vb0=(int)(lds0+LDS_V)+((lane>>4)&1)*32+(lane&3)*8+(4*hi+((lane&15)>>2))*64;
  const char*Kbase=shm+LDS_K; bf16x8 kf[8];
  const lds_cptr shm3=(lds_cptr)shm; const lds_cptr kp0=shm3+LDS_K+hi*1024+r32*16; const lds_cptr vp0=shm3+LDS_V+((lane>>4)&1)*32+(lane&3)*8+(4*hi+((lane&15)>>2))*64;
  const int NT=(q0+QB)/KVBLK;
  DMA_K(0,0);DMA_V(0,0);DMA_K(1,SLOTB);
  const lds_cptr qp0=shm3+LDS_OST+wid*4096+hi*512+r32*16;
  { bf16x8 qt[4];
  #pragma unroll
  for(int d0=0;d0<4;++d0)qt[d0]=*reinterpret_cast<const bf16x8*>(&Qw[(long)r32*DM+d0*16+hi*8]);
  #pragma unroll
  for(int d0=0;d0<4;++d0)*(__attribute__((address_space(3))) bf16x8*)(qp0+d0*1024)=qt[d0]; }
  #define QF(d0) (*(const __attribute__((address_space(3))) bf16x8*)(qp0+(d0)*1024))
  float mhat=0.f,l_reg=0.f;float zf_=0.f;asm volatile("":"+v"(zf_));
  f32x16 o[4];f32x16 negm;
  #pragma unroll
  for(int r=0;r<16;++r){o[0][r]=zf_;o[1][r]=zf_;o[2][r]=zf_;o[3][r]=zf_;negm[r]=zf_;}asm volatile("":"+v"(negm));
  const int qrel=wid*QBLK+r32;
  #define CMASK(P0,P1,t) do{int jb_=(t)-(NT-4); if(jb_>=0)cmask(P0,P1,jb_,qrel,hi);}while(0)
  bool resc=false;
  #define START(P0,P1) do{ const float rm=rowmax(P0,P1); resc=false; \
    { const float dl=rm; mhat=fadd_s(mhat,dl); \
      _Pragma("unroll") for(int r=0;r<16;++r){P0[r]=fsub_s(P0[r],dl);P1[r]=fsub_s(P1[r],dl);} \
      _Pragma("unroll") for(int r=0;r<16;++r)negm[r]=-mhat; asm volatile("":"+v"(negm)); } \
    _Pragma("unroll") for(int r=0;r<16;++r)P0[r]=__builtin_amdgcn_exp2f(P0[r]); }while(0)
  #define RESC() do{ if(resc){ asm volatile("s_waitcnt lgkmcnt(0)":::"memory"); \
      _Pragma("unroll") for(int d_=0;d_<4;++d_) _Pragma("unroll") for(int r=0;r<16;++r)o[d_][r]*=wsf[crow(r,hi)]; } }while(0)
  f32x16 pA0,pA1,pB0,pB1;
  int sl_prev=0,sl_cur=0,sl_next=SLOTB;
  #define ROT() do{sl_prev=sl_cur;sl_cur=sl_next;sl_next=(sl_next==(NSLOT-1)*SLOTB)?0:sl_next+SLOTB;}while(0)
  DMA_K(2,2*SLOTB);
  const bf16x8 qf0=QF(0);
  WAIT_BAR(4);
  { const bf16x8 qq[4]={qf0,QF(1),QF(2),QF(3)}; qkt(pA0,pA1,Kbase,qq,negm,r32,hi); }asm volatile("s_nop 15\n\ts_nop 7":"+v"(pA0),"+v"(pA1));CMASK(pA0,pA1,0);
  START(pA0,pA1);
  _Pragma("unroll") for(int r=0;r<16;++r)pA1[r]=__builtin_amdgcn_exp2f(pA1[r]);
  WAIT_BAR(0);
  DMA_K(3,0);DMA_V(1,SLOTB);
  ROT();
  kload8(kf,kp0+sl_cur);
  WAIT_BAR(3);
  s16x4 vlo[8],vhi[8]; u32x4 pw0,pw1,pw2,pw3;
  #define PKW(P,B) cvtpk_s(P[B],P[B+1])
  #define PAF(k) __builtin_bit_cast(bf16x8,pw##k)
  #define VFR(i) (bf16x8){vlo[i][0],vlo[i][1],vlo[i][2],vlo[i][3],vhi[i][0],vhi[i][1],vhi[i][2],vhi[i][3]}
  #define PIN(x) asm volatile("":"+v"(x))
  #define MX3(a,b,c) __builtin_fmaxf(__builtin_fmaxf((a),(b)),(c))
  #define GAPA(MF,A0,A1,A2,A3,W0,W1,PW) do{ MF; sacc+=A0; sacc+=A1; sacc+=A2; sacc+=A3; PIN(sacc); W0; W1; PIN(PW); SBAR(); }while(0)
  #define EX(v) __builtin_amdgcn_exp2f(v)
  #define VRDF(s,f) do{ vlo[s]=vtr(vp_+(((f)>>2)*4096+((f)&3)*1024)); vhi[s]=vtr(vp_+(((f)>>2)*4096+((f)&3)*1024+512)); }while(0)
  #define KRD(G,j) do{ if(G){ kload2(kf,kp0+sl_next,j); SBAR(); } }while(0)
  #define GAPB2(MF,X,B) do{ MF; X[B]=EX(X[B]); X[B+1]=EX(X[B+1]); PIN(X); SBAR(); }while(0)
  #define MF32(a,b,c) __builtin_amdgcn_mfma_f32_32x32x16_bf16(a,b,c,0,0,0)
  #define STEP(C0,C1,P0,P1,t,GK,GV,GL) do{ SBAR(); \
    const lds_cptr vp_=vp0+2*sl_prev; bf16x8 qa,qb; \
    VRDF(0,0); qb=QF(1); SBAR(); float sacc=(P0[0]+P0[1]); \
    GAPA(C0=MF32(kf[0],qf0,negm), P0[2],P0[3],P0[4],P0[5],     pw0[0]=PKW(P0,0), pw0[1]=PKW(P0,2), pw0); \
    VRDF(1,4); SBAR(); GAPA(C1=MF32(kf[1],qf0,negm), P0[6],P0[7],P0[8],P0[9],     pw0[2]=PKW(P0,4), pw0[3]=PKW(P0,6), pw0); \
    VRDF(2,8); qa=QF(2); SBAR(); GAPA(C0=MF32(kf[2],qb,C0),   P0[10],P0[11],P0[12],P0[13], pw1[0]=PKW(P0,8), pw1[1]=PKW(P0,10), pw1); \
    VRDF(3,12); SBAR(); GAPA(C1=MF32(kf[3],qb,C1),   P0[14],P0[15],P1[0],P1[1],   pw1[2]=PKW(P0,12),pw1[3]=PKW(P0,14), pw1); \
    VRDF(4,1); qb=QF(3); SBAR(); GAPA(C0=MF32(kf[4],qa,C0),   P1[2],P1[3],P1[4],P1[5],     pw2[0]=PKW(P1,0), pw2[1]=PKW(P1,2), pw2); \
    VRDF(5,5); SBAR(); GAPA(C1=MF32(kf[5],qa,C1),   P1[6],P1[7],P1[8],P1[9],     pw2[2]=PKW(P1,4), pw2[3]=PKW(P1,6), pw2); \
    VRDF(6,9); SBAR(); GAPA(C0=MF32(kf[6],qb,C0),   P1[10],P1[11],P1[12],P1[13], pw3[0]=PKW(P1,8), pw3[1]=PKW(P1,10), pw3); \
    VRDF(7,13); SBAR(); GAPA(C1=MF32(kf[7],qb,C1),   P1[14],P1[15],0.f,0.f,       pw3[2]=PKW(P1,12),pw3[3]=PKW(P1,14), pw3); \
    l_reg+=sacc; \
    if(GK){DMA_K((t)+3,sl_cur);} if(GV){DMA_V((t)+1,sl_next);} \
    CMASK(C0,C1,t); \
    { float a=MX3(C0[0],C0[1],C1[0]),b=MX3(C0[2],C0[3],C1[1]); a=MX3(a,C1[2],C1[3]); \
      _Pragma("unroll") for(int r=4;r<16;r+=4){a=MX3(a,C0[r],C0[r+1]);b=MX3(b,C0[r+2],C0[r+3]);a=MX3(a,C1[r],C1[r+1]);b=MX3(b,C1[r+2],C1[r+3]);} \
      float rm=__builtin_fmaxf(a,b); { auto rr=__builtin_amdgcn_permlane32_swap(__float_as_uint(rm),__float_as_uint(rm),false,false); rm=__builtin_fmaxf(__uint_as_float(rr[0]),__uint_as_float(rr[1])); } \
      resc=false; \
      if(__builtin_expect(__any(rm>(float)THRL),0)){ const float dl=__builtin_fmaxf(rm,0.f); mhat+=dl; \
        _Pragma("unroll") for(int r=0;r<16;++r){C0[r]-=dl;C1[r]-=dl;} \
        _Pragma("unroll") for(int r=0;r<16;++r)negm[r]=-mhat; asm volatile("":"+v"(negm)); \
        const float f=__builtin_amdgcn_exp2f(-dl); l_reg*=f; if(hi==0)wsf[r32]=f; resc=true; } } \
    SBAR(); \
    GAPB2(o[0]=MF32(PAF(0),VFR(0),o[0]), C0,0);  VRDF(0,2);  SBAR(); \
    GAPB2(o[1]=MF32(PAF(0),VFR(1),o[1]), C0,2);  VRDF(1,6);  SBAR(); \
    KRD(GL,0); GAPB2(o[2]=MF32(PAF(0),VFR(2),o[2]), C0,4);  VRDF(2,10); SBAR(); \
    GAPB2(o[3]=MF32(PAF(0),VFR(3),o[3]), C0,6);  VRDF(3,14); SBAR(); \
    KRD(GL,1); GAPB2(o[0]=MF32(PAF(1),VFR(4),o[0]), C0,8);  VRDF(4,3);  SBAR(); \
    GAPB2(o[1]=MF32(PAF(1),VFR(5),o[1]), C0,10); VRDF(5,7);  SBAR(); \
    KRD(GL,2); GAPB2(o[2]=MF32(PAF(1),VFR(6),o[2]), C0,12); VRDF(6,11); SBAR(); \
    GAPB2(o[3]=MF32(PAF(1),VFR(7),o[3]), C0,14); VRDF(7,15); SBAR(); \
    KRD(GL,3); GAPB2(o[0]=MF32(PAF(2),VFR(0),o[0]), C1,0); \
    GAPB2(o[1]=MF32(PAF(2),VFR(1),o[1]), C1,2); \
    GAPB2(o[2]=MF32(PAF(2),VFR(2),o[2]), C1,4); \
    GAPB2(o[3]=MF32(PAF(2),VFR(3),o[3]), C1,6); \
    GAPB2(o[0]=MF32(PAF(3),VFR(4),o[0]), C1,8); \
    GAPB2(o[1]=MF32(PAF(3),VFR(5),o[1]), C1,10); \
    GAPB2(o[2]=MF32(PAF(3),VFR(6),o[2]), C1,12); \
    GAPB2(o[3]=MF32(PAF(3),VFR(7),o[3]), C1,14); \
    }while(0)
  int t=1;
  #undef CMASK
  #define CMASK(P0,P1,t) do{}while(0)
  for(;t+5<NT;t+=2){
    STEP(pB0,pB1,pA0,pA1,t,true,true,true);     WAIT_BAR(3); RESC(); ROT();
    STEP(pA0,pA1,pB0,pB1,t+1,true,true,true);   WAIT_BAR(3); RESC(); ROT();
  }
  #undef CMASK
  #define CMASK(P0,P1,t) do{int jb_=(t)-(NT-4); if(jb_>=0)cmask(P0,P1,jb_,qrel,hi);}while(0)
  #define ENDW(tt) do{ if((tt)+3<NT){WAIT_BAR(3);} else if((tt)+2<NT){WAIT_BAR(2);} else {WAIT_BAR(0);} }while(0)
  for(;t+1<NT;t+=2){
    STEP(pB0,pB1,pA0,pA1,t,(t+3<NT),(t+1<NT),(t+1<NT));       ENDW(t);   RESC(); ROT();
    STEP(pA0,pA1,pB0,pB1,t+1,(t+4<NT),(t+2<NT),(t+2<NT));     ENDW(t+1); RESC(); ROT();
  }
  STEP(pB0,pB1,pA0,pA1,NT-1,false,false,false); RESC();
  { float sacc=pB0[0]+pB0[1]; _Pragma("unroll") for(int r=2;r<16;++r)sacc+=pB0[r]; _Pragma("unroll") for(int r=0;r<16;++r)sacc+=pB1[r]; l_reg+=sacc;
    pw0=(u32x4){PKW(pB0,0),PKW(pB0,2),PKW(pB0,4),PKW(pB0,6)};pw1=(u32x4){PKW(pB0,8),PKW(pB0,10),PKW(pB0,12),PKW(pB0,14)};pw2=(u32x4){PKW(pB1,0),PKW(pB1,2),PKW(pB1,4),PKW(pB1,6)};pw3=(u32x4){PKW(pB1,8),PKW(pB1,10),PKW(pB1,12),PKW(pB1,14)};
    SBAR(); pv(o,vb0+2*sl_cur,PAF(0),PAF(1),PAF(2),PAF(3)); }
  #undef PKW
  #undef PAF
  #undef VFR
  #undef PIN
  #undef MX3
  #undef GAPA
  #undef GAPB2
  #undef MF32
  #undef EX
  #undef VRDF
  #undef KRD
  #undef STEP
  #undef ENDW
  {auto rr=__builtin_amdgcn_permlane32_swap(__float_as_uint(l_reg),__float_as_uint(l_reg),false,false);l_reg=__uint_as_float(rr[0])+__uint_as_float(rr[1]);}
  if(hi==0)wsf[32+r32]=l_reg;asm volatile("s_waitcnt lgkmcnt(0)":::"memory");
  float rli[16];
  #pragma unroll
  for(int r=0;r<16;++r)rli[r]=__builtin_amdgcn_rcpf(wsf[32+crow(r,hi)]);
  bf16*Ow=O+(long)(q0+wid*QBLK)*OP;
  { bf16*stg=(bf16*)(shm+LDS_OST)+wid*2048;
    #pragma unroll
    for(int p=0;p<2;++p){
      #pragma unroll
      for(int r=0;r<16;++r){const int orow=crow(r,hi);
        #pragma unroll
        for(int d0=0;d0<2;++d0)stg[orow*64+d0*32+r32]=__float2bfloat16(o[2*p+d0][r]*rli[r]);}
      asm volatile("s_waitcnt lgkmcnt(0)":::"memory");
      #pragma unroll
      for(int i=0;i<4;++i){const int row=i*8+(lane>>3),ch=lane&7; const u32x4 v=*(const u32x4*)(stg+row*64+ch*8); ATTN_STORE16(Ow+(long)row*OP+p*64+ch*8,v);}
      asm volatile("s_waitcnt lgkmcnt(0)":::"memory");
    } }
  asm volatile("s_waitcnt lgkmcnt(0)\n\ts_barrier":::"memory");
  #undef DMA_K
  #undef DMA_V
  #undef CMASK
  #undef START
  #undef RESC
  #undef ROT
}
constexpr int ATTN_LDS_BYTES=LDS_BYTES;
struct AttnTensors { const bf16* Q; const bf16* K; const bf16* V; bf16* O; };
struct AttnUnit { int bh; int qb; };
struct StaticOrder {
  int vcu;
  __device__ __forceinline__ explicit StaticOrder(int grid,int block):vcu((block%8)*(grid/8)+block/8){}
  __device__ __forceinline__ bool next(int i,AttnUnit&u)const{ if(i>=2)return false; const int s=vcu&15; u.bh=vcu>>4; u.qb=(i==0)?31-s:s; return true; }
  __device__ __forceinline__ void a_ready(const AttnUnit&)const{}
  __device__ __forceinline__ void done(const AttnUnit&)const{}
};
template<class Sched,int THRL=8> __device__ __forceinline__ void attn_phase(char*lds,const AttnTensors&T,const Sched&S){
  AttnUnit u;
  for(int i=0;S.next(i,u);++i){ S.a_ready(u); { const int p=u.bh;   attn_unit<THRL>(u.qb,T.Q+p*64,T.K+p*64,T.V+(p>>1)*128,T.O+(p&1)*1024+(p>>1)*128,lds); } S.done(u); }
}
#undef SBAR
#undef WAIT_BAR
}
#ifndef FILLER
#define FILLER 1
#endif
#ifndef PROBE_SLEEP
#define PROBE_SLEEP 0
#endif
#ifndef WIN_SPLIT
#define WIN_SPLIT 0
#endif
#ifndef LOCAL_BAR
#define LOCAL_BAR 1
#endif
#ifndef PROBE_DUP
#define PROBE_DUP 0
#endif
constexpr int NWAVES = 8;
constexpr int M = 8192, D = 2048, FF = 5632, NIN = 6144, DEPTH = 4;
constexpr float EPS = 1e-5f;
__device__ const float INV_FREQ[8] = {1.0f, 0.1939227432012558f, 0.03760603070259094f, 0.007292664609849453f, 0.0014142135623842478f, 0.00027424818836152554f, 5.3182957344688475e-05f, 1.0313385246263351e-05f};
__device__ const float LAM_INIT[4] = {0.2f, 0.35550906759096934f, 0.4707130183435842f, 0.5560582041556406f};
constexpr size_t MiB = 1u << 20;
constexpr size_t WS_CTL = 0, CTL_ZERO_BYTES = 3 * MiB;
constexpr size_t WS_CS = 1 * MiB;
constexpr size_t WS_SSQ = 2 * MiB;
constexpr size_t WS_W = 3 * MiB;
constexpr size_t WO_GU1 = 0, WO_D1 = 44 * MiB, WO_IN = 66 * MiB, WO_OUT = 90 * MiB, WO_GU2 = 98 * MiB, WO_D2 = 142 * MiB, W_LAYER = 164 * MiB;
constexpr size_t WS_XB = WS_W + DEPTH * W_LAYER;
constexpr size_t WS_ACT = WS_XB + 32 * MiB;
constexpr size_t WS_Q = WS_ACT + 88 * MiB, WS_K = WS_Q + 16 * MiB, WS_V = WS_K + 16 * MiB, WS_GB = WS_V + 16 * MiB, WS_CU = WS_GB + 16 * MiB;
constexpr size_t WS_O = WS_CU + 16 * MiB;
constexpr size_t WS_MIX = WS_O + 32 * MiB;
constexpr size_t WS_END = WS_MIX + 32 * MiB;
static_assert((size_t)2 * FF * D * 2 == 44 * MiB && (size_t)FF * D * 2 == 22 * MiB && (size_t)NIN * D * 2 == 24 * MiB && (size_t)D * D * 2 == 8 * MiB && (size_t)M * FF * 2 == 88 * MiB, "d_ws map");
constexpr int CW_BAR = 4096;
constexpr int RING_OFF = 0, RING_BYTES = 131072;
constexpr int LDSCTL_OFF = RING_BYTES, MISC_OFF = LDSCTL_OFF + 320;
constexpr int LDS_BYTES = 147456;
static_assert(MISC_OFF + 128 <= pg8::RSTD_OFF && pg8::RSTD_OFF == LDSCTL_OFF + 1024 && pg8::RSTD_OFF + 1024 <= LDS_BYTES, "LDS map");
#define GAS __attribute__((address_space(1)))
#define LAS __attribute__((address_space(3)))
typedef unsigned short bf16;
typedef unsigned v4u __attribute__((ext_vector_type(4)));
typedef float f32x4 __attribute__((ext_vector_type(4)));
typedef short bf16x8 __attribute__((ext_vector_type(8)));
typedef GAS unsigned gu32;
typedef GAS unsigned long long gu64;
#define RLX_AGENT __ATOMIC_RELAXED, __HIP_MEMORY_SCOPE_AGENT
#define LDS_WAIT() asm volatile("s_waitcnt lgkmcnt(0)" ::: "memory")
#define VM_WAIT() asm volatile("s_waitcnt vmcnt(0)" ::: "memory")
__device__ __forceinline__ unsigned long long rt() { return __builtin_amdgcn_s_memrealtime(); }
__device__ __forceinline__ unsigned f2bf(float f) { unsigned u = __builtin_bit_cast(unsigned, f); return (u + 0x7fffu + ((u >> 16) & 1u)) >> 16; }
__device__ __forceinline__ unsigned pk2(float lo, float hi) { return f2bf(lo) | (f2bf(hi) << 16); }

#define XB_TMO      128
#define XB_XCNT(j)  (256  + 64 * (j))
#define XB_XSUB(j)  (1280 + 64 * (j))
#define XB_XGEN(j)  (2304 + 64 * (j))
#define XB_TOP      3328
#define XB_TOPGEN   3392
#define XCD_BAR_WORDS 3456
#define XB_SPIN_CAP (1u << 18)

__device__ __forceinline__ unsigned xb_ld(unsigned* p)              { return __hip_atomic_load(p, __ATOMIC_RELAXED, __HIP_MEMORY_SCOPE_AGENT); }
__device__ __forceinline__ unsigned xb_add(unsigned* p, unsigned v) { return __hip_atomic_fetch_add(p, v, __ATOMIC_RELAXED, __HIP_MEMORY_SCOPE_AGENT); }
__device__ __forceinline__ unsigned xb_xcc_id() { return (unsigned)__builtin_amdgcn_s_getreg((3 << 11) | 20) & 0xFu; }
#define XB_SPIN(cond, bar) do { unsigned _sp = 0; while (cond) { __builtin_amdgcn_s_sleep(1); \
    if ((++_sp & 255u) == 0u) { if (xb_ld(&(bar)[XB_TMO])) break; if (_sp > XB_SPIN_CAP) { atomicAdd(&(bar)[XB_TMO], 1u); break; } } } } while (0)

struct XcdBarrier {
    unsigned* bar; unsigned x;
    volatile LAS unsigned* st;
};

__device__ __forceinline__ XcdBarrier xcd_barrier_post(unsigned* bar, volatile LAS unsigned* st) {
    XcdBarrier b; b.bar = bar; b.x = xb_xcc_id(); b.st = st;
    if (threadIdx.x == 0) (void)xb_add(&bar[XB_XCNT(b.x)], 1u);
    return b;
}
__device__ __forceinline__ void xcd_barrier_complete(unsigned* bar, unsigned x, unsigned& nloc, unsigned& nx) {
    const unsigned G = gridDim.x * gridDim.y * gridDim.z;
    unsigned sum, cnt, mine, sp = 0u;
    for (;;) {
        sum = 0u; cnt = 0u; mine = 0u;
#pragma unroll
        for (unsigned j = 0; j < 16; ++j) { const unsigned c = xb_ld(&bar[XB_XCNT(j)]); sum += c; cnt += (c > 0u) ? 1u : 0u; mine = (j == x) ? c : mine; }
        if (sum == G) break;
        __builtin_amdgcn_s_sleep(1);
        if ((++sp & 255u) == 0u) { if (xb_ld(&bar[XB_TMO])) break; if (sp > XB_SPIN_CAP) { atomicAdd(&bar[XB_TMO], 1u); break; } }
    }
    nloc = mine > 0u ? mine : 1u; nx = cnt > 0u ? cnt : 1u;
}

__device__ __forceinline__ void xcd_barrier(const XcdBarrier& b) {
    asm volatile("s_waitcnt vmcnt(0)" ::: "memory");
    __syncthreads();
    if (threadIdx.x == 0) {
        unsigned* bar = b.bar;
        __builtin_amdgcn_s_waitcnt(0);
        unsigned nloc = b.st[0], nx = b.st[1];
        if (nloc == 0u) { xcd_barrier_complete(bar, b.x, nloc, nx); b.st[0] = nloc; b.st[1] = nx; }
        const unsigned old = xb_add(&bar[XB_XSUB(b.x)], 1u);
        const unsigned gen = old / nloc;
        if (old + 1u == (gen + 1u) * nloc) {
            __builtin_amdgcn_fence(__ATOMIC_RELEASE, "agent");
            asm volatile("s_waitcnt vmcnt(0)" ::: "memory");
            const unsigned og = xb_add(&bar[XB_TOP], 1u);
            const unsigned tg = og / nx;
            if (og + 1u == (tg + 1u) * nx) xb_add(&bar[XB_TOPGEN], 1u);
            else XB_SPIN(xb_ld(&bar[XB_TOPGEN]) == tg, bar);
            __builtin_amdgcn_fence(__ATOMIC_ACQUIRE, "agent");
            xb_add(&bar[XB_XGEN(b.x)], 1u);
            asm volatile("s_waitcnt vmcnt(0)" ::: "memory");
        } else {
            XB_SPIN(xb_ld(&bar[XB_XGEN(b.x)]) == gen, bar);
            __builtin_amdgcn_fence(__ATOMIC_ACQUIRE, "agent");
            asm volatile("s_waitcnt vmcnt(0)" ::: "memory");
        }
    }
    __syncthreads();
}

#define XB_LSUB(j)  (3456 + 64 * (j))
#define XB_LGEN(j)  (4480 + 64 * (j))
__device__ __forceinline__ void xcd_barrier_local(const XcdBarrier& b) {
    asm volatile("s_waitcnt vmcnt(0)" ::: "memory");
    __syncthreads();
    if (threadIdx.x == 0) {
        unsigned* bar = b.bar; const unsigned nloc = b.st[0];
        const unsigned old = xb_add(&bar[XB_LSUB(b.x)], 1u); const unsigned gen = old / nloc;
        if (old + 1u == (gen + 1u) * nloc) xb_add(&bar[XB_LGEN(b.x)], 1u);
        else XB_SPIN(xb_ld(&bar[XB_LGEN(b.x)]) == gen, bar);
        __builtin_amdgcn_fence(__ATOMIC_ACQUIRE, "agent");
        asm volatile("s_waitcnt vmcnt(0)" ::: "memory");
    }
    __syncthreads();
}

struct Frame {
    LAS unsigned char* lds;
    volatile LAS unsigned* MISC;
    gu32* ctl;
    int tid, lane, wave;
    int vcu, G;
};

__device__ __forceinline__ float shx(float v, int lane, int mask) { return __int_as_float(__builtin_amdgcn_ds_bpermute((lane ^ mask) << 2, __float_as_int(v))); }
__device__ __forceinline__ float wave_sum(float v, int lane) {
#pragma unroll
    for (int o = 1; o < 64; o <<= 1) v += shx(v, lane, o);
    return v;
}
__device__ __forceinline__ float bflo(unsigned w) { return __uint_as_float(w << 16); }
__device__ __forceinline__ float bfhi(unsigned w) { return __uint_as_float(w & 0xffff0000u); }

__device__ __forceinline__ int dst_row(int kind, int ns) {
    if (kind == 0) return ns;
    if (kind == 1) return 256 * (ns >> 7) + (ns & 127);
    if (kind == 2) return 256 * (ns >> 7) + 128 + (ns & 127);
    if (ns < 2048) { const int d = ns & 63; const int c = d < 8 ? 2 * d : d < 16 ? 2 * (d - 8) + 1 : d; return (ns & ~63) + c; }
    if (ns < 4096) return ns;
    if (ns < 5120) { const int j = ns - 4096; return 4096 + 256 * (j >> 7) + (j & 127); }
    { const int j = ns - 5120; return 4096 + 256 * (j >> 7) + 128 + (j & 127); }
}
struct CvtItem { const float* W; bf16* WT; const float* gain; int K, N, kind, r; };
__device__ __forceinline__ void cvt_load(const CvtItem& c, int lane, float (&t)[32]) {
    const int nblk = c.N / 32, kb = c.r / nblk, nb = c.r % nblk;
    const float* src = c.W + (size_t)(64 * kb + (lane >> 5)) * c.N + 32 * nb + (lane & 31);
#pragma unroll
    for (int i = 0; i < 32; ++i) t[i] = __builtin_nontemporal_load(src + (size_t)(2 * i) * c.N);
}
__device__ __forceinline__ void cvt_store(const CvtItem& c, int lane, LAS float* scr) {
    const int nblk = c.N / 32, kb = c.r / nblk, nb = c.r % nblk, k0 = 64 * kb, n0 = 32 * nb;
    const int ch = lane & 7;
    f32x4 ga = (f32x4){1.f, 1.f, 1.f, 1.f}, gb = ga;
    if (c.gain) { ga = *(const f32x4*)(c.gain + k0 + 8 * ch); gb = *(const f32x4*)(c.gain + k0 + 8 * ch + 4); }
#pragma unroll
    for (int j = 0; j < 4; ++j) { const int n = (lane >> 3) + 8 * j; const LAS float* s = scr + (8 * ch) * 33 + n;
        v4u o; o.x = pk2(s[0 * 33] * ga[0], s[1 * 33] * ga[1]); o.y = pk2(s[2 * 33] * ga[2], s[3 * 33] * ga[3]); o.z = pk2(s[4 * 33] * gb[0], s[5 * 33] * gb[1]); o.w = pk2(s[6 * 33] * gb[2], s[7 * 33] * gb[3]);
        *(GAS v4u*)(c.WT + (size_t)dst_row(c.kind, n0 + n) * c.K + k0 + 8 * ch) = o; }
}

__device__ __forceinline__ void stats_phase(Frame& F, const float* x, bf16* XB, unsigned long long* SSQ) {
    const int gw = F.vcu * NWAVES + F.wave, NGW = F.G * NWAVES;
    for (int m = gw; m < M; m += NGW) {
        const float* xr = x + (size_t)m * D; f32x4 v[8]; float s = 0.f;
#pragma unroll
        for (int j = 0; j < 4; ++j) { v[2 * j] = *(const GAS f32x4*)(xr + 512 * j + 8 * F.lane); v[2 * j + 1] = *(const GAS f32x4*)(xr + 512 * j + 8 * F.lane + 4); }
#pragma unroll
        for (int j = 0; j < 8; ++j) s += (v[j].x * v[j].x + v[j].y * v[j].y) + (v[j].z * v[j].z + v[j].w * v[j].w);
        s = wave_sum(s, F.lane);
        if (F.lane == 0) SSQ[m] = (unsigned long long)(s * 16777216.0f);
        bf16* hr = XB + (size_t)m * D;
#pragma unroll
        for (int j = 0; j < 4; ++j) { const f32x4 a = v[2 * j], b = v[2 * j + 1];
            v4u o; o.x = pk2(a.x, a.y); o.y = pk2(a.z, a.w); o.z = pk2(b.x, b.y); o.w = pk2(b.z, b.w);
            *(GAS v4u*)(hr + 512 * j + 8 * F.lane) = o; }
    }
}
__device__ __forceinline__ void final_norm_phase(Frame& F, const bf16* xb, const float* g, float* out) {
    const int gw = F.vcu * NWAVES + F.wave, NGW = F.G * NWAVES;
    f32x4 gv[8];
#pragma unroll
    for (int j = 0; j < 4; ++j) { gv[2 * j] = *(const f32x4*)(g + 512 * j + 8 * F.lane); gv[2 * j + 1] = *(const f32x4*)(g + 512 * j + 8 * F.lane + 4); }
    for (int m = gw; m < M; m += NGW) {
        v4u v[4]; float s = 0.f;
#pragma unroll
        for (int j = 0; j < 4; ++j) v[j] = *(const GAS v4u*)(xb + (size_t)m * D + 512 * j + 8 * F.lane);
#pragma unroll
        for (int j = 0; j < 4; ++j)
#pragma unroll
            for (int q = 0; q < 4; ++q) { const float lo = bflo(v[j][q]), hi = bfhi(v[j][q]); s += lo * lo + hi * hi; }
        const float rstd = 1.0f / sqrtf(wave_sum(s, F.lane) * (1.f / D) + EPS);
        float* orow = out + (size_t)m * D;
#pragma unroll
        for (int j = 0; j < 4; ++j) {
            const f32x4 a = (f32x4){bflo(v[j][0]), bfhi(v[j][0]), bflo(v[j][1]), bfhi(v[j][1])} * rstd * gv[2 * j], b = (f32x4){bflo(v[j][2]), bfhi(v[j][2]), bflo(v[j][3]), bfhi(v[j][3])} * rstd * gv[2 * j + 1];
            *(GAS f32x4*)(orow + 512 * j + 8 * F.lane) = a; *(GAS f32x4*)(orow + 512 * j + 8 * F.lane + 4) = b; }
    }
}
__device__ __forceinline__ void fin_phase(Frame& F, const bf16* O, const bf16* GB, const bf16* CU, bf16* MIX, const float* lq1, const float* lk1, const float* lq2, const float* lk2,
                                          const float* subw, const float* convw, float lam_init) {
    const int gw = F.vcu * NWAVES + F.wave, NGW = F.G * NWAVES, lane = F.lane;
    const float lam = expf(wave_sum(lq1[lane] * lk1[lane], lane)) - expf(wave_sum(lq2[lane] * lk2[lane], lane)) + lam_init;
    const float om = 1.0f - lam_init;
    const int c0 = 16 * lane;
    float sw[16], w0[16], w1[16], w2[16];
#pragma unroll
    for (int j = 0; j < 16; ++j) { sw[j] = subw[(c0 & 127) + j] * om; w0[j] = convw[c0 + j]; w1[j] = convw[1024 + c0 + j]; w2[j] = convw[2048 + c0 + j]; }
    for (int mb = 512 * (gw >> 8) + (gw & 255); mb < 512 * (gw >> 8) + 512; mb += 256) {
        v4u a0[2], a1[2], b0[2], b1[2], g0[2], g1[2], x0[2], x1[2], y0[2], y1[2], u0[2], u1[2];
        const v4u z = (v4u){0u, 0u, 0u, 0u};
#pragma unroll
        for (int k = 0; k < 2; ++k) { const int m = 2 * mb + k;
            a0[k] = *(const GAS v4u*)(O + (size_t)m * 2048 + c0); a1[k] = *(const GAS v4u*)(O + (size_t)m * 2048 + c0 + 8);
            b0[k] = *(const GAS v4u*)(O + (size_t)m * 2048 + 1024 + c0); b1[k] = *(const GAS v4u*)(O + (size_t)m * 2048 + 1024 + c0 + 8);
            g0[k] = *(const GAS v4u*)(GB + (size_t)m * 1024 + c0); g1[k] = *(const GAS v4u*)(GB + (size_t)m * 1024 + c0 + 8);
            x0[k] = *(const GAS v4u*)(CU + (size_t)m * 1024 + c0); x1[k] = *(const GAS v4u*)(CU + (size_t)m * 1024 + c0 + 8); }
        y0[1] = x0[0]; y1[1] = x1[0];
        y0[0] = mb >= 1 ? *(const GAS v4u*)(CU + (size_t)(2 * mb - 1) * 1024 + c0) : z; y1[0] = mb >= 1 ? *(const GAS v4u*)(CU + (size_t)(2 * mb - 1) * 1024 + c0 + 8) : z;
        u0[1] = y0[0]; u1[1] = y1[0];
        u0[0] = mb >= 1 ? *(const GAS v4u*)(CU + (size_t)(2 * mb - 2) * 1024 + c0) : z; u1[0] = mb >= 1 ? *(const GAS v4u*)(CU + (size_t)(2 * mb - 2) * 1024 + c0 + 8) : z;
#pragma unroll
        for (int k = 0; k < 2; ++k) { const int m = 2 * mb + k;
            float d[16]; float ss = 0.f;
#pragma unroll
            for (int q = 0; q < 4; ++q) { d[2 * q] = bflo(a0[k][q]) - lam * bflo(b0[k][q]); d[2 * q + 1] = bfhi(a0[k][q]) - lam * bfhi(b0[k][q]); d[8 + 2 * q] = bflo(a1[k][q]) - lam * bflo(b1[k][q]); d[8 + 2 * q + 1] = bfhi(a1[k][q]) - lam * bfhi(b1[k][q]); }
#pragma unroll
            for (int j = 0; j < 16; ++j) ss += d[j] * d[j];
            ss += shx(ss, lane, 1); ss += shx(ss, lane, 2); ss += shx(ss, lane, 4);
            const float rs = 1.0f / sqrtf(ss * (1.f / 128.f) + EPS);
            v4u o0, o1;
#pragma unroll
            for (int q = 0; q < 4; ++q) { o0[q] = pk2(d[2 * q] * rs * sw[2 * q], d[2 * q + 1] * rs * sw[2 * q + 1]); o1[q] = pk2(d[8 + 2 * q] * rs * sw[8 + 2 * q], d[8 + 2 * q + 1] * rs * sw[8 + 2 * q + 1]); }
            *(GAS v4u*)(MIX + (size_t)m * 2048 + c0) = o0; *(GAS v4u*)(MIX + (size_t)m * 2048 + c0 + 8) = o1;
            v4u p0, p1;
#pragma unroll
            for (int q = 0; q < 4; ++q) {
                const float e0 = bflo(g0[k][q]) * (w0[2 * q] * bflo(u0[k][q]) + w1[2 * q] * bflo(y0[k][q]) + w2[2 * q] * bflo(x0[k][q]));
                const float e1 = bfhi(g0[k][q]) * (w0[2 * q + 1] * bfhi(u0[k][q]) + w1[2 * q + 1] * bfhi(y0[k][q]) + w2[2 * q + 1] * bfhi(x0[k][q]));
                const float e2 = bflo(g1[k][q]) * (w0[8 + 2 * q] * bflo(u1[k][q]) + w1[8 + 2 * q] * bflo(y1[k][q]) + w2[8 + 2 * q] * bflo(x1[k][q]));
                const float e3 = bfhi(g1[k][q]) * (w0[8 + 2 * q + 1] * bfhi(u1[k][q]) + w1[8 + 2 * q + 1] * bfhi(y1[k][q]) + w2[8 + 2 * q + 1] * bfhi(x1[k][q]));
                p0[q] = pk2(e0, e1); p1[q] = pk2(e2, e3); }
            *(GAS v4u*)(MIX + (size_t)m * 2048 + 1024 + c0) = p0; *(GAS v4u*)(MIX + (size_t)m * 2048 + 1024 + c0 + 8) = p1; }
    }
}

struct Args { const float* in[19]; float* out; unsigned char* ws; };
typedef const __attribute__((address_space(4))) Args* cargs_t;
__device__ __forceinline__ cargs_t get_args() { cargs_t p = (cargs_t)__builtin_amdgcn_kernarg_segment_ptr(); asm volatile("" : "+s"(p)); return p; }
__device__ __forceinline__ int bid_o() { int b = (int)__builtin_amdgcn_readfirstlane((int)*(volatile LAS unsigned*)(size_t)(MISC_OFF + 40)); asm volatile("" : "+s"(b)); return b; }
__device__ __forceinline__ int gdim_o() { int g = gridDim.x; asm volatile("" : "+s"(g)); return g; }
__device__ __forceinline__ void make_frame(Frame& F, unsigned char* lds) {
    F.lds = (LAS unsigned char*)lds; F.MISC = (volatile LAS unsigned*)(F.lds + MISC_OFF);
    { int t_ = threadIdx.x; asm volatile("" : "+v"(t_)); F.tid = t_; } F.lane = F.tid & 63; F.wave = __builtin_amdgcn_readfirstlane(F.tid >> 6);
    F.G = gdim_o(); { const int bx = bid_o(); F.vcu = (F.G % 8 == 0) ? (bx % 8) * (F.G / 8) + bx / 8 : bx; }
    F.ctl = (gu32*)(get_args()->ws + WS_CTL);
}
__device__ __forceinline__ void grid_bar(unsigned char* lds) {
    XcdBarrier b; b.bar = (unsigned*)(get_args()->ws + WS_CTL) + CW_BAR; b.x = xb_xcc_id(); b.st = (volatile LAS unsigned*)((LAS unsigned char*)lds + MISC_OFF) + 8;
    xcd_barrier(b);
#if PROBE_BAR2
    xcd_barrier(b);
#endif
#if PROBE_SLEEP
    { const unsigned long long t0 = __builtin_amdgcn_s_memrealtime(); while (__builtin_amdgcn_s_memrealtime() - t0 < 1000ull) __builtin_amdgcn_s_sleep(32); }
#endif
}
__device__ __forceinline__ void grid_bar_local(unsigned char* lds) {
#if LOCAL_BAR
    if (*((volatile LAS unsigned*)((LAS unsigned char*)lds + MISC_OFF) + 11) == 0u) { grid_bar(lds); return; }
    XcdBarrier b; b.bar = (unsigned*)(get_args()->ws + WS_CTL) + CW_BAR; b.x = xb_xcc_id(); b.st = (volatile LAS unsigned*)((LAS unsigned char*)lds + MISC_OFF) + 8;
    xcd_barrier_local(b);
#else
    grid_bar(lds);
#endif
}
__device__ __forceinline__ unsigned char* wlayer(cargs_t a, int l) { return a->ws + WS_W + (size_t)l * W_LAYER; }

constexpr int I_G = (D / 64) * (FF / 32), I_D = (FF / 64) * (D / 32), I_IN = (D / 64) * (NIN / 32), I_OUT = (D / 64) * (D / 32), I_LAYER = 4 * I_G + 2 * I_D + I_IN + I_OUT;
constexpr int CVT_B0 = 2 * I_G, CVT_UP2 = 4 * I_G + I_D + I_IN + I_OUT;
__device__ __forceinline__ int cvt_end(int s) { const int e = CVT_UP2 + s * (I_LAYER / 2); return e < DEPTH * I_LAYER ? e : DEPTH * I_LAYER; }
__device__ __forceinline__ void cvt_decode(cargs_t a, int l, int it, CvtItem& c) {
    unsigned char* wl = a->ws + WS_W + (size_t)l * W_LAYER; int r = it;
    if (r < I_G) { c = CvtItem{a->in[2] + (size_t)l * D * FF, (bf16*)(wl + WO_GU1), a->in[1] + (size_t)l * D, D, FF, 1, r}; return; } r -= I_G;
    if (r < I_G) { c = CvtItem{a->in[3] + (size_t)l * D * FF, (bf16*)(wl + WO_GU1), a->in[1] + (size_t)l * D, D, FF, 2, r}; return; } r -= I_G;
    if (r < I_D) { c = CvtItem{a->in[4] + (size_t)l * FF * D, (bf16*)(wl + WO_D1), nullptr, FF, D, 0, r}; return; } r -= I_D;
    if (r < I_IN) { c = CvtItem{a->in[6] + (size_t)l * D * NIN, (bf16*)(wl + WO_IN), a->in[5] + (size_t)l * D, D, NIN, 3, r}; return; } r -= I_IN;
    if (r < I_OUT) { c = CvtItem{a->in[13] + (size_t)l * D * D, (bf16*)(wl + WO_OUT), nullptr, D, D, 0, r}; return; } r -= I_OUT;
    if (r < I_G) { c = CvtItem{a->in[15] + (size_t)l * D * FF, (bf16*)(wl + WO_GU2), a->in[14] + (size_t)l * D, D, FF, 1, r}; return; } r -= I_G;
    if (r < I_G) { c = CvtItem{a->in[16] + (size_t)l * D * FF, (bf16*)(wl + WO_GU2), a->in[14] + (size_t)l * D, D, FF, 2, r}; return; } r -= I_G;
    c = CvtItem{a->in[17] + (size_t)l * FF * D, (bf16*)(wl + WO_D2), nullptr, FF, D, 0, r};
}
__device__ __forceinline__ void convert_items(unsigned char* lds, int lo, int hi, int worker, int nworkers) {
    Frame F; make_frame(F, lds); cargs_t a = get_args();
    LAS float* scr = (LAS float*)(F.lds + RING_OFF + F.wave * 16384);
    int it = lo + worker; if (it >= hi) return;
    CvtItem cur, nxt; float t[32];
    cvt_decode(a, it / I_LAYER, it % I_LAYER, cur); cvt_load(cur, F.lane, t);
    for (;;) {
#pragma unroll
        for (int i = 0; i < 32; ++i) scr[(2 * i + (F.lane >> 5)) * 33 + (F.lane & 31)] = t[i];
        LDS_WAIT(); asm volatile("" ::: "memory");
        const int ni = it + nworkers; const bool more = ni < hi;
        if (more) { cvt_decode(a, ni / I_LAYER, ni % I_LAYER, nxt); cvt_load(nxt, F.lane, t); }
        cvt_store(cur, F.lane, scr);
        LDS_WAIT(); asm volatile("" ::: "memory");
        if (!more) break;
        cur = nxt; it = ni;
    }
}
__device__ __forceinline__ void ph_prologue(unsigned char* lds) {
    Frame F; make_frame(F, lds);
    convert_items(lds, 0, FILLER ? CVT_B0 : DEPTH * I_LAYER, F.vcu * NWAVES + F.wave, F.G * NWAVES);
    cargs_t a = get_args(); unsigned char* ws = a->ws;
    float* CS = (float*)(ws + WS_CS);
    for (int i = bid_o() * (NWAVES * 64) + F.tid; i < M * 8; i += F.G * NWAVES * 64) {
        const int pos = i >> 3, fi = i & 7; const float ang = (float)pos * INV_FREQ[fi];
        CS[(size_t)pos * 16 + fi] = cosf(ang); CS[(size_t)pos * 16 + 8 + fi] = sinf(ang); }
    stats_phase(F, a->in[0], (bf16*)(ws + WS_XB), (unsigned long long*)(ws + WS_SSQ));
}
__device__ __forceinline__ void ph_gateup(unsigned char* lds, int l, int second) {
    { cargs_t a = get_args(); unsigned char* ws = a->ws;
      pg8::Gemm g{(const bf16*)(ws + WS_XB), (const bf16*)(wlayer(a, l) + (second ? WO_GU2 : WO_GU1)), M, 2 * FF, D}; pg8::StaticOrder S; S.init(M, 2 * FF, gdim_o(), bid_o());
      pg8::EpiSwiGLU E{(bf16*)(ws + WS_ACT), FF, (const unsigned long long*)(ws + WS_SSQ) + (3 * l + (second ? 2 : 0)) * M};
      pg8::gemm_phase<pg8::EpiSwiGLU, pg8::StaticOrder, PG8_ALIGN, PG8_SP2>((LAS unsigned char*)lds + RING_OFF, g, S, E); }
    const int bx = bid_o();
    if (FILLER && bx >= 128 && gdim_o() == 256) {
        int t_ = threadIdx.x; asm volatile("" : "+v"(t_)); const int wave = __builtin_amdgcn_readfirstlane(t_ >> 6);
        const int s = 2 * l + second;
        convert_items(lds, s == 0 ? CVT_B0 : cvt_end(s - 1), cvt_end(s), (bx - 128) * NWAVES + wave, 128 * NWAVES);
#if PROBE_DUP == 5
        convert_items(lds, s == 0 ? CVT_B0 : cvt_end(s - 1), cvt_end(s), (bx - 128) * NWAVES + wave, 128 * NWAVES);
#endif
    }
}
__device__ __forceinline__ void ph_down(unsigned char* lds, int l, int second, int dummy = 0) {
    cargs_t a = get_args(); unsigned char* ws = a->ws;
    pg8::Gemm g{(const bf16*)(ws + WS_ACT), (const bf16*)(wlayer(a, l) + (second ? WO_D2 : WO_D1)), M, D, FF}; pg8::StaticOrder S; S.init(M, D, gdim_o(), bid_o());
    pg8::EpiResidual E{(bf16*)(ws + WS_XB), D, 0.5f, (unsigned long long*)(ws + WS_SSQ) + (3 * l + (second ? 3 : 1)) * M};
    pg8::gemm_phase<pg8::EpiResidual, pg8::StaticOrder, PG8_ALIGN1, PG8_SP2>((LAS unsigned char*)lds + RING_OFF, g, S, E);
}
template <int MODE> __device__ __forceinline__ void ph_win_part(unsigned char* lds, int l) {
    cargs_t a = get_args(); unsigned char* ws = a->ws;
    pg8::Gemm g{(const bf16*)(ws + WS_XB), (const bf16*)(wlayer(a, l) + WO_IN) + (size_t)MODE * 2048 * D, M, D, D}; pg8::StaticOrder S; S.init(M, D, gdim_o(), bid_o());
    pg8::EpiWin<MODE> E{(bf16*)(ws + (MODE == 0 ? WS_Q : MODE == 1 ? WS_V : WS_CU)), (bf16*)(ws + (MODE == 0 ? WS_K : WS_GB)), (const float*)(ws + WS_CS), attn_body::C2, (const unsigned long long*)(ws + WS_SSQ) + (3 * l + 1) * M};
    pg8::gemm_phase<pg8::EpiWin<MODE>, pg8::StaticOrder, PG8_ALIGN, PG8_SP2>((LAS unsigned char*)lds + RING_OFF, g, S, E);
}
#if WIN_SPLIT
__device__ __forceinline__ void ph_win(unsigned char* lds, int l) { ph_win_part<0>(lds, l); ph_win_part<1>(lds, l); ph_win_part<2>(lds, l); }
#else
__device__ __forceinline__ void ph_win(unsigned char* lds, int l) {
    cargs_t a = get_args(); unsigned char* ws = a->ws;
    const bf16* W = (const bf16*)(wlayer(a, l) + WO_IN);
    pg8::Gemm g{(const bf16*)(ws + WS_XB), W, M, D, D}; pg8::StaticOrder S; S.init(M, D, gdim_o(), bid_o());
    const float* cs = (const float*)(ws + WS_CS); const unsigned long long* ssq = (const unsigned long long*)(ws + WS_SSQ) + (3 * l + 1) * M;
    pg8::EpiWin<0> E0{(bf16*)(ws + WS_Q), (bf16*)(ws + WS_K), cs, attn_body::C2, ssq};
    pg8::EpiWin<1> E1{(bf16*)(ws + WS_V), (bf16*)(ws + WS_GB), cs, attn_body::C2, ssq};
    pg8::EpiWin<2> E2{(bf16*)(ws + WS_CU), (bf16*)(ws + WS_GB), cs, attn_body::C2, ssq};
    const bf16* W1 = W + (size_t)2048 * D; const bf16* W2 = W + (size_t)4096 * D;
    asm volatile("" : "+s"(W1), "+s"(W2));
    pg8::gemm_phase3<pg8::EpiWin<0>, pg8::EpiWin<1>, pg8::EpiWin<2>, pg8::StaticOrder, PG8_ALIGN, PG8_SP2>((LAS unsigned char*)lds + RING_OFF, g, W1, W2, S, E0, E1, E2);
}

#endif
__device__ __forceinline__ void ph_attn(unsigned char* lds) {
    unsigned char* ws = get_args()->ws;
    const attn_body::AttnTensors AT{(const attn_body::bf16*)(ws + WS_Q), (const attn_body::bf16*)(ws + WS_K), (const attn_body::bf16*)(ws + WS_V), (attn_body::bf16*)(ws + WS_O)};
    const attn_body::StaticOrder S(gdim_o(), bid_o());
    attn_body::attn_phase<attn_body::StaticOrder>((char*)lds + RING_OFF, AT, S);
}
__device__ __forceinline__ void ph_fin(unsigned char* lds, int l) {
    Frame F; make_frame(F, lds); cargs_t a = get_args(); unsigned char* ws = a->ws;
    fin_phase(F, (const bf16*)(ws + WS_O), (const bf16*)(ws + WS_GB), (const bf16*)(ws + WS_CU), (bf16*)(ws + WS_MIX), a->in[8] + l * 64, a->in[9] + l * 64, a->in[10] + l * 64, a->in[11] + l * 64,
              a->in[12] + l * 128, a->in[7] + (size_t)l * 3 * 1024, LAM_INIT[l]);
}
__device__ __forceinline__ void ph_wout(unsigned char* lds, int l) {
    cargs_t a = get_args(); unsigned char* ws = a->ws;
    pg8::Gemm g{(const bf16*)(ws + WS_MIX), (const bf16*)(wlayer(a, l) + WO_OUT), M, D, D}; pg8::StaticOrder S; S.init(M, D, gdim_o(), bid_o());
    pg8::EpiResidual E{(bf16*)(ws + WS_XB), D, 1.0f, (unsigned long long*)(ws + WS_SSQ) + (3 * l + 2) * M};
    pg8::gemm_phase<pg8::EpiResidual, pg8::StaticOrder, PG8_ALIGN1, PG8_SP2>((LAS unsigned char*)lds + RING_OFF, g, S, E);
}
__device__ __forceinline__ void ph_final(unsigned char* lds) {
    Frame F; make_frame(F, lds); cargs_t a = get_args();
    final_norm_phase(F, (const bf16*)(a->ws + WS_XB), a->in[18], a->out);
}

__global__ void __launch_bounds__(NWAVES * 64, 2) mk_fwd(Args args) {
    extern __shared__ __attribute__((aligned(16))) unsigned char lds[];
    for (int u = threadIdx.x; u < (LDS_BYTES - LDSCTL_OFF) / 4; u += NWAVES * 64) ((LAS unsigned*)((LAS unsigned char*)lds + LDSCTL_OFF))[u] = 0u;
    __syncthreads();
    { volatile LAS unsigned* MISC = (volatile LAS unsigned*)((LAS unsigned char*)lds + MISC_OFF);
      if (threadIdx.x == 0) { unsigned* bar = (unsigned*)(get_args()->ws + WS_CTL) + CW_BAR; MISC[12] = xb_add(&bar[XB_XCNT(xb_xcc_id())], 1u); MISC[10] = blockIdx.x; }
      __syncthreads(); }
    ph_prologue(lds);
    grid_bar(lds);
    { volatile LAS unsigned* MISC = (volatile LAS unsigned*)((LAS unsigned char*)lds + MISC_OFF);
      if (threadIdx.x == 0) { unsigned* bar = (unsigned*)(get_args()->ws + WS_CTL) + CW_BAR; const unsigned x = xb_xcc_id(); bool ok = gridDim.x == 256u; unsigned npop = 0u, below = 0u;
          for (unsigned j = 0; j < 16u; ++j) { const unsigned c = xb_ld(&bar[XB_XCNT(j)]); if (c != 0u && c != 32u) ok = false; if (c == 32u) { ++npop; if (j < x) ++below; } }
          if (ok && npop == 8u && LOCAL_BAR) { MISC[10] = MISC[12] * 8u + below; MISC[11] = 1u; } }
      __syncthreads(); }
#if PROBE_DUP == 4
    ph_prologue(lds);
    grid_bar(lds);
#endif
#pragma unroll 1
    for (int l = 0; l < DEPTH; ++l) {
        ph_gateup(lds, l, 0); grid_bar(lds);
#if PROBE_DUP == 1
        ph_gateup(lds, l, 0); grid_bar(lds);
#endif
        ph_down(lds, l, 0); grid_bar_local(lds);
        ph_win(lds, l); grid_bar(lds);
#if PROBE_DUP == 3
        ph_win(lds, l); grid_bar(lds);
#endif
        ph_attn(lds); grid_bar(lds);
#if PROBE_DUP == 2
        ph_attn(lds); grid_bar(lds);
#endif
        ph_fin(lds, l); grid_bar_local(lds);
        ph_wout(lds, l); grid_bar_local(lds);
        ph_gateup(lds, l, 1); grid_bar(lds);
        ph_down(lds, l, 1); if (l + 1 < DEPTH) grid_bar_local(lds); else grid_bar(lds);
    }
    ph_final(lds);
}

extern "C" void kernel_launch(void* const* d_in, const int* in_sizes, int n_in, void* d_out, int out_size, void* d_ws, size_t ws_size, hipStream_t stream) {
    static int grid = 0;
    if (grid == 0) {
        if (n_in != 19 || in_sizes[0] != M * D || out_size != M * D || ws_size < WS_END) { fprintf(stderr, "kernel_launch: built for 19 inputs, x and out of %d floats, >= %zu bytes of workspace; got n_in %d, in0 %d, out %d, ws %zu; nothing launched\n", M * D, (size_t)WS_END, n_in, n_in > 0 ? in_sizes[0] : -1, out_size, ws_size); grid = -1; return; }
        int dev = 0, cus = 0, per_cu = 0;
        if (hipGetDevice(&dev) != hipSuccess || hipDeviceGetAttribute(&cus, hipDeviceAttributeMultiprocessorCount, dev) != hipSuccess) { fprintf(stderr, "kernel_launch: hipGetDevice / hipDeviceGetAttribute failed; nothing launched\n"); grid = -1; return; }
        if (hipFuncSetAttribute((const void*)mk_fwd, hipFuncAttributeMaxDynamicSharedMemorySize, LDS_BYTES) != hipSuccess) { fprintf(stderr, "kernel_launch: hipFuncSetAttribute failed\n"); grid = -1; return; }
        if (hipOccupancyMaxActiveBlocksPerMultiprocessor(&per_cu, (const void*)mk_fwd, NWAVES * 64, LDS_BYTES) != hipSuccess || per_cu < 1)
            fprintf(stderr, "kernel_launch: note: the occupancy query reports %d workgroups per CU\n", per_cu);
        (void)hipGetLastError();
        grid = 256;
        if (cus != 256) fprintf(stderr, "kernel_launch: device has %d CUs; this kernel is built for 256\n", cus);
    }
    if (grid < 0) return;
    if (hipMemsetAsync((char*)d_ws + WS_CTL, 0, CTL_ZERO_BYTES, stream) != hipSuccess) { fprintf(stderr, "kernel_launch: hipMemsetAsync of the control words failed; nothing launched\n"); return; }
    Args a{};
    for (int i = 0; i < 19; ++i) a.in[i] = (const float*)d_in[i];
    a.out = (float*)d_out; a.ws = (unsigned char*)d_ws;
    hipLaunchKernelGGL(mk_fwd, dim3(grid), dim3(NWAVES * 64), LDS_BYTES, stream, a);
    const hipError_t le = hipPeekAtLastError();
    if (le != hipSuccess) fprintf(stderr, "kernel_launch: launch failed: %s\n", hipGetErrorName(le));
}
```

```cpp
#include <hip/hip_runtime.h>
#include <cstdio>
#include <cstdint>
#ifndef PG8_WGM
#define PG8_WGM 4
#endif
namespace pg8 {
#define PG8_LAS __attribute__((address_space(3)))
typedef unsigned short bf16_t;
typedef short bf16x8 __attribute__((ext_vector_type(8)));
typedef float f32x4 __attribute__((ext_vector_type(4)));
typedef unsigned u32x4 __attribute__((ext_vector_type(4)));
constexpr int BM = 256, BK = 64, HALF = 128, HTB = HALF * BK * 2  , STAGE_BYTES = 8 * HTB, NXCD = 8, WGM = PG8_WGM;

__host__ __device__ __forceinline__ int lds_byte(int r, int c) { const int st = (r >> 4) * 2 + (c >> 5), rr = r & 15, cc = c & 31, ob = rr * 64 + cc * 2; return st * 1024 + (ob ^ (((ob >> 9) & 1) << 5)); }
__host__ __device__ __forceinline__ void stage_rc(int b, int& R, int& C) { const int st = b / 1024, sb = b % 1024, swz = sb ^ (((sb >> 9) & 1) << 5); R = (st >> 1) * 16 + swz / 64; C = (st & 1) * 32 + (swz % 64) / 2; }
__host__ __device__ __forceinline__ int perm32(int rho) { const int n = rho >> 4, i = rho & 15; return 8 * (i >> 2) + 4 * n + (i & 3); }

struct Unit { int pm, pn; };
struct Gemm { const bf16_t* A; const bf16_t* Bt; int M, N, K; };

struct StaticOrder {
    int nM, nN, nwg, G, c;
    __host__ __device__ void init(int M, int N, int G_, int c_) { nM = M / BM; nN = N / BM; nwg = nM * nN; G = G_; c = c_; }
    __host__ __device__ bool next(int i, Unit& u) const {
        const long L = (long)i * G + c; if (L >= nwg) return false;
        int wgid = (int)L; { const int q = nwg / NXCD, r = nwg % NXCD, xcd = wgid % NXCD, off = wgid / NXCD; wgid = (xcd < r ? xcd * (q + 1) : r * (q + 1) + (xcd - r) * q) + off; }
        const int nig = WGM * nN, gid = wgid / nig, fm = gid * WGM, gsz = (nM - fm) < WGM ? (nM - fm) : WGM;
        u.pm = fm + ((wgid % nig) % gsz); u.pn = (wgid % nig) / gsz; return true;
    }
    __device__ __forceinline__ void a_ready(const Unit&) const {}
    __device__ __forceinline__ void done(const Unit&) const {}
};

__device__ __forceinline__ unsigned cvt_pk_bf16(float lo, float hi) { unsigned r; asm volatile("v_cvt_pk_bf16_f32 %0, %1, %2" : "=v"(r) : "v"(lo), "v"(hi)); return r; }
typedef float f32x2 __attribute__((ext_vector_type(2)));
#define PG8_GAS __attribute__((address_space(1)))
__device__ __forceinline__ int lane_now() { int l; asm volatile("v_mbcnt_lo_u32_b32 %0, -1, 0\n\tv_mbcnt_hi_u32_b32 %0, -1, %0" : "=v"(l)); return l; }
__device__ __forceinline__ float sum_fq(float s, int fr, int fq) { const int l4 = (fr + 16 * fq) << 2;
    s += __int_as_float(__builtin_amdgcn_ds_bpermute(l4 ^ 64, __float_as_int(s))); s += __int_as_float(__builtin_amdgcn_ds_bpermute(l4 ^ 128, __float_as_int(s))); return s; }
__device__ __forceinline__ float silu_f(float g) { const float e = __builtin_amdgcn_exp2f(g * -1.4426950408889634f); return g * __builtin_amdgcn_rcpf(1.0f + e); }

__device__ __forceinline__ void row_rstd(const unsigned long long* ssq, int row0, float (&rs)[2][4]) {
#pragma unroll
    for (int ai = 0; ai < 2; ++ai)
#pragma unroll
        for (int m = 0; m < 4; ++m) { const unsigned long long v = *(const PG8_GAS unsigned long long*)(ssq + (unsigned)(row0 + ai * HALF + m * 16));
            const float s = (float)(unsigned)(v >> 24) + (float)((unsigned)v & 0xffffffu) * (1.0f / 16777216.0f);
            rs[ai][m] = __builtin_amdgcn_rsqf(s * (1.0f / 2048.0f) + 1e-5f); }
}
constexpr int RSTD_OFF = 131072 + 1024;
__device__ __forceinline__ unsigned long long rstd_fetch(const unsigned long long* ssq, int row) { return *(const PG8_GAS unsigned long long*)(ssq + (unsigned)row); }
__device__ __forceinline__ void rstd_put(unsigned long long v, int slot) {
    const float s = (float)(unsigned)(v >> 24) + (float)((unsigned)v & 0xffffffu) * (1.0f / 16777216.0f);
    *(PG8_LAS float*)(size_t)(RSTD_OFF + 4 * slot) = __builtin_amdgcn_rsqf(s * (1.0f / 2048.0f) + 1e-5f);
}
__device__ __forceinline__ void row_rstd_tab(int rl0, float (&rs)[2][4]) {
#pragma unroll
    for (int ai = 0; ai < 2; ++ai)
#pragma unroll
        for (int m = 0; m < 4; ++m) rs[ai][m] = *(const PG8_LAS float*)(size_t)(RSTD_OFF + 4 * (rl0 + ai * HALF + m * 16));
}
__device__ __forceinline__ void pin_acc(f32x4 (&acc)[2][2][4][2]) {
#pragma unroll
    for (int ai = 0; ai < 2; ++ai)
#pragma unroll
        for (int m = 0; m < 4; ++m) asm volatile("" : "+v"(acc[ai][0][m][0]), "+v"(acc[ai][0][m][1]), "+v"(acc[ai][1][m][0]), "+v"(acc[ai][1][m][1]));
}
struct EpiSwiGLU {
    static constexpr bool PERM = true, AFTER_DRAIN = false, RSTD = true;
    bf16_t* O; int ldc; const unsigned long long* ssq;
    __device__ __forceinline__ void operator()(f32x4 (&acc)[2][2][4][2], const Unit& u, int wr, int wc, int fr, int fq, int pm_tab) const {
        const int row0 = u.pm * BM + wr * 64 + fr, col0 = u.pn * HALF + wc * 32 + 8 * fq;
        float rs[2][4]; if (u.pm == pm_tab) row_rstd_tab(wr * 64 + fr, rs); else row_rstd(ssq, row0, rs);
#pragma unroll
        for (int ai = 0; ai < 2; ++ai)
#pragma unroll
            for (int m = 0; m < 4; ++m) { bf16_t* rowp = O + (unsigned)((row0 + ai * HALF + m * 16) * ldc + col0);
                const float r_ = rs[ai][m]; const f32x2 ce = (f32x2){r_, r_} * -1.4426950408889634f, r2 = (f32x2){r_, r_} * (f32x2){r_, r_};
                u32x4 w;
#pragma unroll
                for (int h = 0; h < 4; ++h) { const f32x4 gq = acc[ai][0][m][h >> 1], uq = acc[ai][1][m][h >> 1];
                    const f32x2 g = (h & 1) ? (f32x2){gq[2], gq[3]} : (f32x2){gq[0], gq[1]}, u2 = (h & 1) ? (f32x2){uq[2], uq[3]} : (f32x2){uq[0], uq[1]};
                    f32x2 e = g * ce; e = (f32x2){__builtin_amdgcn_exp2f(e[0]), __builtin_amdgcn_exp2f(e[1])} + 1.0f; e = (f32x2){__builtin_amdgcn_rcpf(e[0]), __builtin_amdgcn_rcpf(e[1])};
                    const f32x2 o = (g * u2) * (r2 * e); w[h] = cvt_pk_bf16(o[0], o[1]); }
                *(PG8_GAS u32x4*)rowp = w; __builtin_amdgcn_sched_barrier(0); }
    }
};
struct EpiResidual {
    static constexpr bool PERM = true, AFTER_DRAIN = false, RSTD = false;
    bf16_t* xb; int ldc; float scale; unsigned long long* ssq;
    __device__ __forceinline__ void operator()(f32x4 (&acc)[2][2][4][2], const Unit& u, int wr, int wc, int fr, int fq, int pm_tab) const {
        const int row0 = u.pm * BM + wr * 64 + fr, col0 = u.pn * BM + wc * 32 + 8 * fq;
        u32x4 nb[2][2];
#pragma unroll
        for (int p = 0; p < 2; ++p)
#pragma unroll
            for (int bj = 0; bj < 2; ++bj) nb[p][bj] = *(const PG8_GAS u32x4*)(xb + (unsigned)((row0 + p * 16) * ldc + col0 + bj * HALF));
#pragma unroll
        for (int g = 0; g < 8; ++g) { const int ai = g >> 2, m = g & 3;
            u32x4 cb[2];
#pragma unroll
            for (int bj = 0; bj < 2; ++bj) cb[bj] = nb[g & 1][bj];
            asm volatile("" ::: "memory");
            if (g < 6) { const unsigned off = (unsigned)((row0 + ((g + 2) >> 2) * HALF + ((g + 2) & 3) * 16) * ldc + col0);
#pragma unroll
                for (int bj = 0; bj < 2; ++bj) nb[g & 1][bj] = *(const PG8_GAS u32x4*)(xb + (off + bj * HALF)); }
#pragma unroll
            for (int bj = 0; bj < 2; ++bj) { const u32x4 x = cb[bj];
                acc[ai][bj][m][0] = (f32x4){__uint_as_float(x.x << 16), __uint_as_float(x.x & 0xffff0000u), __uint_as_float(x.y << 16), __uint_as_float(x.y & 0xffff0000u)} + acc[ai][bj][m][0] * scale;
                acc[ai][bj][m][1] = (f32x4){__uint_as_float(x.z << 16), __uint_as_float(x.z & 0xffff0000u), __uint_as_float(x.w << 16), __uint_as_float(x.w & 0xffff0000u)} + acc[ai][bj][m][1] * scale; }
            asm volatile("" : "+v"(acc[ai][0][m][0]), "+v"(acc[ai][0][m][1]), "+v"(acc[ai][1][m][0]), "+v"(acc[ai][1][m][1])); }
        asm volatile("" ::: "memory");
#pragma unroll
        for (int ai = 0; ai < 2; ++ai)
#pragma unroll
            for (int m = 0; m < 4; ++m) { const int row = row0 + ai * HALF + m * 16; const unsigned off = (unsigned)(row * ldc + col0); float s = 0.f;
#pragma unroll
                for (int bj = 0; bj < 2; ++bj) { const f32x4 a0 = acc[ai][bj][m][0], a1 = acc[ai][bj][m][1];
                    u32x4 w; w.x = cvt_pk_bf16(a0[0], a0[1]); w.y = cvt_pk_bf16(a0[2], a0[3]); w.z = cvt_pk_bf16(a1[0], a1[1]); w.w = cvt_pk_bf16(a1[2], a1[3]);
                    *(PG8_GAS u32x4*)(xb + (off + bj * HALF)) = w;
#pragma unroll
                    for (int q = 0; q < 4; ++q) { const float lo = __uint_as_float(w[q] << 16), hi = __uint_as_float(w[q] & 0xffff0000u); s += lo * lo + hi * hi; } }
                s = sum_fq(s, fr, fq);
                if (fq == 0) (void)__hip_atomic_fetch_add(ssq + (unsigned)row, (unsigned long long)(s * 16777216.0f), __ATOMIC_RELAXED, __HIP_MEMORY_SCOPE_AGENT); }
    }
};
template <int MODE> struct EpiWin {
    static constexpr bool PERM = true, AFTER_DRAIN = false, RSTD = true;
    bf16_t *O0, *O1; const float* cs; float qscale; const unsigned long long* ssq;
    __device__ __forceinline__ void operator()(f32x4 (&acc)[2][2][4][2], const Unit& u, int wr, int wc, int fr, int fq, int pm_tab) const {
        const int row0 = u.pm * BM + wr * 64 + fr; const int pn = u.pn;
        float rs[2][4]; if (u.pm == pm_tab) row_rstd_tab(wr * 64 + fr, rs); else row_rstd(ssq, row0, rs);
        if constexpr (MODE == 2) {
            const int col0 = pn * HALF + wc * 32 + 8 * fq;
#pragma unroll
            for (int ai = 0; ai < 2; ++ai)
#pragma unroll
                for (int m = 0; m < 4; ++m) { bf16_t* rowp = O0 + (unsigned)((row0 + ai * HALF + m * 16) * 1024 + col0);
                    const float r2 = rs[ai][m] * rs[ai][m]; const f32x4 a0 = acc[ai][0][m][0] * acc[ai][1][m][0] * r2, a1 = acc[ai][0][m][1] * acc[ai][1][m][1] * r2;
                    u32x4 w; w.x = cvt_pk_bf16(a0[0], a0[1]); w.y = cvt_pk_bf16(a0[2], a0[3]); w.z = cvt_pk_bf16(a1[0], a1[1]); w.w = cvt_pk_bf16(a1[2], a1[3]);
                    *(PG8_GAS u32x4*)rowp = w; }
        } else {
            const int col0 = (pn & 3) * BM + wc * 32 + 8 * fq;
            bf16_t* base = pn < 4 ? O0 : O1; const float sc = (MODE == 0 && pn < 4) ? qscale : 1.0f;
            if constexpr (MODE == 0) {
                const bool rope = ((wc & 1) == 0) && (fq < 2); const int fo = 4 * (fq & 1);
#pragma unroll
                for (int ai = 0; ai < 2; ++ai) { f32x4 c[4], s[4];
#pragma unroll
                    for (int m = 0; m < 4; ++m) { const int row = row0 + ai * HALF + m * 16; c[m] = *(const PG8_GAS f32x4*)(cs + (unsigned)(row * 16 + fo)); s[m] = *(const PG8_GAS f32x4*)(cs + (unsigned)(row * 16 + 8 + fo));
                        if (!rope) { c[m] = (f32x4){1.f, 1.f, 1.f, 1.f}; s[m] = (f32x4){0.f, 0.f, 0.f, 0.f}; } }
#pragma unroll
                    for (int m = 0; m < 4; ++m) {
#pragma unroll
                        for (int bj = 0; bj < 2; ++bj) { const f32x4 v0 = acc[ai][bj][m][0], v1 = acc[ai][bj][m][1], cc = c[m], ss = s[m]; f32x4 o0, o1;
                            o0[0] = v0[0] * cc[0] - v0[1] * ss[0]; o0[1] = v0[1] * cc[0] + v0[0] * ss[0]; o0[2] = v0[2] * cc[1] - v0[3] * ss[1]; o0[3] = v0[3] * cc[1] + v0[2] * ss[1];
                            o1[0] = v1[0] * cc[2] - v1[1] * ss[2]; o1[1] = v1[1] * cc[2] + v1[0] * ss[2]; o1[2] = v1[2] * cc[3] - v1[3] * ss[3]; o1[3] = v1[3] * cc[3] + v1[2] * ss[3];
                            acc[ai][bj][m][0] = o0; acc[ai][bj][m][1] = o1; }
                        asm volatile("" : "+v"(acc[ai][0][m][0]), "+v"(acc[ai][0][m][1]), "+v"(acc[ai][1][m][0]), "+v"(acc[ai][1][m][1])); }
                    asm volatile("" ::: "memory"); }
            }
#pragma unroll
            for (int ai = 0; ai < 2; ++ai)
#pragma unroll
                for (int m = 0; m < 4; ++m) { const int row = row0 + ai * HALF + m * 16; bf16_t* rowp = base + (unsigned)(row * 1024 + col0); const float f = sc * rs[ai][m];
#pragma unroll
                    for (int bj = 0; bj < 2; ++bj) { const f32x4 o0 = acc[ai][bj][m][0] * f, o1 = acc[ai][bj][m][1] * f;
                        u32x4 w; w.x = cvt_pk_bf16(o0[0], o0[1]); w.y = cvt_pk_bf16(o0[2], o0[3]); w.z = cvt_pk_bf16(o1[0], o1[1]); w.w = cvt_pk_bf16(o1[2], o1[3]);
                        *(PG8_GAS u32x4*)(rowp + bj * HALF) = w; } }
        }
    }
};

__device__ __forceinline__ void glds16_s(const void* gbase, unsigned voff, unsigned lds_dst) {
    asm volatile("s_mov_b32 m0, %2\n\ts_nop 0\n\tglobal_load_lds_dwordx4 %0, %1" :: "v"(voff), "s"(gbase), "s"(lds_dst) : "memory", "m0");
}
template <bool B> struct ZTag { static constexpr bool value = B; };
template <class Epi, class Sched, bool ALIGN_EPI = false, bool SP2 = false>
__device__ __forceinline__ void gemm_phase(PG8_LAS unsigned char* lds, const Gemm g, const Sched& S, const Epi& E) {
    int tid_ = threadIdx.x; asm volatile("" : "+v"(tid_));
    const int tid = tid_, wid = __builtin_amdgcn_readfirstlane(tid >> 6), lane = tid & 63, wr = wid >> 2, wc = wid & 3, fr = lane & 15, fq = lane >> 4;
    constexpr bool RSTD_ = Epi::RSTD; const unsigned long long* SSQ_ = nullptr; if constexpr (RSTD_) SSQ_ = E.ssq;
    const int K = g.K, nt = K / BK;
    unsigned voffA[2], voffB[2];
#pragma unroll
    for (int i = 0; i < 2; ++i) { int R, C; stage_rc(tid * 16 + i * 8192, R, C); const int Rb = Epi::PERM ? ((R & ~31) + perm32(R & 31)) : R;
        voffA[i] = (unsigned)(R * K + C) * 2u; voffB[i] = (unsigned)(Rb * K + C) * 2u; }
    const size_t kstep = (size_t)(BK * 2);
    const size_t hstep = (size_t)HALF * K * 2;
    const size_t tstep = 2 * hstep;
    const unsigned ldsw = (unsigned)wid * 1024u;
    const unsigned ldsb = (unsigned)__builtin_amdgcn_readfirstlane((int)((unsigned)(size_t)lds + ldsw));
    const int aoff = lds_byte(wr * 64 + fr, fq * 8); int boff = lds_byte(wc * 32 + fr, fq * 8) + 4 * HTB;
    asm volatile("" : "+v"(boff));
#define PG8_SA(b, h) (((b) * 2 + (h)) * HTB)
#define PG8_SB(b, h) ((4 + (b) * 2 + (h)) * HTB)
#define PG8_SBR(b, h) (((b) * 2 + (h)) * HTB)
#define PG8_STAGE(bufoff, gbase, voff) do { _Pragma("unroll") for (int _i = 0; _i < 2; ++_i) \
        glds16_s((gbase), (voff)[_i], ldsb + (unsigned)((bufoff) + _i * 8192)); } while (0)
#define PG8_LDA(dst, b, h) do { _Pragma("unroll") for (int m = 0; m < 4; ++m) _Pragma("unroll") for (int k = 0; k < 2; ++k) dst[m][k] = *(const PG8_LAS bf16x8*)(lds + PG8_SA(b, h) + aoff + m * 2048 + k * 1024); } while (0)
#define PG8_LDB(dst, b, h) do { _Pragma("unroll") for (int n = 0; n < 2; ++n) _Pragma("unroll") for (int k = 0; k < 2; ++k) dst[n][k] = *(const PG8_LAS bf16x8*)(lds + PG8_SBR(b, h) + boff + n * 2048 + k * 1024); } while (0)
#define PG8_MMA(ai, bj, At, Bt) do { __builtin_amdgcn_s_setprio(1); _Pragma("unroll") for (int m = 0; m < 4; ++m) _Pragma("unroll") for (int n = 0; n < 2; ++n) _Pragma("unroll") for (int k = 0; k < 2; ++k) \
        acc[ai][bj][m][n] = __builtin_amdgcn_mfma_f32_16x16x32_bf16(Bt[n][k], At[m][k], acc[ai][bj][m][n], 0, 0, 0); __builtin_amdgcn_s_setprio(0); } while (0)
#define PG8_MMAZ(Z, ai, bj, At, Bt) do { if constexpr (Z) { __builtin_amdgcn_s_setprio(1); _Pragma("unroll") for (int m = 0; m < 4; ++m) _Pragma("unroll") for (int n = 0; n < 2; ++n) { \
        acc[ai][bj][m][n] = __builtin_amdgcn_mfma_f32_16x16x32_bf16(Bt[n][0], At[m][0], (f32x4){0.f, 0.f, 0.f, 0.f}, 0, 0, 0); acc[ai][bj][m][n] = __builtin_amdgcn_mfma_f32_16x16x32_bf16(Bt[n][1], At[m][1], acc[ai][bj][m][n], 0, 0, 0); } \
        __builtin_amdgcn_s_setprio(0); } else PG8_MMA(ai, bj, At, Bt); } while (0)
#define PG8_WAIT_V(n) asm volatile("s_waitcnt vmcnt(" #n ")" ::: "memory")
#define PG8_WAIT_L(n) asm volatile("s_waitcnt lgkmcnt(" #n ")" ::: "memory")
#define PG8_BAR __builtin_amdgcn_s_barrier()
#define PG8_SCHED __builtin_amdgcn_sched_barrier(0)
    Unit cur, nxt; int ui = 0;
    if (!S.next(0, cur)) return;
    f32x4 acc[2][2][4][2];
    bf16x8 At[4][2], B0[2][2], B1[2][2];
    const char* cA = (const char*)g.A + (size_t)cur.pm * tstep; const char* cB = (const char*)g.Bt + (size_t)cur.pn * tstep;
    S.a_ready(cur);
    const int pm0 = cur.pm;
    unsigned long long sv_ = 0ull; if constexpr (RSTD_) sv_ = rstd_fetch(SSQ_, pm0 * BM + (tid & 255));
    if constexpr (SP2) {
        PG8_STAGE(PG8_SB(0, 0), cB, voffB); PG8_STAGE(PG8_SB(0, 1), cB + hstep, voffB); PG8_STAGE(PG8_SA(0, 0), cA, voffA); PG8_STAGE(PG8_SA(0, 1), cA + hstep, voffA);
        if (wr == 1) PG8_BAR;
        PG8_WAIT_V(2); PG8_BAR;
        if constexpr (RSTD_) { if (tid < 256) rstd_put(sv_, tid); }
        PG8_STAGE(PG8_SB(1, 0), cB + kstep, voffB); PG8_STAGE(PG8_SA(1, 0), cA + kstep, voffA); PG8_STAGE(PG8_SB(1, 1), cB + hstep + kstep, voffB);
        PG8_WAIT_V(6); PG8_BAR;
    } else {
        PG8_STAGE(PG8_SB(0, 0), cB, voffB); PG8_STAGE(PG8_SA(0, 0), cA, voffA); PG8_STAGE(PG8_SB(0, 1), cB + hstep, voffB); PG8_STAGE(PG8_SA(0, 1), cA + hstep, voffA);
        if (wr == 1) PG8_BAR;
        PG8_WAIT_V(4); PG8_BAR;
        if constexpr (RSTD_) { if (tid < 256) rstd_put(sv_, tid); }
        PG8_STAGE(PG8_SB(1, 0), cB + kstep, voffB); PG8_STAGE(PG8_SA(1, 0), cA + kstep, voffA); PG8_STAGE(PG8_SB(1, 1), cB + hstep + kstep, voffB);
        PG8_WAIT_V(6); PG8_BAR;
    }
    for (;;) {
        const bool has_next = S.next(ui + 1, nxt);
        const char* nA = has_next ? (const char*)g.A + (size_t)nxt.pm * tstep : cA; const char* nB = has_next ? (const char*)g.Bt + (size_t)nxt.pn * tstep : cB;
        auto kpair = [&](auto ztag, const int t) __attribute__((always_inline)) {
            constexpr bool Z = decltype(ztag)::value;
            const bool last = (t == nt - 2);
            const char* a1 = cA + (size_t)(t + 1) * kstep;
            const char* a2 = last ? nA : cA + (size_t)(t + 2) * kstep; const char* b2 = last ? nB : cB + (size_t)(t + 2) * kstep;
            const char* a3 = a2 + kstep; const char* b3 = b2 + kstep;
            if (last && has_next) S.a_ready(nxt);
            if constexpr (SP2) {
            PG8_LDB(B0, 0, 0); PG8_LDB(B1, 0, 1); PG8_SCHED; PG8_LDA(At, 0, 0); PG8_STAGE(PG8_SA(1, 1), a1 + hstep, voffA);
            PG8_WAIT_V(8); PG8_WAIT_L(0); PG8_BAR; PG8_MMAZ(Z, 0, 0, At, B0); PG8_MMAZ(Z, 0, 1, At, B1); PG8_BAR; PG8_SCHED;
            PG8_LDA(At, 0, 1); PG8_STAGE(PG8_SB(0, 0), b2, voffB); PG8_STAGE(PG8_SB(0, 1), b2 + hstep, voffB); PG8_STAGE(PG8_SA(0, 0), a2, voffA);
            PG8_WAIT_V(8); PG8_WAIT_L(0); PG8_BAR; PG8_MMAZ(Z, 1, 0, At, B0); PG8_MMAZ(Z, 1, 1, At, B1); PG8_BAR; PG8_SCHED;
            PG8_LDB(B0, 1, 0); PG8_LDB(B1, 1, 1); PG8_SCHED; PG8_LDA(At, 1, 0); PG8_STAGE(PG8_SA(0, 1), a2 + hstep, voffA);
            PG8_WAIT_V(8); PG8_WAIT_L(0); PG8_BAR; PG8_MMA(0, 0, At, B0); PG8_MMA(0, 1, At, B1); PG8_BAR; PG8_SCHED;
            PG8_LDA(At, 1, 1); PG8_STAGE(PG8_SB(1, 0), b3, voffB); PG8_STAGE(PG8_SB(1, 1), b3 + hstep, voffB); PG8_STAGE(PG8_SA(1, 0), a3, voffA);
            PG8_WAIT_V(8); PG8_WAIT_L(0); PG8_BAR; PG8_MMA(1, 0, At, B0); PG8_MMA(1, 1, At, B1); PG8_BAR; PG8_SCHED;
            } else {
            PG8_LDB(B0, 0, 0); PG8_SCHED; PG8_LDA(At, 0, 0); PG8_STAGE(PG8_SA(1, 1), a1 + hstep, voffA);
            PG8_WAIT_L(8); PG8_BAR; PG8_WAIT_L(0); PG8_MMAZ(Z, 0, 0, At, B0); PG8_BAR; PG8_SCHED;
            PG8_LDB(B1, 0, 1); PG8_STAGE(PG8_SB(0, 0), b2, voffB);
            PG8_BAR; PG8_WAIT_L(0); PG8_MMAZ(Z, 0, 1, At, B1); PG8_BAR;
            PG8_LDA(At, 0, 1); PG8_STAGE(PG8_SA(0, 0), a2, voffA);
            PG8_BAR; PG8_WAIT_L(0); PG8_MMAZ(Z, 1, 0, At, B0); PG8_BAR; PG8_SCHED;
            PG8_STAGE(PG8_SB(0, 1), b2 + hstep, voffB);
            PG8_WAIT_V(6); PG8_BAR; PG8_MMAZ(Z, 1, 1, At, B1); PG8_BAR;
            PG8_LDB(B0, 1, 0); PG8_SCHED; PG8_LDA(At, 1, 0); PG8_STAGE(PG8_SA(0, 1), a2 + hstep, voffA);
            PG8_WAIT_L(8); PG8_BAR; PG8_WAIT_L(0); PG8_MMA(0, 0, At, B0); PG8_BAR; PG8_SCHED;
            PG8_LDB(B1, 1, 1); PG8_STAGE(PG8_SB(1, 0), b3, voffB);
            PG8_BAR; PG8_WAIT_L(0); PG8_MMA(0, 1, At, B1); PG8_BAR;
            PG8_LDA(At, 1, 1); PG8_STAGE(PG8_SA(1, 0), a3, voffA);
            PG8_BAR; PG8_WAIT_L(0); PG8_MMA(1, 0, At, B0); PG8_BAR; PG8_SCHED;
            PG8_STAGE(PG8_SB(1, 1), b3 + hstep, voffB);
            PG8_WAIT_V(6); PG8_BAR; PG8_MMA(1, 1, At, B1); PG8_BAR;
            }
        };
        kpair(ZTag<true>{}, 0);
        for (int t = 2; t < nt; t += 2) kpair(ZTag<false>{}, t);
        if constexpr (ALIGN_EPI) { if (wr == 0) PG8_BAR; }
        if constexpr (!Epi::AFTER_DRAIN) { E(acc, cur, wr, wc, fr, fq, pm0); S.done(cur); }
        if (!has_next) break;
        cur = nxt; cA = nA; cB = nB; ++ui;
        if constexpr (ALIGN_EPI) { if (wr == 1) PG8_BAR; }
    }
    PG8_WAIT_V(0);
    if constexpr (!ALIGN_EPI) { if (wr == 0) PG8_BAR; }
    PG8_BAR;
    if constexpr (Epi::AFTER_DRAIN) { E.fused(acc, cur, wr, wc, fr, fq, lds, wid, lane); S.done(cur); }
#undef PG8_SA
#undef PG8_SB
#undef PG8_SBR
#undef PG8_STAGE
#undef PG8_LDA
#undef PG8_LDB
#undef PG8_MMA
#undef PG8_MMAZ
#undef PG8_WAIT_V
#undef PG8_WAIT_L
#undef PG8_BAR
#undef PG8_SCHED
}
template <class E0, class E1, class E2, class Sched, bool ALIGN_EPI = false, bool SP2 = false>
__device__ __forceinline__ void gemm_phase3(PG8_LAS unsigned char* lds, const Gemm g, const bf16_t* Bt1, const bf16_t* Bt2, const Sched& S, const E0& e0, const E1& e1, const E2& e2) {
    int tid_ = threadIdx.x; asm volatile("" : "+v"(tid_));
    const int tid = tid_, wid = __builtin_amdgcn_readfirstlane(tid >> 6), lane = tid & 63, wr = wid >> 2, wc = wid & 3, fr = lane & 15, fq = lane >> 4;
    constexpr bool RSTD_ = E0::RSTD; static_assert(E0::RSTD == E1::RSTD && E1::RSTD == E2::RSTD, "one rstd table"); const unsigned long long* SSQ_ = nullptr; if constexpr (RSTD_) SSQ_ = e0.ssq;
    const int K = g.K, nt = K / BK;
    unsigned voffA[2], voffB[2];
#pragma unroll
    for (int i = 0; i < 2; ++i) { int R, C; stage_rc(tid * 16 + i * 8192, R, C); const int Rb = E0::PERM ? ((R & ~31) + perm32(R & 31)) : R;
        voffA[i] = (unsigned)(R * K + C) * 2u; voffB[i] = (unsigned)(Rb * K + C) * 2u; }
    const size_t kstep = (size_t)(BK * 2);
    const size_t hstep = (size_t)HALF * K * 2;
    const size_t tstep = 2 * hstep;
    const unsigned ldsw = (unsigned)wid * 1024u;
    const unsigned ldsb = (unsigned)__builtin_amdgcn_readfirstlane((int)((unsigned)(size_t)lds + ldsw));
    const int aoff = lds_byte(wr * 64 + fr, fq * 8); int boff = lds_byte(wc * 32 + fr, fq * 8) + 4 * HTB;
    asm volatile("" : "+v"(boff));
#define PG8_SA(b, h) (((b) * 2 + (h)) * HTB)
#define PG8_SB(b, h) ((4 + (b) * 2 + (h)) * HTB)
#define PG8_SBR(b, h) (((b) * 2 + (h)) * HTB)
#define PG8_STAGE(bufoff, gbase, voff) do { _Pragma("unroll") for (int _i = 0; _i < 2; ++_i) \
        glds16_s((gbase), (voff)[_i], ldsb + (unsigned)((bufoff) + _i * 8192)); } while (0)
#define PG8_LDA(dst, b, h) do { _Pragma("unroll") for (int m = 0; m < 4; ++m) _Pragma("unroll") for (int k = 0; k < 2; ++k) dst[m][k] = *(const PG8_LAS bf16x8*)(lds + PG8_SA(b, h) + aoff + m * 2048 + k * 1024); } while (0)
#define PG8_LDB(dst, b, h) do { _Pragma("unroll") for (int n = 0; n < 2; ++n) _Pragma("unroll") for (int k = 0; k < 2; ++k) dst[n][k] = *(const PG8_LAS bf16x8*)(lds + PG8_SBR(b, h) + boff + n * 2048 + k * 1024); } while (0)
#define PG8_MMA(ai, bj, At, Bt) do { __builtin_amdgcn_s_setprio(1); _Pragma("unroll") for (int m = 0; m < 4; ++m) _Pragma("unroll") for (int n = 0; n < 2; ++n) _Pragma("unroll") for (int k = 0; k < 2; ++k) \
        acc[ai][bj][m][n] = __builtin_amdgcn_mfma_f32_16x16x32_bf16(Bt[n][k], At[m][k], acc[ai][bj][m][n], 0, 0, 0); __builtin_amdgcn_s_setprio(0); } while (0)
#define PG8_MMAZ(Z, ai, bj, At, Bt) do { if constexpr (Z) { __builtin_amdgcn_s_setprio(1); _Pragma("unroll") for (int m = 0; m < 4; ++m) _Pragma("unroll") for (int n = 0; n < 2; ++n) { \
        acc[ai][bj][m][n] = __builtin_amdgcn_mfma_f32_16x16x32_bf16(Bt[n][0], At[m][0], (f32x4){0.f, 0.f, 0.f, 0.f}, 0, 0, 0); acc[ai][bj][m][n] = __builtin_amdgcn_mfma_f32_16x16x32_bf16(Bt[n][1], At[m][1], acc[ai][bj][m][n], 0, 0, 0); } \
        __builtin_amdgcn_s_setprio(0); } else PG8_MMA(ai, bj, At, Bt); } while (0)
#define PG8_WAIT_V(n) asm volatile("s_waitcnt vmcnt(" #n ")" ::: "memory")
#define PG8_WAIT_L(n) asm volatile("s_waitcnt lgkmcnt(" #n ")" ::: "memory")
#define PG8_BAR __builtin_amdgcn_s_barrier()
#define PG8_SCHED __builtin_amdgcn_sched_barrier(0)
    Unit cur, nxt; int ui = 0;
    if (!S.next(0, cur)) return;
    f32x4 acc[2][2][4][2];
#pragma unroll
    for (int a = 0; a < 2; ++a)
#pragma unroll
        for (int b = 0; b < 2; ++b)
#pragma unroll
            for (int m = 0; m < 4; ++m)
#pragma unroll
                for (int n = 0; n < 2; ++n) acc[a][b][m][n] = (f32x4){0.f, 0.f, 0.f, 0.f};
    bf16x8 At[4][2], B0[2][2], B1[2][2];
    const char* cA = (const char*)g.A + (size_t)cur.pm * tstep; const char* cB = (const char*)g.Bt + (size_t)cur.pn * tstep;
    S.a_ready(cur);
    const int pm0 = cur.pm;
    unsigned long long sv_ = 0ull; if constexpr (RSTD_) sv_ = rstd_fetch(SSQ_, pm0 * BM + (tid & 255));
    if constexpr (SP2) {
        PG8_STAGE(PG8_SB(0, 0), cB, voffB); PG8_STAGE(PG8_SB(0, 1), cB + hstep, voffB); PG8_STAGE(PG8_SA(0, 0), cA, voffA); PG8_STAGE(PG8_SA(0, 1), cA + hstep, voffA);
        if (wr == 1) PG8_BAR;
        PG8_WAIT_V(2); PG8_BAR;
        if constexpr (RSTD_) { if (tid < 256) rstd_put(sv_, tid); }
        PG8_STAGE(PG8_SB(1, 0), cB + kstep, voffB); PG8_STAGE(PG8_SA(1, 0), cA + kstep, voffA); PG8_STAGE(PG8_SB(1, 1), cB + hstep + kstep, voffB);
        PG8_WAIT_V(6); PG8_BAR;
    } else {
        PG8_STAGE(PG8_SB(0, 0), cB, voffB); PG8_STAGE(PG8_SA(0, 0), cA, voffA); PG8_STAGE(PG8_SB(0, 1), cB + hstep, voffB); PG8_STAGE(PG8_SA(0, 1), cA + hstep, voffA);
        if (wr == 1) PG8_BAR;
        PG8_WAIT_V(4); PG8_BAR;
        if constexpr (RSTD_) { if (tid < 256) rstd_put(sv_, tid); }
        PG8_STAGE(PG8_SB(1, 0), cB + kstep, voffB); PG8_STAGE(PG8_SA(1, 0), cA + kstep, voffA); PG8_STAGE(PG8_SB(1, 1), cB + hstep + kstep, voffB);
        PG8_WAIT_V(6); PG8_BAR;
    }
    static_assert(E0::PERM == E1::PERM && E1::PERM == E2::PERM && !E0::AFTER_DRAIN && !E1::AFTER_DRAIN && !E2::AFTER_DRAIN, "gemm_phase3: one staging order, in-loop epilogues");
    const char* cB1 = (const char*)Bt1 + (size_t)cur.pn * tstep; const char* cB2 = (const char*)Bt2 + (size_t)cur.pn * tstep;
    auto unit = [&](const auto& E, const char* nA, const char* nB, const bool has_next) __attribute__((always_inline)) {
            auto kpair = [&](auto ztag, const int t) __attribute__((always_inline)) {
                constexpr bool Z = decltype(ztag)::value;
                const bool last = (t == nt - 2);
                const char* a1 = cA + (size_t)(t + 1) * kstep;
                const char* a2 = last ? nA : cA + (size_t)(t + 2) * kstep; const char* b2 = last ? nB : cB + (size_t)(t + 2) * kstep;
                const char* a3 = a2 + kstep; const char* b3 = b2 + kstep;

                if constexpr (SP2) {
                PG8_LDB(B0, 0, 0); PG8_LDB(B1, 0, 1); PG8_SCHED; PG8_LDA(At, 0, 0); PG8_STAGE(PG8_SA(1, 1), a1 + hstep, voffA);
                PG8_WAIT_V(8); PG8_WAIT_L(0); PG8_BAR; PG8_MMAZ(Z, 0, 0, At, B0); PG8_MMAZ(Z, 0, 1, At, B1); PG8_BAR; PG8_SCHED;
                PG8_LDA(At, 0, 1); PG8_STAGE(PG8_SB(0, 0), b2, voffB); PG8_STAGE(PG8_SB(0, 1), b2 + hstep, voffB); PG8_STAGE(PG8_SA(0, 0), a2, voffA);
                PG8_WAIT_V(8); PG8_WAIT_L(0); PG8_BAR; PG8_MMAZ(Z, 1, 0, At, B0); PG8_MMAZ(Z, 1, 1, At, B1); PG8_BAR; PG8_SCHED;
                PG8_LDB(B0, 1, 0); PG8_LDB(B1, 1, 1); PG8_SCHED; PG8_LDA(At, 1, 0); PG8_STAGE(PG8_SA(0, 1), a2 + hstep, voffA);
                PG8_WAIT_V(8); PG8_WAIT_L(0); PG8_BAR; PG8_MMA(0, 0, At, B0); PG8_MMA(0, 1, At, B1); PG8_BAR; PG8_SCHED;
                PG8_LDA(At, 1, 1); PG8_STAGE(PG8_SB(1, 0), b3, voffB); PG8_STAGE(PG8_SB(1, 1), b3 + hstep, voffB); PG8_STAGE(PG8_SA(1, 0), a3, voffA);
                PG8_WAIT_V(8); PG8_WAIT_L(0); PG8_BAR; PG8_MMA(1, 0, At, B0); PG8_MMA(1, 1, At, B1); PG8_BAR; PG8_SCHED;
                } else {
                PG8_LDB(B0, 0, 0); PG8_SCHED; PG8_LDA(At, 0, 0); PG8_STAGE(PG8_SA(1, 1), a1 + hstep, voffA);
                PG8_WAIT_L(8); PG8_BAR; PG8_WAIT_L(0); PG8_MMAZ(Z, 0, 0, At, B0); PG8_BAR; PG8_SCHED;
                PG8_LDB(B1, 0, 1); PG8_STAGE(PG8_SB(0, 0), b2, voffB);
                PG8_BAR; PG8_WAIT_L(0); PG8_MMAZ(Z, 0, 1, At, B1); PG8_BAR;
                PG8_LDA(At, 0, 1); PG8_STAGE(PG8_SA(0, 0), a2, voffA);
                PG8_BAR; PG8_WAIT_L(0); PG8_MMAZ(Z, 1, 0, At, B0); PG8_BAR; PG8_SCHED;
                PG8_STAGE(PG8_SB(0, 1), b2 + hstep, voffB);
                PG8_WAIT_V(6); PG8_BAR; PG8_MMAZ(Z, 1, 1, At, B1); PG8_BAR;
                PG8_LDB(B0, 1, 0); PG8_SCHED; PG8_LDA(At, 1, 0); PG8_STAGE(PG8_SA(0, 1), a2 + hstep, voffA);
                PG8_WAIT_L(8); PG8_BAR; PG8_WAIT_L(0); PG8_MMA(0, 0, At, B0); PG8_BAR; PG8_SCHED;
                PG8_LDB(B1, 1, 1); PG8_STAGE(PG8_SB(1, 0), b3, voffB);
                PG8_BAR; PG8_WAIT_L(0); PG8_MMA(0, 1, At, B1); PG8_BAR;
                PG8_LDA(At, 1, 1); PG8_STAGE(PG8_SA(1, 0), a3, voffA);
                PG8_BAR; PG8_WAIT_L(0); PG8_MMA(1, 0, At, B0); PG8_BAR; PG8_SCHED;
                PG8_STAGE(PG8_SB(1, 1), b3 + hstep, voffB);
                PG8_WAIT_V(6); PG8_BAR; PG8_MMA(1, 1, At, B1); PG8_BAR;
                }
            };
            for (int t = 0; t < nt; t += 2) kpair(ZTag<false>{}, t);
            if constexpr (ALIGN_EPI) { if (wr == 0) PG8_BAR; }
            { const int ln_ = lane_now();
              E(acc, cur, wr, wc, ln_ & 15, ln_ >> 4, pm0); }
            if (!has_next) return;
    #pragma unroll
            for (int a = 0; a < 2; ++a)
    #pragma unroll
                for (int b = 0; b < 2; ++b)
    #pragma unroll
                    for (int m = 0; m < 4; ++m)
    #pragma unroll
                        for (int n = 0; n < 2; ++n) acc[a][b][m][n] = (f32x4){0.f, 0.f, 0.f, 0.f};
            cA = nA; cB = nB;
            if constexpr (ALIGN_EPI) { if (wr == 1) PG8_BAR; }
    };
    const char* cA1 = cA; const char* cA2 = cA; asm volatile("" : "+s"(cA1), "+s"(cA2));
    unit(e0, cA1, cB1, true); unit(e1, cA2, cB2, true); unit(e2, cA, cB, false);
    PG8_WAIT_V(0);
    if constexpr (!ALIGN_EPI) { if (wr == 0) PG8_BAR; }
    PG8_BAR;
#undef PG8_SA
#undef PG8_SB
#undef PG8_SBR
#undef PG8_STAGE
#undef PG8_LDA
#undef PG8_LDB
#undef PG8_MMA
#undef PG8_MMAZ
#undef PG8_WAIT_V
#undef PG8_WAIT_L
#undef PG8_BAR
#undef PG8_SCHED
}
}

#ifndef PG8_SP2
#define PG8_SP2 true
#endif
#ifndef PG8_ALIGN1
#define PG8_ALIGN1 false
#endif
#ifndef PG8_ALIGN
#define PG8_ALIGN true
#endif
#include <hip/hip_bf16.h>
#include <cmath>
namespace attn_body {
using bf16=__hip_bfloat16;
using bf16x8=__attribute__((ext_vector_type(8)))short;
using s16x4=__attribute__((ext_vector_type(4)))short;
using f32x16=__attribute__((ext_vector_type(16)))float;
using u32x4=__attribute__((ext_vector_type(4)))unsigned;
constexpr int BATCH=1,NHEAD=32,SEQ=8192,D=64,DM=1024,OP=2048;
constexpr int NW=8,QBLK=32,QB=QBLK*NW,KVBLK=64,NQB=SEQ/QB;
constexpr int ATTN_PITCH=DM, ATTN_UNIT_ROWS=QB;
__device__ __forceinline__ int crow(int r,int hi){return (r&3)+8*(r>>2)+4*hi;}
#define SBAR() __builtin_amdgcn_sched_barrier(0)
__device__ __forceinline__ void cmask(f32x16&p0,f32x16&p1,int jb,int qrel,int hi){
  const float NEG=-INFINITY; int kb=64*jb+4*hi;
  #pragma unroll
  for(int r=0;r<16;++r){int kv=kb+(r&3)+8*(r>>2); if(kv>qrel)p0[r]=NEG; if(kv+32>qrel)p1[r]=NEG;}
}

constexpr int NSLOT=3, SLOTB=8192;
constexpr int LDS_K=0, LDS_V=NSLOT*SLOTB, LDS_WS=3*NSLOT*SLOTB, LDS_OST=LDS_WS+NW*64*4, LDS_BYTES=LDS_OST+NW*4096;
constexpr float C2=0.125f*1.4426950408889634f;
__device__ __forceinline__ void glds16(const void*gsrc,unsigned lds_dst){
  asm volatile("s_mov_b32 m0, %1\n\ts_nop 0\n\tglobal_load_lds_dwordx4 %0, off"::"v"(gsrc),"s"(lds_dst):"memory","m0");}
__device__ __forceinline__ float max3f(float a,float b,float c){float r;asm("v_max3_f32 %0, %1, %2, %3":"=v"(r):"v"(a),"v"(b),"v"(c));return r;}
__device__ __forceinline__ float max2f(float a,float b){float r;asm("v_max_f32_e32 %0, %1, %2":"=v"(r):"v"(a),"v"(b));return r;}
__device__ __forceinline__ float fadd_s(float a,float b){float r;asm("v_add_f32_e32 %0, %1, %2":"=v"(r):"v"(a),"v"(b));return r;}
__device__ __forceinline__ float fsub_s(float a,float b){float r;asm("v_sub_f32_e32 %0, %1, %2":"=v"(r):"v"(a),"v"(b));return r;}
typedef float f32x2_t __attribute__((ext_vector_type(2))); typedef __bf16 bf16x2_t __attribute__((ext_vector_type(2)));
__device__ __forceinline__ unsigned cvtpk_s(float lo,float hi){f32x2_t v={lo,hi};bf16x2_t b=__builtin_convertvector(v,bf16x2_t);return __builtin_bit_cast(unsigned,b);}
#define WAIT_BAR(N) asm volatile("s_waitcnt vmcnt(" #N ") lgkmcnt(0)\n\ts_barrier":::"memory")

__device__ __forceinline__ void qkt(f32x16&p0,f32x16&p1,const char*Kslot,const bf16x8*qr,const f32x16&negm,int r32,int hi){
  const char*kb=Kslot+hi*1024+r32*16;
  #pragma unroll
  for(int d0=0;d0<4;++d0){
    const bf16x8 b0=*reinterpret_cast<const bf16x8*>(kb+d0*2048);
    const bf16x8 b1=*reinterpret_cast<const bf16x8*>(kb+d0*2048+512);
    if(d0==0){p0=__builtin_amdgcn_mfma_f32_32x32x16_bf16(b0,qr[0],negm,0,0,0);p1=__builtin_amdgcn_mfma_f32_32x32x16_bf16(b1,qr[0],negm,0,0,0);}
    else{p0=__builtin_amdgcn_mfma_f32_32x32x16_bf16(b0,qr[d0],p0,0,0,0);p1=__builtin_amdgcn_mfma_f32_32x32x16_bf16(b1,qr[d0],p1,0,0,0);}}
}
typedef __attribute__((address_space(3))) const char* lds_cptr;
typedef short v4i16_t __attribute__((ext_vector_type(4)));
__device__ __forceinline__ void kload8(bf16x8*kf,lds_cptr kp){
  kf[0]=*(const __attribute__((address_space(3))) bf16x8*)(kp);      kf[1]=*(const __attribute__((address_space(3))) bf16x8*)(kp+512);
  kf[2]=*(const __attribute__((address_space(3))) bf16x8*)(kp+2048); kf[3]=*(const __attribute__((address_space(3))) bf16x8*)(kp+2560);
  kf[4]=*(const __attribute__((address_space(3))) bf16x8*)(kp+4096); kf[5]=*(const __attribute__((address_space(3))) bf16x8*)(kp+4608);
  kf[6]=*(const __attribute__((address_space(3))) bf16x8*)(kp+6144); kf[7]=*(const __attribute__((address_space(3))) bf16x8*)(kp+6656);
}
__device__ __forceinline__ void kload2(bf16x8*kf,lds_cptr kp,int j){ kf[2*j]=*(const __attribute__((address_space(3))) bf16x8*)(kp+j*2048); kf[2*j+1]=*(const __attribute__((address_space(3))) bf16x8*)(kp+j*2048+512); }
__device__ __forceinline__ s16x4 vtr(lds_cptr p){ return __builtin_bit_cast(s16x4,__builtin_amdgcn_ds_read_tr16_b64_v4i16((__attribute__((address_space(3))) v4i16_t*)p)); }
__device__ __forceinline__ float rowmax(const f32x16&p0,const f32x16&p1){
  float a=max3f(p0[0],p0[1],p1[0]),b=max3f(p0[2],p0[3],p1[1]);a=max3f(a,p1[2],p1[3]);
  #pragma unroll
  for(int r=4;r<16;r+=4){a=max3f(a,p0[r],p0[r+1]);b=max3f(b,p0[r+2],p0[r+3]);a=max3f(a,p1[r],p1[r+1]);b=max3f(b,p1[r+2],p1[r+3]);}
  const float m=max2f(a,b);
  auto rr=__builtin_amdgcn_permlane32_swap(__float_as_uint(m),__float_as_uint(m),false,false);
  return max2f(__uint_as_float(rr[0]),__uint_as_float(rr[1]));
}
__device__ __forceinline__ void pv(f32x16*o,int vb,bf16x8 pa0,bf16x8 pa1,bf16x8 pa2,bf16x8 pa3){
  #pragma unroll
  for(int d0=0;d0<4;++d0){s16x4 lo[4],hi[4];
    #pragma unroll
    for(int ks=0;ks<4;++ks){
      asm volatile("ds_read_b64_tr_b16 %0,%1 offset:%c2":"=&v"(lo[ks]):"v"(vb),"i"(d0*4096+ks*1024):"memory");
      asm volatile("ds_read_b64_tr_b16 %0,%1 offset:%c2":"=&v"(hi[ks]):"v"(vb),"i"(d0*4096+ks*1024+512):"memory");}
    asm volatile("s_waitcnt lgkmcnt(0)":::"memory");SBAR();
    #define PK(k) (bf16x8){lo[k][0],lo[k][1],lo[k][2],lo[k][3],hi[k][0],hi[k][1],hi[k][2],hi[k][3]}
    o[d0]=__builtin_amdgcn_mfma_f32_32x32x16_bf16(pa0,PK(0),o[d0],0,0,0);
    o[d0]=__builtin_amdgcn_mfma_f32_32x32x16_bf16(pa1,PK(1),o[d0],0,0,0);
    o[d0]=__builtin_amdgcn_mfma_f32_32x32x16_bf16(pa2,PK(2),o[d0],0,0,0);
    o[d0]=__builtin_amdgcn_mfma_f32_32x32x16_bf16(pa3,PK(3),o[d0],0,0,0);
    #undef PK
  }
}

#ifndef ATTN_STORE16
#define ATTN_STORE16(p,v) (*(u32x4*)(p)=(v))
#endif
template<int THRL> __device__ __forceinline__ void attn_unit(int qb,const bf16*Q,const bf16*__restrict__ K,const bf16*__restrict__ V,bf16*O,char*shm){
  int tid_=threadIdx.x; asm volatile("":"+v"(tid_)); const int tid=tid_,lane=tid&63,r32=lane&31,hi=lane>>5; const int wid=__builtin_amdgcn_readfirstlane(tid>>6);
  const int q0=qb*QB;
  const bf16*Qw=Q+(long)(q0+wid*QBLK)*DM;
  const bf16*Kh=K,*Vh=V;
  const unsigned lds0=(unsigned)(uintptr_t)shm;
  float*wsf=(float*)(shm+LDS_WS)+wid*64;
  const bf16*ksrc=Kh+(long)lane*DM+wid*8;
  const bf16*vsrc=Vh+(long)(16*(wid&3)+(lane>>2))*DM+(wid>>2)*32+(lane&3)*8;
  const unsigned kdst=lds0+LDS_K+wid*1024, vdst=lds0+LDS_V+wid*1024;
  #define DMA_K(t,slot) glds16(ksrc+(long)(t)*KVBLK*DM,(unsigned)__builtin_amdgcn_readfirstlane(kdst+(slot)))
  #define DMA_V(t,slot) do{ glds16(vsrc+(long)(t)*KVBLK*DM,(unsigned)__builtin_amdgcn_readfirstlane(vdst+2*(slot))); glds16(vsrc+(long)(t)*KVBLK*DM+64,(unsigned)__builtin_amdgcn_readfirstlane(vdst+2*(slot)+8192)); }while(0)
  const int vb0=(int)(lds0+LDS_V)+((lane>>4)&1)*32+(lane&3)*8+(4*hi+((lane&15)>>2))*64;
  const char*Kbase=shm+LDS_K; bf16x8 kf[8];
  const lds_cptr shm3=(lds_cptr)shm; const lds_cptr kp0=shm3+LDS_K+hi*1024+r32*16; const lds_cptr vp0=shm3+LDS_V+((lane>>4)&1)*32+(lane&3)*8+(4*hi+((lane&15)>>2))*64;
  const int NT=(q0+QB)/KVBLK;
  DMA_K(0,0);DMA_V(0,0);DMA_K(1,SLOTB);
  const lds_cptr qp0=shm3+LDS_OST+wid*4096+hi*512+r32*16;
  { bf16x8 qt[4];
  #pragma unroll
  for(int d0=0;d0<4;++d0)qt[d0]=*reinterpret_cast<const bf16x8*>(&Qw[(long)r32*DM+d0*16+hi*8]);
  #pragma unroll
  for(int d0=0;d0<4;++d0)*(__attribute__((address_space(3))) bf16x8*)(qp0+d0*1024)=qt[d0]; }
  #define QF(d0) (*(const __attribute__((address_space(3))) bf16x8*)(qp0+(d0)*1024))
  float mhat=0.f,l_reg=0.f;float zf_=0.f;asm volatile("":"+v"(zf_));
  f32x16 o[4];f32x16 negm;
  #pragma unroll
  for(int r=0;r<16;++r){o[0][r]=zf_;o[1][r]=zf_;o[2][r]=zf_;o[3][r]=zf_;negm[r]=zf_;}asm volatile("":"+v"(negm));
  const int qrel=wid*QBLK+r32;
  #define CMASK(P0,P1,t) do{int jb_=(t)-(NT-4); if(jb_>=0)cmask(P0,P1,jb_,qrel,hi);}while(0)
  bool resc=false;
  #define START(P0,P1) do{ const float rm=rowmax(P0,P1); resc=false; \
    { const float dl=rm; mhat=fadd_s(mhat,dl); \
      _Pragma("unroll") for(int r=0;r<16;++r){P0[r]=fsub_s(P0[r],dl);P1[r]=fsub_s(P1[r],dl);} \
      _Pragma("unroll") for(int r=0;r<16;++r)negm[r]=-mhat; asm volatile("":"+v"(negm)); } \
    _Pragma("unroll") for(int r=0;r<16;++r)P0[r]=__builtin_amdgcn_exp2f(P0[r]); }while(0)
  #define RESC() do{ if(resc){ asm volatile("s_waitcnt lgkmcnt(0)":::"memory"); \
      _Pragma("unroll") for(int d_=0;d_<4;++d_) _Pragma("unroll") for(int r=0;r<16;++r)o[d_][r]*=wsf[crow(r,hi)]; } }while(0)
  f32x16 pA0,pA1,pB0,pB1;
  int sl_prev=0,sl_cur=0,sl_next=SLOTB;
  #define ROT() do{sl_prev=sl_cur;sl_cur=sl_next;sl_next=(sl_next==(NSLOT-1)*SLOTB)?0:sl_next+SLOTB;}while(0)
  DMA_K(2,2*SLOTB);
  const bf16x8 qf0=QF(0);
  WAIT_BAR(4);
  { const bf16x8 qq[4]={qf0,QF(1),QF(2),QF(3)}; qkt(pA0,pA1,Kbase,qq,negm,r32,hi); }asm volatile("s_nop 15\n\ts_nop 7":"+v"(pA0),"+v"(pA1));CMASK(pA0,pA1,0);
  START(pA0,pA1);
  _Pragma("unroll") for(int r=0;r<16;++r)pA1[r]=__builtin_amdgcn_exp2f(pA1[r]);
  WAIT_BAR(0);
  DMA_K(3,0);DMA_V(1,SLOTB);
  ROT();
  kload8(kf,kp0+sl_cur);
  WAIT_BAR(3);
  s16x4 vlo[8],vhi[8]; u32x4 pw0,pw1,pw2,pw3;
  #define PKW(P,B) cvtpk_s(P[B],P[B+1])
  #define PAF(k) __builtin_bit_cast(bf16x8,pw##k)
  #define VFR(i) (bf16x8){vlo[i][0],vlo[i][1],vlo[i][2],vlo[i][3],vhi[i][0],vhi[i][1],vhi[i][2],vhi[i][3]}
  #define PIN(x) asm volatile("":"+v"(x))
  #define MX3(a,b,c) __builtin_fmaxf(__builtin_fmaxf((a),(b)),(c))
  #define GAPA(MF,A0,A1,A2,A3,W0,W1,PW) do{ MF; sacc+=A0; sacc+=A1; sacc+=A2; sacc+=A3; PIN(sacc); W0; W1; PIN(PW); SBAR(); }while(0)
  #define EX(v) __builtin_amdgcn_exp2f(v)
  #define VRDF(s,f) do{ vlo[s]=vtr(vp_+(((f)>>2)*4096+((f)&3)*1024)); vhi[s]=vtr(vp_+(((f)>>2)*4096+((f)&3)*1024+512)); }while(0)
  #define KRD(G,j) do{ if(G){ kload2(kf,kp0+sl_next,j); SBAR(); } }while(0)
  #define GAPB2(MF,X,B) do{ MF; X[B]=EX(X[B]); X[B+1]=EX(X[B+1]); PIN(X); SBAR(); }while(0)
  #define MF32(a,b,c) __builtin_amdgcn_mfma_f32_32x32x16_bf16(a,b,c,0,0,0)
  #define STEP(C0,C1,P0,P1,t,GK,GV,GL) do{ SBAR(); \
    const lds_cptr vp_=vp0+2*sl_prev; bf16x8 qa,qb; \
    VRDF(0,0); qb=QF(1); SBAR(); float sacc=(P0[0]+P0[1]); \
    GAPA(C0=MF32(kf[0],qf0,negm), P0[2],P0[3],P0[4],P0[5],     pw0[0]=PKW(P0,0), pw0[1]=PKW(P0,2), pw0); \
    VRDF(1,4); SBAR(); GAPA(C1=MF32(kf[1],qf0,negm), P0[6],P0[7],P0[8],P0[9],     pw0[2]=PKW(P0,4), pw0[3]=PKW(P0,6), pw0); \
    VRDF(2,8); qa=QF(2); SBAR(); GAPA(C0=MF32(kf[2],qb,C0),   P0[10],P0[11],P0[12],P0[13], pw1[0]=PKW(P0,8), pw1[1]=PKW(P0,10), pw1); \
    VRDF(3,12); SBAR(); GAPA(C1=MF32(kf[3],qb,C1),   P0[14],P0[15],P1[0],P1[1],   pw1[2]=PKW(P0,12),pw1[3]=PKW(P0,14), pw1); \
    VRDF(4,1); qb=QF(3); SBAR(); GAPA(C0=MF32(kf[4],qa,C0),   P1[2],P1[3],P1[4],P1[5],     pw2[0]=PKW(P1,0), pw2[1]=PKW(P1,2), pw2); \
    VRDF(5,5); SBAR(); GAPA(C1=MF32(kf[5],qa,C1),   P1[6],P1[7],P1[8],P1[9],     pw2[2]=PKW(P1,4), pw2[3]=PKW(P1,6), pw2); \
    VRDF(6,9); SBAR(); GAPA(C0=MF32(kf[6],qb,C0),   P1[10],P1[11],P1[12],P1[13], pw3[0]=PKW(P1,8), pw3[1]=PKW(P1,10), pw3); \
    VRDF(7,13); SBAR(); GAPA(C1=MF32(kf[7],qb,C1),   P1[14],P1[15],0.f,0.f,       pw3[2]=PKW(P1,12),pw3[3]=PKW(P1,14), pw3); \
    l_reg+=sacc; \
    if(GK){DMA_K((t)+3,sl_cur);} if(GV){DMA_V((t)+1,sl_next);} \
    CMASK(C0,C1,t); \
    { float a=MX3(C0[0],C0[1],C1[0]),b=MX3(C0[2],C0[3],C1[1]); a=MX3(a,C1[2],C1[3]); \
      _Pragma("unroll") for(int r=4;r<16;r+=4){a=MX3(a,C0[r],C0[r+1]);b=MX3(b,C0[r+2],C0[r+3]);a=MX3(a,C1[r],C1[r+1]);b=MX3(b,C1[r+2],C1[r+3]);} \
      float rm=__builtin_fmaxf(a,b); { auto rr=__builtin_amdgcn_permlane32_swap(__float_as_uint(rm),__float_as_uint(rm),false,false); rm=__builtin_fmaxf(__uint_as_float(rr[0]),__uint_as_float(rr[1])); } \
      resc=false; \
      if(__builtin_expect(__any(rm>(float)THRL),0)){ const float dl=__builtin_fmaxf(rm,0.f); mhat+=dl; \
        _Pragma("unroll") for(int r=0;r<16;++r){C0[r]-=dl;C1[r]-=dl;} \
        _Pragma("unroll") for(int r=0;r<16;++r)negm[r]=-mhat; asm volatile("":"+v"(negm)); \
        const float f=__builtin_amdgcn_exp2f(-dl); l_reg*=f; if(hi==0)wsf[r32]=f; resc=true; } } \
    SBAR(); \
    GAPB2(o[0]=MF32(PAF(0),VFR(0),o[0]), C0,0);  VRDF(0,2);  SBAR(); \
    GAPB2(o[1]=MF32(PAF(0),VFR(1),o[1]), C0,2);  VRDF(1,6);  SBAR(); \
    KRD(GL,0); GAPB2(o[2]=MF32(PAF(0),VFR(2),o[2]), C0,4);  VRDF(2,10); SBAR(); \
    GAPB2(o[3]=MF32(PAF(0),VFR(3),o[3]), C0,6);  VRDF(3,14); SBAR(); \
    KRD(GL,1); GAPB2(o[0]=MF32(PAF(1),VFR(4),o[0]), C0,8);  VRDF(4,3);  SBAR(); \
    GAPB2(o[1]=MF32(PAF(1),VFR(5),o[1]), C0,10); VRDF(5,7);  SBAR(); \
    KRD(GL,2); GAPB2(o[2]=MF32(PAF(1),VFR(6),o[2]), C0,12); VRDF(6,11); SBAR(); \
    GAPB2(o[3]=MF32(PAF(1),VFR(7),o[3]), C0,14); VRDF(7,15); SBAR(); \
    KRD(GL,3); GAPB2(o[0]=MF32(PAF(2),VFR(0),o[0]), C1,0); \
    GAPB2(o[1]=MF32(PAF(2),VFR(1),o[1]), C1,2); \
    GAPB2(o[2]=MF32(PAF(2),VFR(2),o[2]), C1,4); \
    GAPB2(o[3]=MF32(PAF(2),VFR(3),o[3]), C1,6); \
    GAPB2(o[0]=MF32(PAF(3),VFR(4),o[0]), C1,8); \
    GAPB2(o[1]=MF32(PAF(3),VFR(5),o[1]), C1,10); \
    GAPB2(o[2]=MF32(PAF(3),VFR(6),o[2]), C1,12); \
    GAPB2(o[3]=MF32(PAF(3),VFR(7),o[3]), C1,14); \
    }while(0)
  int t=1;
  #undef CMASK
  #define CMASK(P0,P1,t) do{}while(0)
  for(;t+5<NT;t+=2){
    STEP(pB0,pB1,pA0,pA1,t,true,true,true);     WAIT_BAR(3); RESC(); ROT();
    STEP(pA0,pA1,pB0,pB1,t+1,true,true,true);   WAIT_BAR(3); RESC(); ROT();
  }
  #undef CMASK
  #define CMASK(P0,P1,t) do{int jb_=(t)-(NT-4); if(jb_>=0)cmask(P0,P1,jb_,qrel,hi);}while(0)
  #define ENDW(tt) do{ if((tt)+3<NT){WAIT_BAR(3);} else if((tt)+2<NT){WAIT_BAR(2);} else {WAIT_BAR(0);} }while(0)
  for(;t+1<NT;t+=2){
    STEP(pB0,pB1,pA0,pA1,t,(t+3<NT),(t+1<NT),(t+1<NT));       ENDW(t);   RESC(); ROT();
    STEP(pA0,pA1,pB0,pB1,t+1,(t+4<NT),(t+2<NT),(t+2<NT));     ENDW(t+1); RESC(); ROT();
  }
  STEP(pB0,pB1,pA0,pA1,NT-1,false,false,false); RESC();
  { float sacc=pB0[0]+pB0[1]; _Pragma("unroll") for(int r=2;r<16;++r)sacc+=pB0[r]; _Pragma("unroll") for(int r=0;r<16;++r)sacc+=pB1[r]; l_reg+=sacc;
    pw0=(u32x4){PKW(pB0,0),PKW(pB0,2),PKW(pB0,4),PKW(pB0,6)};pw1=(u32x4){PKW(pB0,8),PKW(pB0,10),PKW(pB0,12),PKW(pB0,14)};pw2=(u32x4){PKW(pB1,0),PKW(pB1,2),PKW(pB1,4),PKW(pB1,6)};pw3=(u32x4){PKW(pB1,8),PKW(pB1,10),PKW(pB1,12),PKW(pB1,14)};
    SBAR(); pv(o,vb0+2*sl_cur,PAF(0),PAF(1),PAF(2),PAF(3)); }
  #undef PKW
  #undef PAF
  #undef VFR
  #undef PIN
  #undef MX3
  #undef GAPA
  #undef GAPB2
  #undef MF32
  #undef EX
  #undef VRDF
  #undef KRD
  #undef STEP
  #undef ENDW
  {auto rr=__builtin_amdgcn_permlane32_swap(__float_as_uint(l_reg),__float_as_uint(l_reg),false,false);l_reg=__uint_as_float(rr[0])+__uint_as_float(rr[1]);}
  if(hi==0)wsf[32+r32]=l_reg;asm volatile("s_waitcnt lgkmcnt(0)":::"memory");
  float rli[16];
  #pragma unroll
  for(int r=0;r<16;++r)rli[r]=__builtin_amdgcn_rcpf(wsf[32+crow(r,hi)]);
  bf16*Ow=O+(long)(q0+wid*QBLK)*OP;
  { bf16*stg=(bf16*)(shm+LDS_OST)+wid*2048;
    #pragma unroll
    for(int p=0;p<2;++p){
      #pragma unroll
      for(int r=0;r<16;++r){const int orow=crow(r,hi);
        #pragma unroll
        for(int d0=0;d0<2;++d0)stg[orow*64+d0*32+r32]=__float2bfloat16(o[2*p+d0][r]*rli[r]);}
      asm volatile("s_waitcnt lgkmcnt(0)":::"memory");
      #pragma unroll
      for(int i=0;i<4;++i){const int row=i*8+(lane>>3),ch=lane&7; const u32x4 v=*(const u32x4*)(stg+row*64+ch*8); ATTN_STORE16(Ow+(long)row*OP+p*64+ch*8,v);}
      asm volatile("s_waitcnt lgkmcnt(0)":::"memory");
    } }
  asm volatile("s_waitcnt lgkmcnt(0)\n\ts_barrier":::"memory");
  #undef DMA_K
  #undef DMA_V
  #undef CMASK
  #undef START
  #undef RESC
  #undef ROT
}
constexpr int ATTN_LDS_BYTES=LDS_BYTES;
struct AttnTensors { const bf16* Q; const bf16* K; const bf16* V; bf16* O; };
struct AttnUnit { int bh; int qb; };
struct StaticOrder {
  int vcu;
  __device__ __forceinline__ explicit StaticOrder(int grid,int block):vcu((block%8)*(grid/8)+block/8){}
  __device__ __forceinline__ bool next(int i,AttnUnit&u)const{ if(i>=2)return false; const int s=vcu&15; u.bh=vcu>>4; u.qb=(i==0)?31-s:s; return true; }
  __device__ __forceinline__ void a_ready(const AttnUnit&)const{}
  __device__ __forceinline__ void done(const AttnUnit&)const{}
};
template<class Sched,int THRL=8> __device__ __forceinline__ void attn_phase(char*lds,const AttnTensors&T,const Sched&S){
  AttnUnit u;
  for(int i=0;S.next(i,u);++i){ S.a_ready(u); { const int p=u.bh;   attn_unit<THRL>(u.qb,T.Q+p*64,T.K+p*64,T.V+(p>>1)*128,T.O+(p&1)*1024+(p>>1)*128,lds); } S.done(u); }
}
#undef SBAR
#undef WAIT_BAR
}
#ifndef FILLER
#define FILLER 1
#endif
#ifndef PROBE_SLEEP
#define PROBE_SLEEP 0
#endif
#ifndef WIN_SPLIT
#define WIN_SPLIT 0
#endif
#ifndef LOCAL_BAR
#define LOCAL_BAR 1
#endif
#ifndef PROBE_CLK
#define PROBE_CLK 0
#endif
#ifndef PROBE_DUP
#define PROBE_DUP 0
#endif
constexpr int NWAVES = 8;
constexpr int M = 8192, D = 2048, FF = 5632, NIN = 6144, DEPTH = 4;
constexpr float EPS = 1e-5f;
__device__ const float INV_FREQ[8] = {1.0f, 0.1939227432012558f, 0.03760603070259094f, 0.007292664609849453f, 0.0014142135623842478f, 0.00027424818836152554f, 5.3182957344688475e-05f, 1.0313385246263351e-05f};
__device__ const float LAM_INIT[4] = {0.2f, 0.35550906759096934f, 0.4707130183435842f, 0.5560582041556406f};
constexpr size_t MiB = 1u << 20;
constexpr size_t WS_CTL = 0, CTL_ZERO_BYTES = 3 * MiB;
constexpr size_t WS_CS = 1 * MiB;
constexpr size_t WS_SSQ = 2 * MiB;
constexpr size_t WS_W = 3 * MiB;
constexpr size_t WO_GU1 = 0, WO_D1 = 44 * MiB, WO_IN = 66 * MiB, WO_OUT = 90 * MiB, WO_GU2 = 98 * MiB, WO_D2 = 142 * MiB, W_LAYER = 164 * MiB;
constexpr size_t WS_XB = WS_W + DEPTH * W_LAYER;
constexpr size_t WS_ACT = WS_XB + 32 * MiB;
constexpr size_t WS_Q = WS_ACT + 88 * MiB, WS_K = WS_Q + 16 * MiB, WS_V = WS_K + 16 * MiB, WS_GB = WS_V + 16 * MiB, WS_CU = WS_GB + 16 * MiB;
constexpr size_t WS_O = WS_CU + 16 * MiB;
constexpr size_t WS_MIX = WS_O + 32 * MiB;
constexpr size_t WS_END = WS_MIX + 32 * MiB;
static_assert((size_t)2 * FF * D * 2 == 44 * MiB && (size_t)FF * D * 2 == 22 * MiB && (size_t)NIN * D * 2 == 24 * MiB && (size_t)D * D * 2 == 8 * MiB && (size_t)M * FF * 2 == 88 * MiB, "d_ws map");
constexpr int CW_BAR = 4096;
constexpr int RING_OFF = 0, RING_BYTES = 131072;
constexpr int LDSCTL_OFF = RING_BYTES, MISC_OFF = LDSCTL_OFF + 320;
constexpr int LDS_BYTES = 147456;
static_assert(MISC_OFF + 128 <= pg8::RSTD_OFF && pg8::RSTD_OFF == LDSCTL_OFF + 1024 && pg8::RSTD_OFF + 1024 <= LDS_BYTES, "LDS map");
#define GAS __attribute__((address_space(1)))
#define LAS __attribute__((address_space(3)))
typedef unsigned short bf16;
typedef unsigned v4u __attribute__((ext_vector_type(4)));
typedef float f32x4 __attribute__((ext_vector_type(4)));
typedef short bf16x8 __attribute__((ext_vector_type(8)));
typedef GAS unsigned gu32;
typedef GAS unsigned long long gu64;
#define RLX_AGENT __ATOMIC_RELAXED, __HIP_MEMORY_SCOPE_AGENT
#define LDS_WAIT() asm volatile("s_waitcnt lgkmcnt(0)" ::: "memory")
#define VM_WAIT() asm volatile("s_waitcnt vmcnt(0)" ::: "memory")
__device__ __forceinline__ unsigned long long rt() { return __builtin_amdgcn_s_memrealtime(); }
__device__ __forceinline__ unsigned f2bf(float f) { unsigned u = __builtin_bit_cast(unsigned, f); return (u + 0x7fffu + ((u >> 16) & 1u)) >> 16; }
__device__ __forceinline__ unsigned pk2(float lo, float hi) { return f2bf(lo) | (f2bf(hi) << 16); }

#define XB_TMO      128
#define XB_XCNT(j)  (256  + 64 * (j))
#define XB_XSUB(j)  (1280 + 64 * (j))
#define XB_XGEN(j)  (2304 + 64 * (j))
#define XB_TOP      3328
#define XB_TOPGEN   3392
#define XCD_BAR_WORDS 3456
#define XB_SPIN_CAP (1u << 18)

__device__ __forceinline__ unsigned xb_ld(unsigned* p)              { return __hip_atomic_load(p, __ATOMIC_RELAXED, __HIP_MEMORY_SCOPE_AGENT); }
__device__ __forceinline__ unsigned xb_add(unsigned* p, unsigned v) { return __hip_atomic_fetch_add(p, v, __ATOMIC_RELAXED, __HIP_MEMORY_SCOPE_AGENT); }
__device__ __forceinline__ unsigned xb_xcc_id() { return (unsigned)__builtin_amdgcn_s_getreg((3 << 11) | 20) & 0xFu; }
#define XB_SPIN(cond, bar) do { unsigned _sp = 0; while (cond) { __builtin_amdgcn_s_sleep(1); \
    if ((++_sp & 255u) == 0u) { if (xb_ld(&(bar)[XB_TMO])) break; if (_sp > XB_SPIN_CAP) { atomicAdd(&(bar)[XB_TMO], 1u); break; } } } } while (0)

struct XcdBarrier {
    unsigned* bar; unsigned x;
    volatile LAS unsigned* st;
};

__device__ __forceinline__ XcdBarrier xcd_barrier_post(unsigned* bar, volatile LAS unsigned* st) {
    XcdBarrier b; b.bar = bar; b.x = xb_xcc_id(); b.st = st;
    if (threadIdx.x == 0) (void)xb_add(&bar[XB_XCNT(b.x)], 1u);
    return b;
}
__device__ __forceinline__ void xcd_barrier_complete(unsigned* bar, unsigned x, unsigned& nloc, unsigned& nx) {
    const unsigned G = gridDim.x * gridDim.y * gridDim.z;
    unsigned sum, cnt, mine, sp = 0u;
    for (;;) {
        sum = 0u; cnt = 0u; mine = 0u;
#pragma unroll
        for (unsigned j = 0; j < 16; ++j) { const unsigned c = xb_ld(&bar[XB_XCNT(j)]); sum += c; cnt += (c > 0u) ? 1u : 0u; mine = (j == x) ? c : mine; }
        if (sum == G) break;
        __builtin_amdgcn_s_sleep(1);
        if ((++sp & 255u) == 0u) { if (xb_ld(&bar[XB_TMO])) break; if (sp > XB_SPIN_CAP) { atomicAdd(&bar[XB_TMO], 1u); break; } }
    }
    nloc = mine > 0u ? mine : 1u; nx = cnt > 0u ? cnt : 1u;
}

__device__ __forceinline__ void xcd_barrier(const XcdBarrier& b) {
    asm volatile("s_waitcnt vmcnt(0)" ::: "memory");
    __syncthreads();
    if (threadIdx.x == 0) {
        unsigned* bar = b.bar;
        __builtin_amdgcn_s_waitcnt(0);
        unsigned nloc = b.st[0], nx = b.st[1];
        if (nloc == 0u) { xcd_barrier_complete(bar, b.x, nloc, nx); b.st[0] = nloc; b.st[1] = nx; }
        const unsigned old = xb_add(&bar[XB_XSUB(b.x)], 1u);
        const unsigned gen = old / nloc;
        if (old + 1u == (gen + 1u) * nloc) {
            __builtin_amdgcn_fence(__ATOMIC_RELEASE, "agent");
            asm volatile("s_waitcnt vmcnt(0)" ::: "memory");
            const unsigned og = xb_add(&bar[XB_TOP], 1u);
            const unsigned tg = og / nx;
            if (og + 1u == (tg + 1u) * nx) xb_add(&bar[XB_TOPGEN], 1u);
            else XB_SPIN(xb_ld(&bar[XB_TOPGEN]) == tg, bar);
            __builtin_amdgcn_fence(__ATOMIC_ACQUIRE, "agent");
            xb_add(&bar[XB_XGEN(b.x)], 1u);
            asm volatile("s_waitcnt vmcnt(0)" ::: "memory");
        } else {
            XB_SPIN(xb_ld(&bar[XB_XGEN(b.x)]) == gen, bar);
            __builtin_amdgcn_fence(__ATOMIC_ACQUIRE, "agent");
            asm volatile("s_waitcnt vmcnt(0)" ::: "memory");
        }
    }
    __syncthreads();
}

#define XB_LSUB(j)  (3456 + 64 * (j))
#define XB_LGEN(j)  (4480 + 64 * (j))
__device__ __forceinline__ void xcd_barrier_local(const XcdBarrier& b) {
    asm volatile("s_waitcnt vmcnt(0)" ::: "memory");
    __syncthreads();
    if (threadIdx.x == 0) {
        unsigned* bar = b.bar; const unsigned nloc = b.st[0];
        const unsigned old = xb_add(&bar[XB_LSUB(b.x)], 1u); const unsigned gen = old / nloc;
        if (old + 1u == (gen + 1u) * nloc) xb_add(&bar[XB_LGEN(b.x)], 1u);
        else XB_SPIN(xb_ld(&bar[XB_LGEN(b.x)]) == gen, bar);
        __builtin_amdgcn_fence(__ATOMIC_ACQUIRE, "agent");
        asm volatile("s_waitcnt vmcnt(0)" ::: "memory");
    }
    __syncthreads();
}

struct Frame {
    LAS unsigned char* lds;
    volatile LAS unsigned* MISC;
    gu32* ctl;
    int tid, lane, wave;
    int vcu, G;
};

__device__ __forceinline__ float shx(float v, int lane, int mask) { return __int_as_float(__builtin_amdgcn_ds_bpermute((lane ^ mask) << 2, __float_as_int(v))); }
__device__ __forceinline__ float wave_sum(float v, int lane) {
#pragma unroll
    for (int o = 1; o < 64; o <<= 1) v += shx(v, lane, o);
    return v;
}
__device__ __forceinline__ float bflo(unsigned w) { return __uint_as_float(w << 16); }
__device__ __forceinline__ float bfhi(unsigned w) { return __uint_as_float(w & 0xffff0000u); }

__device__ __forceinline__ int dst_row(int kind, int ns) {
    if (kind == 0) return ns;
    if (kind == 1) return 256 * (ns >> 7) + (ns & 127);
    if (kind == 2) return 256 * (ns >> 7) + 128 + (ns & 127);
    if (ns < 2048) { const int d = ns & 63; const int c = d < 8 ? 2 * d : d < 16 ? 2 * (d - 8) + 1 : d; return (ns & ~63) + c; }
    if (ns < 4096) return ns;
    if (ns < 5120) { const int j = ns - 4096; return 4096 + 256 * (j >> 7) + (j & 127); }
    { const int j = ns - 5120; return 4096 + 256 * (j >> 7) + 128 + (j & 127); }
}
struct CvtItem { const float* W; bf16* WT; const float* gain; int K, N, kind, r; };
__device__ __forceinline__ void cvt_load(const CvtItem& c, int lane, float (&t)[32]) {
    const int nblk = c.N / 32, kb = c.r / nblk, nb = c.r % nblk;
    const float* src = c.W + (size_t)(64 * kb + (lane >> 5)) * c.N + 32 * nb + (lane & 31);
#pragma unroll
    for (int i = 0; i < 32; ++i) t[i] = __builtin_nontemporal_load(src + (size_t)(2 * i) * c.N);
}
__device__ __forceinline__ void cvt_store(const CvtItem& c, int lane, LAS float* scr) {
    const int nblk = c.N / 32, kb = c.r / nblk, nb = c.r % nblk, k0 = 64 * kb, n0 = 32 * nb;
    const int ch = lane & 7;
    f32x4 ga = (f32x4){1.f, 1.f, 1.f, 1.f}, gb = ga;
    if (c.gain) { ga = *(const f32x4*)(c.gain + k0 + 8 * ch); gb = *(const f32x4*)(c.gain + k0 + 8 * ch + 4); }
#pragma unroll
    for (int j = 0; j < 4; ++j) { const int n = (lane >> 3) + 8 * j; const LAS float* s = scr + (8 * ch) * 33 + n;
        v4u o; o.x = pk2(s[0 * 33] * ga[0], s[1 * 33] * ga[1]); o.y = pk2(s[2 * 33] * ga[2], s[3 * 33] * ga[3]); o.z = pk2(s[4 * 33] * gb[0], s[5 * 33] * gb[1]); o.w = pk2(s[6 * 33] * gb[2], s[7 * 33] * gb[3]);
        *(GAS v4u*)(c.WT + (size_t)dst_row(c.kind, n0 + n) * c.K + k0 + 8 * ch) = o; }
}

__device__ __forceinline__ void stats_phase(Frame& F, const float* x, bf16* XB, unsigned long long* SSQ) {
    const int gw = F.vcu * NWAVES + F.wave, NGW = F.G * NWAVES;
    for (int m = gw; m < M; m += NGW) {
        const float* xr = x + (size_t)m * D; f32x4 v[8]; float s = 0.f;
#pragma unroll
        for (int j = 0; j < 4; ++j) { v[2 * j] = *(const GAS f32x4*)(xr + 512 * j + 8 * F.lane); v[2 * j + 1] = *(const GAS f32x4*)(xr + 512 * j + 8 * F.lane + 4); }
#pragma unroll
        for (int j = 0; j < 8; ++j) s += (v[j].x * v[j].x + v[j].y * v[j].y) + (v[j].z * v[j].z + v[j].w * v[j].w);
        s = wave_sum(s, F.lane);
        if (F.lane == 0) SSQ[m] = (unsigned long long)(s * 16777216.0f);
        bf16* hr = XB + (size_t)m * D;
#pragma unroll
        for (int j = 0; j < 4; ++j) { const f32x4 a = v[2 * j], b = v[2 * j + 1];
            v4u o; o.x = pk2(a.x, a.y); o.y = pk2(a.z, a.w); o.z = pk2(b.x, b.y); o.w = pk2(b.z, b.w);
            *(GAS v4u*)(hr + 512 * j + 8 * F.lane) = o; }
    }
}
__device__ __forceinline__ void final_norm_phase(Frame& F, const bf16* xb, const float* g, float* out) {
    const int gw = F.vcu * NWAVES + F.wave, NGW = F.G * NWAVES;
    f32x4 gv[8];
#pragma unroll
    for (int j = 0; j < 4; ++j) { gv[2 * j] = *(const f32x4*)(g + 512 * j + 8 * F.lane); gv[2 * j + 1] = *(const f32x4*)(g + 512 * j + 8 * F.lane + 4); }
    for (int m = gw; m < M; m += NGW) {
        v4u v[4]; float s = 0.f;
#pragma unroll
        for (int j = 0; j < 4; ++j) v[j] = *(const GAS v4u*)(xb + (size_t)m * D + 512 * j + 8 * F.lane);
#pragma unroll
        for (int j = 0; j < 4; ++j)
#pragma unroll
            for (int q = 0; q < 4; ++q) { const float lo = bflo(v[j][q]), hi = bfhi(v[j][q]); s += lo * lo + hi * hi; }
        const float rstd = 1.0f / sqrtf(wave_sum(s, F.lane) * (1.f / D) + EPS);
        float* orow = out + (size_t)m * D;
#pragma unroll
        for (int j = 0; j < 4; ++j) {
            const f32x4 a = (f32x4){bflo(v[j][0]), bfhi(v[j][0]), bflo(v[j][1]), bfhi(v[j][1])} * rstd * gv[2 * j], b = (f32x4){bflo(v[j][2]), bfhi(v[j][2]), bflo(v[j][3]), bfhi(v[j][3])} * rstd * gv[2 * j + 1];
            *(GAS f32x4*)(orow + 512 * j + 8 * F.lane) = a; *(GAS f32x4*)(orow + 512 * j + 8 * F.lane + 4) = b; }
    }
}
__device__ __forceinline__ void fin_phase(Frame& F, const bf16* O, const bf16* GB, const bf16* CU, bf16* MIX, const float* lq1, const float* lk1, const float* lq2, const float* lk2,
                                          const float* subw, const float* convw, float lam_init) {
    const int gw = F.vcu * NWAVES + F.wave, NGW = F.G * NWAVES, lane = F.lane;
    const float lam = expf(wave_sum(lq1[lane] * lk1[lane], lane)) - expf(wave_sum(lq2[lane] * lk2[lane], lane)) + lam_init;
    const float om = 1.0f - lam_init;
    const int c0 = 16 * lane;
    float sw[16], w0[16], w1[16], w2[16];
#pragma unroll
    for (int j = 0; j < 16; ++j) { sw[j] = subw[(c0 & 127) + j] * om; w0[j] = convw[c0 + j]; w1[j] = convw[1024 + c0 + j]; w2[j] = convw[2048 + c0 + j]; }
    for (int mb = 512 * (gw >> 8) + (gw & 255); mb < 512 * (gw >> 8) + 512; mb += 256) {
        v4u a0[2], a1[2], b0[2], b1[2], g0[2], g1[2], x0[2], x1[2], y0[2], y1[2], u0[2], u1[2];
        const v4u z = (v4u){0u, 0u, 0u, 0u};
#pragma unroll
        for (int k = 0; k < 2; ++k) { const int m = 2 * mb + k;
            a0[k] = *(const GAS v4u*)(O + (size_t)m * 2048 + c0); a1[k] = *(const GAS v4u*)(O + (size_t)m * 2048 + c0 + 8);
            b0[k] = *(const GAS v4u*)(O + (size_t)m * 2048 + 1024 + c0); b1[k] = *(const GAS v4u*)(O + (size_t)m * 2048 + 1024 + c0 + 8);
            g0[k] = *(const GAS v4u*)(GB + (size_t)m * 1024 + c0); g1[k] = *(const GAS v4u*)(GB + (size_t)m * 1024 + c0 + 8);
            x0[k] = *(const GAS v4u*)(CU + (size_t)m * 1024 + c0); x1[k] = *(const GAS v4u*)(CU + (size_t)m * 1024 + c0 + 8); }
        y0[1] = x0[0]; y1[1] = x1[0];
        y0[0] = mb >= 1 ? *(const GAS v4u*)(CU + (size_t)(2 * mb - 1) * 1024 + c0) : z; y1[0] = mb >= 1 ? *(const GAS v4u*)(CU + (size_t)(2 * mb - 1) * 1024 + c0 + 8) : z;
        u0[1] = y0[0]; u1[1] = y1[0];
        u0[0] = mb >= 1 ? *(const GAS v4u*)(CU + (size_t)(2 * mb - 2) * 1024 + c0) : z; u1[0] = mb >= 1 ? *(const GAS v4u*)(CU + (size_t)(2 * mb - 2) * 1024 + c0 + 8) : z;
#pragma unroll
        for (int k = 0; k < 2; ++k) { const int m = 2 * mb + k;
            float d[16]; float ss = 0.f;
#pragma unroll
            for (int q = 0; q < 4; ++q) { d[2 * q] = bflo(a0[k][q]) - lam * bflo(b0[k][q]); d[2 * q + 1] = bfhi(a0[k][q]) - lam * bfhi(b0[k][q]); d[8 + 2 * q] = bflo(a1[k][q]) - lam * bflo(b1[k][q]); d[8 + 2 * q + 1] = bfhi(a1[k][q]) - lam * bfhi(b1[k][q]); }
#pragma unroll
            for (int j = 0; j < 16; ++j) ss += d[j] * d[j];
            ss += shx(ss, lane, 1); ss += shx(ss, lane, 2); ss += shx(ss, lane, 4);
            const float rs = 1.0f / sqrtf(ss * (1.f / 128.f) + EPS);
            v4u o0, o1;
#pragma unroll
            for (int q = 0; q < 4; ++q) { o0[q] = pk2(d[2 * q] * rs * sw[2 * q], d[2 * q + 1] * rs * sw[2 * q + 1]); o1[q] = pk2(d[8 + 2 * q] * rs * sw[8 + 2 * q], d[8 + 2 * q + 1] * rs * sw[8 + 2 * q + 1]); }
            *(GAS v4u*)(MIX + (size_t)m * 2048 + c0) = o0; *(GAS v4u*)(MIX + (size_t)m * 2048 + c0 + 8) = o1;
            v4u p0, p1;
#pragma unroll
            for (int q = 0; q < 4; ++q) {
                const float e0 = bflo(g0[k][q]) * (w0[2 * q] * bflo(u0[k][q]) + w1[2 * q] * bflo(y0[k][q]) + w2[2 * q] * bflo(x0[k][q]));
                const float e1 = bfhi(g0[k][q]) * (w0[2 * q + 1] * bfhi(u0[k][q]) + w1[2 * q + 1] * bfhi(y0[k][q]) + w2[2 * q + 1] * bfhi(x0[k][q]));
                const float e2 = bflo(g1[k][q]) * (w0[8 + 2 * q] * bflo(u1[k][q]) + w1[8 + 2 * q] * bflo(y1[k][q]) + w2[8 + 2 * q] * bflo(x1[k][q]));
                const float e3 = bfhi(g1[k][q]) * (w0[8 + 2 * q + 1] * bfhi(u1[k][q]) + w1[8 + 2 * q + 1] * bfhi(y1[k][q]) + w2[8 + 2 * q + 1] * bfhi(x1[k][q]));
                p0[q] = pk2(e0, e1); p1[q] = pk2(e2, e3); }
            *(GAS v4u*)(MIX + (size_t)m * 2048 + 1024 + c0) = p0; *(GAS v4u*)(MIX + (size_t)m * 2048 + 1024 + c0 + 8) = p1; }
    }
}

struct Args { const float* in[19]; float* out; unsigned char* ws; };
typedef const __attribute__((address_space(4))) Args* cargs_t;
__device__ __forceinline__ cargs_t get_args() { cargs_t p = (cargs_t)__builtin_amdgcn_kernarg_segment_ptr(); asm volatile("" : "+s"(p)); return p; }
__device__ __forceinline__ int bid_o() { int b = (int)__builtin_amdgcn_readfirstlane((int)*(volatile LAS unsigned*)(size_t)(MISC_OFF + 40)); asm volatile("" : "+s"(b)); return b; }
__device__ __forceinline__ int gdim_o() { int g = gridDim.x; asm volatile("" : "+s"(g)); return g; }
__device__ __forceinline__ void make_frame(Frame& F, unsigned char* lds) {
    F.lds = (LAS unsigned char*)lds; F.MISC = (volatile LAS unsigned*)(F.lds + MISC_OFF);
    { int t_ = threadIdx.x; asm volatile("" : "+v"(t_)); F.tid = t_; } F.lane = F.tid & 63; F.wave = __builtin_amdgcn_readfirstlane(F.tid >> 6);
    F.G = gdim_o(); { const int bx = bid_o(); F.vcu = (F.G % 8 == 0) ? (bx % 8) * (F.G / 8) + bx / 8 : bx; }
    F.ctl = (gu32*)(get_args()->ws + WS_CTL);
}
__device__ __forceinline__ void grid_bar(unsigned char* lds) {
    XcdBarrier b; b.bar = (unsigned*)(get_args()->ws + WS_CTL) + CW_BAR; b.x = xb_xcc_id(); b.st = (volatile LAS unsigned*)((LAS unsigned char*)lds + MISC_OFF) + 8;
    xcd_barrier(b);
#if PROBE_BAR2
    xcd_barrier(b);
#endif
#if PROBE_SLEEP
    { const unsigned long long t0 = __builtin_amdgcn_s_memrealtime(); while (__builtin_amdgcn_s_memrealtime() - t0 < 1000ull) __builtin_amdgcn_s_sleep(32); }
#endif
}
__device__ __forceinline__ void grid_bar_local(unsigned char* lds) {
#if LOCAL_BAR
    if (*((volatile LAS unsigned*)((LAS unsigned char*)lds + MISC_OFF) + 11) == 0u) { grid_bar(lds); return; }
    XcdBarrier b; b.bar = (unsigned*)(get_args()->ws + WS_CTL) + CW_BAR; b.x = xb_xcc_id(); b.st = (volatile LAS unsigned*)((LAS unsigned char*)lds + MISC_OFF) + 8;
    xcd_barrier_local(b);
#else
    grid_bar(lds);
#endif
}
__device__ __forceinline__ unsigned char* wlayer(cargs_t a, int l) { return a->ws + WS_W + (size_t)l * W_LAYER; }

constexpr int I_G = (D / 64) * (FF / 32), I_D = (FF / 64) * (D / 32), I_IN = (D / 64) * (NIN / 32), I_OUT = (D / 64) * (D / 32), I_LAYER = 4 * I_G + 2 * I_D + I_IN + I_OUT;
constexpr int CVT_B0 = 2 * I_G, CVT_UP2 = 4 * I_G + I_D + I_IN + I_OUT;
__device__ __forceinline__ int cvt_end(int s) { const int e = CVT_UP2 + s * (I_LAYER / 2); return e < DEPTH * I_LAYER ? e : DEPTH * I_LAYER; }
__device__ __forceinline__ void cvt_decode(cargs_t a, int l, int it, CvtItem& c) {
    unsigned char* wl = a->ws + WS_W + (size_t)l * W_LAYER; int r = it;
    if (r < I_G) { c = CvtItem{a->in[2] + (size_t)l * D * FF, (bf16*)(wl + WO_GU1), a->in[1] + (size_t)l * D, D, FF, 1, r}; return; } r -= I_G;
    if (r < I_G) { c = CvtItem{a->in[3] + (size_t)l * D * FF, (bf16*)(wl + WO_GU1), a->in[1] + (size_t)l * D, D, FF, 2, r}; return; } r -= I_G;
    if (r < I_D) { c = CvtItem{a->in[4] + (size_t)l * FF * D, (bf16*)(wl + WO_D1), nullptr, FF, D, 0, r}; return; } r -= I_D;
    if (r < I_IN) { c = CvtItem{a->in[6] + (size_t)l * D * NIN, (bf16*)(wl + WO_IN), a->in[5] + (size_t)l * D, D, NIN, 3, r}; return; } r -= I_IN;
    if (r < I_OUT) { c = CvtItem{a->in[13] + (size_t)l * D * D, (bf16*)(wl + WO_OUT), nullptr, D, D, 0, r}; return; } r -= I_OUT;
    if (r < I_G) { c = CvtItem{a->in[15] + (size_t)l * D * FF, (bf16*)(wl + WO_GU2), a->in[14] + (size_t)l * D, D, FF, 1, r}; return; } r -= I_G;
    if (r < I_G) { c = CvtItem{a->in[16] + (size_t)l * D * FF, (bf16*)(wl + WO_GU2), a->in[14] + (size_t)l * D, D, FF, 2, r}; return; } r -= I_G;
    c = CvtItem{a->in[17] + (size_t)l * FF * D, (bf16*)(wl + WO_D2), nullptr, FF, D, 0, r};
}
__device__ __forceinline__ void convert_items(unsigned char* lds, int lo, int hi, int worker, int nworkers) {
    Frame F; make_frame(F, lds); cargs_t a = get_args();
    LAS float* scr = (LAS float*)(F.lds + RING_OFF + F.wave * 16384);
    int it = lo + worker; if (it >= hi) return;
    CvtItem cur, nxt; float t[32];
    cvt_decode(a, it / I_LAYER, it % I_LAYER, cur); cvt_load(cur, F.lane, t);
    for (;;) {
#pragma unroll
        for (int i = 0; i < 32; ++i) scr[(2 * i + (F.lane >> 5)) * 33 + (F.lane & 31)] = t[i];
        LDS_WAIT(); asm volatile("" ::: "memory");
        const int ni = it + nworkers; const bool more = ni < hi;
        if (more) { cvt_decode(a, ni / I_LAYER, ni % I_LAYER, nxt); cvt_load(nxt, F.lane, t); }
        cvt_store(cur, F.lane, scr);
        LDS_WAIT(); asm volatile("" ::: "memory");
        if (!more) break;
        cur = nxt; it = ni;
    }
}
__device__ __forceinline__ void ph_prologue(unsigned char* lds) {
    Frame F; make_frame(F, lds);
    convert_items(lds, 0, FILLER ? CVT_B0 : DEPTH * I_LAYER, F.vcu * NWAVES + F.wave, F.G * NWAVES);
    cargs_t a = get_args(); unsigned char* ws = a->ws;
    float* CS = (float*)(ws + WS_CS);
    for (int i = bid_o() * (NWAVES * 64) + F.tid; i < M * 8; i += F.G * NWAVES * 64) {
        const int pos = i >> 3, fi = i & 7; const float ang = (float)pos * INV_FREQ[fi];
        CS[(size_t)pos * 16 + fi] = cosf(ang); CS[(size_t)pos * 16 + 8 + fi] = sinf(ang); }
    stats_phase(F, a->in[0], (bf16*)(ws + WS_XB), (unsigned long long*)(ws + WS_SSQ));
}
__device__ __forceinline__ void ph_gateup(unsigned char* lds, int l, int second) {
    { cargs_t a = get_args(); unsigned char* ws = a->ws;
      pg8::Gemm g{(const bf16*)(ws + WS_XB), (const bf16*)(wlayer(a, l) + (second ? WO_GU2 : WO_GU1)), M, 2 * FF, D}; pg8::StaticOrder S; S.init(M, 2 * FF, gdim_o(), bid_o());
      pg8::EpiSwiGLU E{(bf16*)(ws + WS_ACT), FF, (const unsigned long long*)(ws + WS_SSQ) + (3 * l + (second ? 2 : 0)) * M};
#if PROBE_CLK == 1
      unsigned long long c0_ = __builtin_amdgcn_s_memtime(), r0_ = __builtin_amdgcn_s_memrealtime();
#endif
      pg8::gemm_phase<pg8::EpiSwiGLU, pg8::StaticOrder, PG8_ALIGN, PG8_SP2>((LAS unsigned char*)lds + RING_OFF, g, S, E);
#if PROBE_CLK == 1
      { const unsigned long long c1_ = __builtin_amdgcn_s_memtime(), r1_ = __builtin_amdgcn_s_memrealtime(); volatile LAS unsigned* MISC = (volatile LAS unsigned*)((LAS unsigned char*)lds + MISC_OFF);
        if (threadIdx.x == 0) { MISC[14] += (unsigned)((c1_ - c0_) >> 4); MISC[15] += (unsigned)(r1_ - r0_); } }
#endif
      }
    const int bx = bid_o();
    if (FILLER && bx >= 128 && gdim_o() == 256) {
        int t_ = threadIdx.x; asm volatile("" : "+v"(t_)); const int wave = __builtin_amdgcn_readfirstlane(t_ >> 6);
        const int s = 2 * l + second;
        convert_items(lds, s == 0 ? CVT_B0 : cvt_end(s - 1), cvt_end(s), (bx - 128) * NWAVES + wave, 128 * NWAVES);
#if PROBE_DUP == 5
        convert_items(lds, s == 0 ? CVT_B0 : cvt_end(s - 1), cvt_end(s), (bx - 128) * NWAVES + wave, 128 * NWAVES);
#endif
    }
}
__device__ __forceinline__ void ph_down(unsigned char* lds, int l, int second, int dummy = 0) {
    cargs_t a = get_args(); unsigned char* ws = a->ws;
    pg8::Gemm g{(const bf16*)(ws + WS_ACT), (const bf16*)(wlayer(a, l) + (second ? WO_D2 : WO_D1)), M, D, FF}; pg8::StaticOrder S; S.init(M, D, gdim_o(), bid_o());
    pg8::EpiResidual E{(bf16*)(ws + WS_XB), D, 0.5f, (unsigned long long*)(ws + WS_SSQ) + (3 * l + (second ? 3 : 1)) * M};
    pg8::gemm_phase<pg8::EpiResidual, pg8::StaticOrder, PG8_ALIGN1, PG8_SP2>((LAS unsigned char*)lds + RING_OFF, g, S, E);
}
template <int MODE> __device__ __forceinline__ void ph_win_part(unsigned char* lds, int l) {
    cargs_t a = get_args(); unsigned char* ws = a->ws;
    pg8::Gemm g{(const bf16*)(ws + WS_XB), (const bf16*)(wlayer(a, l) + WO_IN) + (size_t)MODE * 2048 * D, M, D, D}; pg8::StaticOrder S; S.init(M, D, gdim_o(), bid_o());
    pg8::EpiWin<MODE> E{(bf16*)(ws + (MODE == 0 ? WS_Q : MODE == 1 ? WS_V : WS_CU)), (bf16*)(ws + (MODE == 0 ? WS_K : WS_GB)), (const float*)(ws + WS_CS), attn_body::C2, (const unsigned long long*)(ws + WS_SSQ) + (3 * l + 1) * M};
    pg8::gemm_phase<pg8::EpiWin<MODE>, pg8::StaticOrder, PG8_ALIGN, PG8_SP2>((LAS unsigned char*)lds + RING_OFF, g, S, E);
}
#if WIN_SPLIT
__device__ __forceinline__ void ph_win(unsigned char* lds, int l) { ph_win_part<0>(lds, l); ph_win_part<1>(lds, l); ph_win_part<2>(lds, l); }
#else
__device__ __forceinline__ void ph_win(unsigned char* lds, int l) {
    cargs_t a = get_args(); unsigned char* ws = a->ws;
    const bf16* W = (const bf16*)(wlayer(a, l) + WO_IN);
    pg8::Gemm g{(const bf16*)(ws + WS_XB), W, M, D, D}; pg8::StaticOrder S; S.init(M, D, gdim_o(), bid_o());
    const float* cs = (const float*)(ws + WS_CS); const unsigned long long* ssq = (const unsigned long long*)(ws + WS_SSQ) + (3 * l + 1) * M;
    pg8::EpiWin<0> E0{(bf16*)(ws + WS_Q), (bf16*)(ws + WS_K), cs, attn_body::C2, ssq};
    pg8::EpiWin<1> E1{(bf16*)(ws + WS_V), (bf16*)(ws + WS_GB), cs, attn_body::C2, ssq};
    pg8::EpiWin<2> E2{(bf16*)(ws + WS_CU), (bf16*)(ws + WS_GB), cs, attn_body::C2, ssq};
    const bf16* W1 = W + (size_t)2048 * D; const bf16* W2 = W + (size_t)4096 * D;
    asm volatile("" : "+s"(W1), "+s"(W2));
    pg8::gemm_phase3<pg8::EpiWin<0>, pg8::EpiWin<1>, pg8::EpiWin<2>, pg8::StaticOrder, PG8_ALIGN, PG8_SP2>((LAS unsigned char*)lds + RING_OFF, g, W1, W2, S, E0, E1, E2);
}

#endif
__device__ __forceinline__ void ph_attn(unsigned char* lds) {
    unsigned char* ws = get_args()->ws;
    const attn_body::AttnTensors AT{(const attn_body::bf16*)(ws + WS_Q), (const attn_body::bf16*)(ws + WS_K), (const attn_body::bf16*)(ws + WS_V), (attn_body::bf16*)(ws + WS_O)};
    const attn_body::StaticOrder S(gdim_o(), bid_o());
    attn_body::attn_phase<attn_body::StaticOrder>((char*)lds + RING_OFF, AT, S);
}
__device__ __forceinline__ void ph_fin(unsigned char* lds, int l) {
    Frame F; make_frame(F, lds); cargs_t a = get_args(); unsigned char* ws = a->ws;
    fin_phase(F, (const bf16*)(ws + WS_O), (const bf16*)(ws + WS_GB), (const bf16*)(ws + WS_CU), (bf16*)(ws + WS_MIX), a->in[8] + l * 64, a->in[9] + l * 64, a->in[10] + l * 64, a->in[11] + l * 64,
              a->in[12] + l * 128, a->in[7] + (size_t)l * 3 * 1024, LAM_INIT[l]);
}
__device__ __forceinline__ void ph_wout(unsigned char* lds, int l) {
    cargs_t a = get_args(); unsigned char* ws = a->ws;
    pg8::Gemm g{(const bf16*)(ws + WS_MIX), (const bf16*)(wlayer(a, l) + WO_OUT), M, D, D}; pg8::StaticOrder S; S.init(M, D, gdim_o(), bid_o());
    pg8::EpiResidual E{(bf16*)(ws + WS_XB), D, 1.0f, (unsigned long long*)(ws + WS_SSQ) + (3 * l + 2) * M};
    pg8::gemm_phase<pg8::EpiResidual, pg8::StaticOrder, PG8_ALIGN1, PG8_SP2>((LAS unsigned char*)lds + RING_OFF, g, S, E);
}
__device__ __forceinline__ void ph_final(unsigned char* lds) {
    Frame F; make_frame(F, lds); cargs_t a = get_args();
    final_norm_phase(F, (const bf16*)(a->ws + WS_XB), a->in[18], a->out);
}

__global__ void __launch_bounds__(NWAVES * 64, 2) mk_fwd(Args args) {
    extern __shared__ __attribute__((aligned(16))) unsigned char lds[];
    for (int u = threadIdx.x; u < (LDS_BYTES - LDSCTL_OFF) / 4; u += NWAVES * 64) ((LAS unsigned*)((LAS unsigned char*)lds + LDSCTL_OFF))[u] = 0u;
    __syncthreads();
    { volatile LAS unsigned* MISC = (volatile LAS unsigned*)((LAS unsigned char*)lds + MISC_OFF);
      if (threadIdx.x == 0) { unsigned* bar = (unsigned*)(get_args()->ws + WS_CTL) + CW_BAR; MISC[12] = xb_add(&bar[XB_XCNT(xb_xcc_id())], 1u); MISC[10] = blockIdx.x; }
      __syncthreads(); }
    ph_prologue(lds);
    grid_bar(lds);
    { volatile LAS unsigned* MISC = (volatile LAS unsigned*)((LAS unsigned char*)lds + MISC_OFF);
      if (threadIdx.x == 0) { unsigned* bar = (unsigned*)(get_args()->ws + WS_CTL) + CW_BAR; const unsigned x = xb_xcc_id(); bool ok = gridDim.x == 256u; unsigned npop = 0u, below = 0u;
          for (unsigned j = 0; j < 16u; ++j) { const unsigned c = xb_ld(&bar[XB_XCNT(j)]); if (c != 0u && c != 32u) ok = false; if (c == 32u) { ++npop; if (j < x) ++below; } }
          if (ok && npop == 8u && LOCAL_BAR) { MISC[10] = MISC[12] * 8u + below; MISC[11] = 1u; } }
      __syncthreads(); }
#if PROBE_DUP == 4
    ph_prologue(lds);
    grid_bar(lds);
#endif
#pragma unroll 1
    for (int l = 0; l < DEPTH; ++l) {
        ph_gateup(lds, l, 0); grid_bar(lds);
#if PROBE_DUP == 1
        ph_gateup(lds, l, 0); grid_bar(lds);
#endif
        ph_down(lds, l, 0); grid_bar_local(lds);
        ph_win(lds, l); grid_bar(lds);
#if PROBE_DUP == 3
        ph_win(lds, l); grid_bar(lds);
#endif
        ph_attn(lds); grid_bar(lds);
#if PROBE_DUP == 2
        ph_attn(lds); grid_bar(lds);
#endif
        ph_fin(lds, l); grid_bar_local(lds);
        ph_wout(lds, l); grid_bar_local(lds);
        ph_gateup(lds, l, 1); grid_bar(lds);
        ph_down(lds, l, 1); if (l + 1 < DEPTH) grid_bar_local(lds); else grid_bar(lds);
    }
    ph_final(lds);
#if PROBE_CLK
    { volatile LAS unsigned* MISC = (volatile LAS unsigned*)((LAS unsigned char*)lds + MISC_OFF);
      if (blockIdx.x == 0 && threadIdx.x == 0) { const unsigned long long tgt = (unsigned long long)MISC[14] * 16ull * 5000ull / (unsigned long long)(MISC[15] ? MISC[15] : 1u);
          const unsigned long long t0 = __builtin_amdgcn_s_memrealtime(); while (__builtin_amdgcn_s_memrealtime() - t0 < tgt) __builtin_amdgcn_s_sleep(32); } }
#endif
}

extern "C" void kernel_launch(void* const* d_in, const int* in_sizes, int n_in, void* d_out, int out_size, void* d_ws, size_t ws_size, hipStream_t stream) {
    static int grid = 0;
    if (grid == 0) {
        if (n_in != 19 || in_sizes[0] != M * D || out_size != M * D || ws_size < WS_END) { fprintf(stderr, "kernel_launch: built for 19 inputs, x and out of %d floats, >= %zu bytes of workspace; got n_in %d, in0 %d, out %d, ws %zu; nothing launched\n", M * D, (size_t)WS_END, n_in, n_in > 0 ? in_sizes[0] : -1, out_size, ws_size); grid = -1; return; }
        int dev = 0, cus = 0, per_cu = 0;
        if (hipGetDevice(&dev) != hipSuccess || hipDeviceGetAttribute(&cus, hipDeviceAttributeMultiprocessorCount, dev) != hipSuccess) { fprintf(stderr, "kernel_launch: hipGetDevice / hipDeviceGetAttribute failed; nothing launched\n"); grid = -1; return; }
        if (hipFuncSetAttribute((const void*)mk_fwd, hipFuncAttributeMaxDynamicSharedMemorySize, LDS_BYTES) != hipSuccess) { fprintf(stderr, "kernel_launch: hipFuncSetAttribute failed\n"); grid = -1; return; }
        if (hipOccupancyMaxActiveBlocksPerMultiprocessor(&per_cu, (const void*)mk_fwd, NWAVES * 64, LDS_BYTES) != hipSuccess || per_cu < 1)
            fprintf(stderr, "kernel_launch: note: the occupancy query reports %d workgroups per CU\n", per_cu);
        (void)hipGetLastError();
        grid = 256;
        if (cus != 256) fprintf(stderr, "kernel_launch: device has %d CUs; this kernel is built for 256\n", cus);
    }
    if (grid < 0) return;
    if (hipMemsetAsync((char*)d_ws + WS_CTL, 0, CTL_ZERO_BYTES, stream) != hipSuccess) { fprintf(stderr, "kernel_launch: hipMemsetAsync of the control words failed; nothing launched\n"); return; }
    Args a{};
    for (int i = 0; i < 19; ++i) a.in[i] = (const float*)d_in[i];
    a.out = (float*)d_out; a.ws = (unsigned char*)d_ws;
    hipLaunchKernelGGL(mk_fwd, dim3(grid), dim3(NWAVES * 64), LDS_BYTES, stream, a);
    const hipError_t le = hipPeekAtLastError();
    if (le != hipSuccess) fprintf(stderr, "kernel_launch: launch failed: %s\n", hipGetErrorName(le));
}
```

```cpp
#define PG8_MV 1
#include <hip/hip_runtime.h>
#include <cstdio>
#include <cstdint>
#ifndef PG8_WGM
#define PG8_WGM 4
#endif
namespace pg8 {
#define PG8_LAS __attribute__((address_space(3)))
typedef unsigned short bf16_t;
typedef short bf16x8 __attribute__((ext_vector_type(8)));
typedef float f32x4 __attribute__((ext_vector_type(4)));
typedef unsigned u32x4 __attribute__((ext_vector_type(4)));
constexpr int BM = 256, BK = 64, HALF = 128, HTB = HALF * BK * 2  , STAGE_BYTES = 8 * HTB, NXCD = 8, WGM = PG8_WGM;

__host__ __device__ __forceinline__ int lds_byte(int r, int c) { const int st = (r >> 4) * 2 + (c >> 5), rr = r & 15, cc = c & 31, ob = rr * 64 + cc * 2; return st * 1024 + (ob ^ (((ob >> 9) & 1) << 5)); }
__host__ __device__ __forceinline__ void stage_rc(int b, int& R, int& C) { const int st = b / 1024, sb = b % 1024, swz = sb ^ (((sb >> 9) & 1) << 5); R = (st >> 1) * 16 + swz / 64; C = (st & 1) * 32 + (swz % 64) / 2; }
__host__ __device__ __forceinline__ int perm32(int rho) { const int n = rho >> 4, i = rho & 15; return 8 * (i >> 2) + 4 * n + (i & 3); }

struct Unit { int pm, pn; };
struct Gemm { const bf16_t* A; const bf16_t* Bt; int M, N, K; };

struct StaticOrder {
    int nM, nN, nwg, G, c;
    __host__ __device__ void init(int M, int N, int G_, int c_) { nM = M / BM; nN = N / BM; nwg = nM * nN; G = G_; c = c_; }
    __host__ __device__ bool next(int i, Unit& u) const {
        const long L = (long)i * G + c; if (L >= nwg) return false;
        int wgid = (int)L; { const int q = nwg / NXCD, r = nwg % NXCD, xcd = wgid % NXCD, off = wgid / NXCD; wgid = (xcd < r ? xcd * (q + 1) : r * (q + 1) + (xcd - r) * q) + off; }
        const int nig = WGM * nN, gid = wgid / nig, fm = gid * WGM, gsz = (nM - fm) < WGM ? (nM - fm) : WGM;
        u.pm = fm + ((wgid % nig) % gsz); u.pn = (wgid % nig) / gsz; return true;
    }
    __device__ __forceinline__ void a_ready(const Unit&) const {}
    __device__ __forceinline__ void done(const Unit&) const {}
};

__device__ __forceinline__ unsigned cvt_pk_bf16(float lo, float hi) { unsigned r; asm volatile("v_cvt_pk_bf16_f32 %0, %1, %2" : "=v"(r) : "v"(lo), "v"(hi)); return r; }
typedef float f32x2 __attribute__((ext_vector_type(2)));
#define PG8_GAS __attribute__((address_space(1)))
__device__ __forceinline__ int lane_now() { int l; asm volatile("v_mbcnt_lo_u32_b32 %0, -1, 0\n\tv_mbcnt_hi_u32_b32 %0, -1, %0" : "=v"(l)); return l; }
__device__ __forceinline__ float sum_fq(float s, int fr, int fq) { const int l4 = (fr + 16 * fq) << 2;
    s += __int_as_float(__builtin_amdgcn_ds_bpermute(l4 ^ 64, __float_as_int(s))); s += __int_as_float(__builtin_amdgcn_ds_bpermute(l4 ^ 128, __float_as_int(s))); return s; }
__device__ __forceinline__ float silu_f(float g) { const float e = __builtin_amdgcn_exp2f(g * -1.4426950408889634f); return g * __builtin_amdgcn_rcpf(1.0f + e); }

__device__ __forceinline__ void row_rstd(const unsigned long long* ssq, int row0, float (&rs)[2][4]) {
#pragma unroll
    for (int ai = 0; ai < 2; ++ai)
#pragma unroll
        for (int m = 0; m < 4; ++m) { const unsigned long long v = *(const PG8_GAS unsigned long long*)(ssq + (unsigned)(row0 + ai * HALF + m * 16));
            const float s = (float)(unsigned)(v >> 24) + (float)((unsigned)v & 0xffffffu) * (1.0f / 16777216.0f);
            rs[ai][m] = __builtin_amdgcn_rsqf(s * (1.0f / 2048.0f) + 1e-5f); }
}
constexpr int RSTD_OFF = 131072 + 1024;
__device__ __forceinline__ unsigned long long rstd_fetch(const unsigned long long* ssq, int row) { return *(const PG8_GAS unsigned long long*)(ssq + (unsigned)row); }
__device__ __forceinline__ void rstd_put(unsigned long long v, int slot) {
    const float s = (float)(unsigned)(v >> 24) + (float)((unsigned)v & 0xffffffu) * (1.0f / 16777216.0f);
    *(PG8_LAS float*)(size_t)(RSTD_OFF + 4 * slot) = __builtin_amdgcn_rsqf(s * (1.0f / 2048.0f) + 1e-5f);
}
__device__ __forceinline__ void row_rstd_tab(int rl0, float (&rs)[2][4]) {
#pragma unroll
    for (int ai = 0; ai < 2; ++ai)
#pragma unroll
        for (int m = 0; m < 4; ++m) rs[ai][m] = *(const PG8_LAS float*)(size_t)(RSTD_OFF + 4 * (rl0 + ai * HALF + m * 16));
}
__device__ __forceinline__ void pin_acc(f32x4 (&acc)[2][2][4][2]) {
#pragma unroll
    for (int ai = 0; ai < 2; ++ai)
#pragma unroll
        for (int m = 0; m < 4; ++m) asm volatile("" : "+v"(acc[ai][0][m][0]), "+v"(acc[ai][0][m][1]), "+v"(acc[ai][1][m][0]), "+v"(acc[ai][1][m][1]));
}
struct EpiSwiGLU {
    static constexpr bool PERM = true, AFTER_DRAIN = false, RSTD = true;
    bf16_t* O; int ldc; const unsigned long long* ssq;
    __device__ __forceinline__ void operator()(f32x4 (&acc)[2][2][4][2], const Unit& u, int wr, int wc, int fr, int fq, int pm_tab) const {
        const int row0 = u.pm * BM + wr * 64 + fr, col0 = u.pn * HALF + wc * 32 + 8 * fq;
        float rs[2][4]; if (u.pm == pm_tab) row_rstd_tab(wr * 64 + fr, rs); else row_rstd(ssq, row0, rs);
#pragma unroll
        for (int ai = 0; ai < 2; ++ai)
#pragma unroll
            for (int m = 0; m < 4; ++m) { bf16_t* rowp = O + (unsigned)((row0 + ai * HALF + m * 16) * ldc + col0);
                const float r_ = rs[ai][m]; const f32x2 ce = (f32x2){r_, r_} * -1.4426950408889634f, r2 = (f32x2){r_, r_} * (f32x2){r_, r_};
                u32x4 w;
#pragma unroll
                for (int h = 0; h < 4; ++h) { const f32x4 gq = acc[ai][0][m][h >> 1], uq = acc[ai][1][m][h >> 1];
                    const f32x2 g = (h & 1) ? (f32x2){gq[2], gq[3]} : (f32x2){gq[0], gq[1]}, u2 = (h & 1) ? (f32x2){uq[2], uq[3]} : (f32x2){uq[0], uq[1]};
                    f32x2 e = g * ce; e = (f32x2){__builtin_amdgcn_exp2f(e[0]), __builtin_amdgcn_exp2f(e[1])} + 1.0f; e = (f32x2){__builtin_amdgcn_rcpf(e[0]), __builtin_amdgcn_rcpf(e[1])};
                    const f32x2 o = (g * u2) * (r2 * e); w[h] = cvt_pk_bf16(o[0], o[1]); }
                *(PG8_GAS u32x4*)rowp = w; __builtin_amdgcn_sched_barrier(0); }
    }
};
struct EpiResidual {
    static constexpr bool PERM = true, AFTER_DRAIN = false, RSTD = false;
    bf16_t* xb; int ldc; float scale; unsigned long long* ssq;
    __device__ __forceinline__ void operator()(f32x4 (&acc)[2][2][4][2], const Unit& u, int wr, int wc, int fr, int fq, int pm_tab) const {
        const int row0 = u.pm * BM + wr * 64 + fr, col0 = u.pn * BM + wc * 32 + 8 * fq;
        u32x4 nb[2][2];
#pragma unroll
        for (int p = 0; p < 2; ++p)
#pragma unroll
            for (int bj = 0; bj < 2; ++bj) nb[p][bj] = *(const PG8_GAS u32x4*)(xb + (unsigned)((row0 + p * 16) * ldc + col0 + bj * HALF));
#pragma unroll
        for (int g = 0; g < 8; ++g) { const int ai = g >> 2, m = g & 3;
            u32x4 cb[2];
#pragma unroll
            for (int bj = 0; bj < 2; ++bj) cb[bj] = nb[g & 1][bj];
            asm volatile("" ::: "memory");
            if (g < 6) { const unsigned off = (unsigned)((row0 + ((g + 2) >> 2) * HALF + ((g + 2) & 3) * 16) * ldc + col0);
#pragma unroll
                for (int bj = 0; bj < 2; ++bj) nb[g & 1][bj] = *(const PG8_GAS u32x4*)(xb + (off + bj * HALF)); }
#pragma unroll
            for (int bj = 0; bj < 2; ++bj) { const u32x4 x = cb[bj];
                acc[ai][bj][m][0] = (f32x4){__uint_as_float(x.x << 16), __uint_as_float(x.x & 0xffff0000u), __uint_as_float(x.y << 16), __uint_as_float(x.y & 0xffff0000u)} + acc[ai][bj][m][0] * scale;
                acc[ai][bj][m][1] = (f32x4){__uint_as_float(x.z << 16), __uint_as_float(x.z & 0xffff0000u), __uint_as_float(x.w << 16), __uint_as_float(x.w & 0xffff0000u)} + acc[ai][bj][m][1] * scale; }
            asm volatile("" : "+v"(acc[ai][0][m][0]), "+v"(acc[ai][0][m][1]), "+v"(acc[ai][1][m][0]), "+v"(acc[ai][1][m][1])); }
        asm volatile("" ::: "memory");
#pragma unroll
        for (int ai = 0; ai < 2; ++ai)
#pragma unroll
            for (int m = 0; m < 4; ++m) { const int row = row0 + ai * HALF + m * 16; const unsigned off = (unsigned)(row * ldc + col0); float s = 0.f;
#pragma unroll
                for (int bj = 0; bj < 2; ++bj) { const f32x4 a0 = acc[ai][bj][m][0], a1 = acc[ai][bj][m][1];
                    u32x4 w; w.x = cvt_pk_bf16(a0[0], a0[1]); w.y = cvt_pk_bf16(a0[2], a0[3]); w.z = cvt_pk_bf16(a1[0], a1[1]); w.w = cvt_pk_bf16(a1[2], a1[3]);
                    *(PG8_GAS u32x4*)(xb + (off + bj * HALF)) = w;
#pragma unroll
                    for (int q = 0; q < 4; ++q) { const float lo = __uint_as_float(w[q] << 16), hi = __uint_as_float(w[q] & 0xffff0000u); s += lo * lo + hi * hi; } }
                s = sum_fq(s, fr, fq);
                if (fq == 0) (void)__hip_atomic_fetch_add(ssq + (unsigned)row, (unsigned long long)(s * 16777216.0f), __ATOMIC_RELAXED, __HIP_MEMORY_SCOPE_AGENT); }
    }
};
template <int MODE> struct EpiWin {
    static constexpr bool PERM = true, AFTER_DRAIN = false, RSTD = true;
    bf16_t *O0, *O1; const float* cs; float qscale; const unsigned long long* ssq;
    __device__ __forceinline__ void operator()(f32x4 (&acc)[2][2][4][2], const Unit& u, int wr, int wc, int fr, int fq, int pm_tab) const {
        const int row0 = u.pm * BM + wr * 64 + fr; const int pn = u.pn;
        float rs[2][4]; if (u.pm == pm_tab) row_rstd_tab(wr * 64 + fr, rs); else row_rstd(ssq, row0, rs);
        if constexpr (MODE == 2) {
            const int col0 = pn * HALF + wc * 32 + 8 * fq;
#pragma unroll
            for (int ai = 0; ai < 2; ++ai)
#pragma unroll
                for (int m = 0; m < 4; ++m) { bf16_t* rowp = O0 + (unsigned)((row0 + ai * HALF + m * 16) * 1024 + col0);
                    const float r2 = rs[ai][m] * rs[ai][m]; const f32x4 a0 = acc[ai][0][m][0] * acc[ai][1][m][0] * r2, a1 = acc[ai][0][m][1] * acc[ai][1][m][1] * r2;
                    u32x4 w; w.x = cvt_pk_bf16(a0[0], a0[1]); w.y = cvt_pk_bf16(a0[2], a0[3]); w.z = cvt_pk_bf16(a1[0], a1[1]); w.w = cvt_pk_bf16(a1[2], a1[3]);
                    *(PG8_GAS u32x4*)rowp = w; }
        } else {
            const int col0 = (pn & 3) * BM + wc * 32 + 8 * fq;
            bf16_t* base = pn < 4 ? O0 : O1; const float sc = (MODE == 0 && pn < 4) ? qscale : 1.0f;
            if constexpr (MODE == 0) {
                const bool rope = ((wc & 1) == 0) && (fq < 2); const int fo = 4 * (fq & 1);
#pragma unroll
                for (int ai = 0; ai < 2; ++ai) { f32x4 c[4], s[4];
#pragma unroll
                    for (int m = 0; m < 4; ++m) { const int row = row0 + ai * HALF + m * 16; c[m] = *(const PG8_GAS f32x4*)(cs + (unsigned)(row * 16 + fo)); s[m] = *(const PG8_GAS f32x4*)(cs + (unsigned)(row * 16 + 8 + fo));
                        if (!rope) { c[m] = (f32x4){1.f, 1.f, 1.f, 1.f}; s[m] = (f32x4){0.f, 0.f, 0.f, 0.f}; } }
#pragma unroll
                    for (int m = 0; m < 4; ++m) {
#pragma unroll
                        for (int bj = 0; bj < 2; ++bj) { const f32x4 v0 = acc[ai][bj][m][0], v1 = acc[ai][bj][m][1], cc = c[m], ss = s[m]; f32x4 o0, o1;
                            o0[0] = v0[0] * cc[0] - v0[1] * ss[0]; o0[1] = v0[1] * cc[0] + v0[0] * ss[0]; o0[2] = v0[2] * cc[1] - v0[3] * ss[1]; o0[3] = v0[3] * cc[1] + v0[2] * ss[1];
                            o1[0] = v1[0] * cc[2] - v1[1] * ss[2]; o1[1] = v1[1] * cc[2] + v1[0] * ss[2]; o1[2] = v1[2] * cc[3] - v1[3] * ss[3]; o1[3] = v1[3] * cc[3] + v1[2] * ss[3];
                            acc[ai][bj][m][0] = o0; acc[ai][bj][m][1] = o1; }
                        asm volatile("" : "+v"(acc[ai][0][m][0]), "+v"(acc[ai][0][m][1]), "+v"(acc[ai][1][m][0]), "+v"(acc[ai][1][m][1])); }
                    asm volatile("" ::: "memory"); }
            }
#pragma unroll
            for (int ai = 0; ai < 2; ++ai)
#pragma unroll
                for (int m = 0; m < 4; ++m) { const int row = row0 + ai * HALF + m * 16; bf16_t* rowp = base + (unsigned)(row * 1024 + col0); const float f = sc * rs[ai][m];
#pragma unroll
                    for (int bj = 0; bj < 2; ++bj) { const f32x4 o0 = acc[ai][bj][m][0] * f, o1 = acc[ai][bj][m][1] * f;
                        u32x4 w; w.x = cvt_pk_bf16(o0[0], o0[1]); w.y = cvt_pk_bf16(o0[2], o0[3]); w.z = cvt_pk_bf16(o1[0], o1[1]); w.w = cvt_pk_bf16(o1[2], o1[3]);
                        *(PG8_GAS u32x4*)(rowp + bj * HALF) = w; } }
        }
    }
};

#ifndef PG8_MV
#define PG8_MV 0
#endif
__device__ __forceinline__ void glds16_s(const void* gbase, unsigned voff, unsigned lds_dst) {
    asm volatile("s_mov_b32 m0, %2\n\ts_nop 0\n\tglobal_load_lds_dwordx4 %0, %1" :: "v"(voff), "s"(gbase), "s"(lds_dst) : "memory", "m0");
}
template <bool B> struct ZTag { static constexpr bool value = B; };
template <class Epi, class Sched, bool ALIGN_EPI = false, bool SP2 = false>
__device__ __forceinline__ void gemm_phase(PG8_LAS unsigned char* lds, const Gemm g, const Sched& S, const Epi& E) {
    int tid_ = threadIdx.x; asm volatile("" : "+v"(tid_));
    const int tid = tid_, wid = __builtin_amdgcn_readfirstlane(tid >> 6), lane = tid & 63, wr = wid >> 2, wc = wid & 3, fr = lane & 15, fq = lane >> 4;
    constexpr bool RSTD_ = Epi::RSTD; const unsigned long long* SSQ_ = nullptr; if constexpr (RSTD_) SSQ_ = E.ssq;
    const int K = g.K, nt = K / BK;
    unsigned voffA[2], voffB[2];
#pragma unroll
    for (int i = 0; i < 2; ++i) { int R, C; stage_rc(tid * 16 + i * 8192, R, C); const int Rb = Epi::PERM ? ((R & ~31) + perm32(R & 31)) : R;
        voffA[i] = (unsigned)(R * K + C) * 2u; voffB[i] = (unsigned)(Rb * K + C) * 2u; }
    const size_t kstep = (size_t)(BK * 2);
    const size_t hstep = (size_t)HALF * K * 2;
    const size_t tstep = 2 * hstep;
    const unsigned ldsw = (unsigned)wid * 1024u;
    const unsigned ldsb = (unsigned)__builtin_amdgcn_readfirstlane((int)((unsigned)(size_t)lds + ldsw));
    const int aoff = lds_byte(wr * 64 + fr, fq * 8); int boff = lds_byte(wc * 32 + fr, fq * 8) + 4 * HTB;
    asm volatile("" : "+v"(boff));
#define PG8_SA(b, h) (((b) * 2 + (h)) * HTB)
#define PG8_SB(b, h) ((4 + (b) * 2 + (h)) * HTB)
#define PG8_SBR(b, h) (((b) * 2 + (h)) * HTB)
#define PG8_STAGE(bufoff, gbase, voff) do { _Pragma("unroll") for (int _i = 0; _i < 2; ++_i) \
        glds16_s((gbase), (voff)[_i], ldsb + (unsigned)((bufoff) + _i * 8192)); } while (0)
#define PG8_STAGE1(bufoff, gbase, voff, i) glds16_s((gbase), (voff)[i], ldsb + (unsigned)((bufoff) + (i) * 8192))
#define PG8_LDA(dst, b, h) do { _Pragma("unroll") for (int m = 0; m < 4; ++m) _Pragma("unroll") for (int k = 0; k < 2; ++k) dst[m][k] = *(const PG8_LAS bf16x8*)(lds + PG8_SA(b, h) + aoff + m * 2048 + k * 1024); } while (0)
#define PG8_LDB(dst, b, h) do { _Pragma("unroll") for (int n = 0; n < 2; ++n) _Pragma("unroll") for (int k = 0; k < 2; ++k) dst[n][k] = *(const PG8_LAS bf16x8*)(lds + PG8_SBR(b, h) + boff + n * 2048 + k * 1024); } while (0)
#define PG8_MMA(ai, bj, At, Bt) do { __builtin_amdgcn_s_setprio(1); _Pragma("unroll") for (int m = 0; m < 4; ++m) _Pragma("unroll") for (int n = 0; n < 2; ++n) _Pragma("unroll") for (int k = 0; k < 2; ++k) \
        acc[ai][bj][m][n] = __builtin_amdgcn_mfma_f32_16x16x32_bf16(Bt[n][k], At[m][k], acc[ai][bj][m][n], 0, 0, 0); __builtin_amdgcn_s_setprio(0); } while (0)
#define PG8_MMAZ(Z, ai, bj, At, Bt) do { if constexpr (Z) { __builtin_amdgcn_s_setprio(1); _Pragma("unroll") for (int m = 0; m < 4; ++m) _Pragma("unroll") for (int n = 0; n < 2; ++n) { \
        acc[ai][bj][m][n] = __builtin_amdgcn_mfma_f32_16x16x32_bf16(Bt[n][0], At[m][0], (f32x4){0.f, 0.f, 0.f, 0.f}, 0, 0, 0); acc[ai][bj][m][n] = __builtin_amdgcn_mfma_f32_16x16x32_bf16(Bt[n][1], At[m][1], acc[ai][bj][m][n], 0, 0, 0); } \
        __builtin_amdgcn_s_setprio(0); } else PG8_MMA(ai, bj, At, Bt); } while (0)
#define PG8_WAIT_V(n) asm volatile("s_waitcnt vmcnt(" #n ")" ::: "memory")
#define PG8_WAIT_L(n) asm volatile("s_waitcnt lgkmcnt(" #n ")" ::: "memory")
#define PG8_BAR __builtin_amdgcn_s_barrier()
#define PG8_SCHED __builtin_amdgcn_sched_barrier(0)
    Unit cur, nxt; int ui = 0;
    if (!S.next(0, cur)) return;
    f32x4 acc[2][2][4][2];
    bf16x8 At[4][2], B0[2][2], B1[2][2];
    const char* cA = (const char*)g.A + (size_t)cur.pm * tstep; const char* cB = (const char*)g.Bt + (size_t)cur.pn * tstep;
    S.a_ready(cur);
    const int pm0 = cur.pm;
    unsigned long long sv_ = 0ull; if constexpr (RSTD_) sv_ = rstd_fetch(SSQ_, pm0 * BM + (tid & 255));
    if constexpr (SP2) {
        PG8_STAGE(PG8_SB(0, 0), cB, voffB); PG8_STAGE(PG8_SB(0, 1), cB + hstep, voffB); PG8_STAGE(PG8_SA(0, 0), cA, voffA); PG8_STAGE(PG8_SA(0, 1), cA + hstep, voffA);
        if (wr == 1) PG8_BAR;
        PG8_WAIT_V(2); PG8_BAR;
        if constexpr (RSTD_) { if (tid < 256) rstd_put(sv_, tid); }
        if (PG8_MV) { PG8_STAGE(PG8_SB(1, 0), cB + kstep, voffB); PG8_STAGE(PG8_SB(1, 1), cB + hstep + kstep, voffB); PG8_STAGE1(PG8_SA(1, 0), cA + kstep, voffA, 0); PG8_WAIT_V(5); }
        else { PG8_STAGE(PG8_SB(1, 0), cB + kstep, voffB); PG8_STAGE(PG8_SA(1, 0), cA + kstep, voffA); PG8_STAGE(PG8_SB(1, 1), cB + hstep + kstep, voffB); PG8_WAIT_V(6); }
        PG8_BAR;
    } else {
        PG8_STAGE(PG8_SB(0, 0), cB, voffB); PG8_STAGE(PG8_SA(0, 0), cA, voffA); PG8_STAGE(PG8_SB(0, 1), cB + hstep, voffB); PG8_STAGE(PG8_SA(0, 1), cA + hstep, voffA);
        if (wr == 1) PG8_BAR;
        PG8_WAIT_V(4); PG8_BAR;
        if constexpr (RSTD_) { if (tid < 256) rstd_put(sv_, tid); }
        PG8_STAGE(PG8_SB(1, 0), cB + kstep, voffB); PG8_STAGE(PG8_SA(1, 0), cA + kstep, voffA); PG8_STAGE(PG8_SB(1, 1), cB + hstep + kstep, voffB);
        PG8_WAIT_V(6); PG8_BAR;
    }
    for (;;) {
        const bool has_next = S.next(ui + 1, nxt);
        const char* nA = has_next ? (const char*)g.A + (size_t)nxt.pm * tstep : cA; const char* nB = has_next ? (const char*)g.Bt + (size_t)nxt.pn * tstep : cB;
        auto kpair = [&](auto ztag, const int t) __attribute__((always_inline)) {
            constexpr bool Z = decltype(ztag)::value;
            const bool last = (t == nt - 2);
            const char* a1 = cA + (size_t)(t + 1) * kstep;
            const char* a2 = last ? nA : cA + (size_t)(t + 2) * kstep; const char* b2 = last ? nB : cB + (size_t)(t + 2) * kstep;
            const char* a3 = a2 + kstep; const char* b3 = b2 + kstep;
            if (last && has_next) S.a_ready(nxt);
            if constexpr (SP2) {
            PG8_LDB(B0, 0, 0); PG8_LDB(B1, 0, 1); PG8_SCHED; PG8_LDA(At, 0, 0); if (PG8_MV) PG8_STAGE1(PG8_SA(1, 0), a1, voffA, 1); PG8_STAGE(PG8_SA(1, 1), a1 + hstep, voffA);
            PG8_WAIT_V(8); PG8_WAIT_L(0); PG8_BAR; PG8_MMAZ(Z, 0, 0, At, B0); PG8_MMAZ(Z, 0, 1, At, B1); PG8_BAR; PG8_SCHED;
            PG8_LDA(At, 0, 1); PG8_STAGE(PG8_SB(0, 0), b2, voffB); PG8_STAGE(PG8_SB(0, 1), b2 + hstep, voffB); if (PG8_MV) PG8_STAGE1(PG8_SA(0, 0), a2, voffA, 0); else PG8_STAGE(PG8_SA(0, 0), a2, voffA);
            if (PG8_MV) PG8_WAIT_V(7); else PG8_WAIT_V(8); PG8_WAIT_L(0); PG8_BAR; PG8_MMAZ(Z, 1, 0, At, B0); PG8_MMAZ(Z, 1, 1, At, B1); PG8_BAR; PG8_SCHED;
            PG8_LDB(B0, 1, 0); PG8_LDB(B1, 1, 1); PG8_SCHED; PG8_LDA(At, 1, 0); if (PG8_MV) PG8_STAGE1(PG8_SA(0, 0), a2, voffA, 1); PG8_STAGE(PG8_SA(0, 1), a2 + hstep, voffA);
            PG8_WAIT_V(8); PG8_WAIT_L(0); PG8_BAR; PG8_MMA(0, 0, At, B0); PG8_MMA(0, 1, At, B1); PG8_BAR; PG8_SCHED;
            PG8_LDA(At, 1, 1); PG8_STAGE(PG8_SB(1, 0), b3, voffB); PG8_STAGE(PG8_SB(1, 1), b3 + hstep, voffB); if (PG8_MV) PG8_STAGE1(PG8_SA(1, 0), a3, voffA, 0); else PG8_STAGE(PG8_SA(1, 0), a3, voffA);
            if (PG8_MV) PG8_WAIT_V(7); else PG8_WAIT_V(8); PG8_WAIT_L(0); PG8_BAR; PG8_MMA(1, 0, At, B0); PG8_MMA(1, 1, At, B1); PG8_BAR; PG8_SCHED;
            } else {
            PG8_LDB(B0, 0, 0); PG8_SCHED; PG8_LDA(At, 0, 0); PG8_STAGE(PG8_SA(1, 1), a1 + hstep, voffA);
            PG8_WAIT_L(8); PG8_BAR; PG8_WAIT_L(0); PG8_MMAZ(Z, 0, 0, At, B0); PG8_BAR; PG8_SCHED;
            PG8_LDB(B1, 0, 1); PG8_STAGE(PG8_SB(0, 0), b2, voffB);
            PG8_BAR; PG8_WAIT_L(0); PG8_MMAZ(Z, 0, 1, At, B1); PG8_BAR;
            PG8_LDA(At, 0, 1); PG8_STAGE(PG8_SA(0, 0), a2, voffA);
            PG8_BAR; PG8_WAIT_L(0); PG8_MMAZ(Z, 1, 0, At, B0); PG8_BAR; PG8_SCHED;
            PG8_STAGE(PG8_SB(0, 1), b2 + hstep, voffB);
            PG8_WAIT_V(6); PG8_BAR; PG8_MMAZ(Z, 1, 1, At, B1); PG8_BAR;
            PG8_LDB(B0, 1, 0); PG8_SCHED; PG8_LDA(At, 1, 0); PG8_STAGE(PG8_SA(0, 1), a2 + hstep, voffA);
            PG8_WAIT_L(8); PG8_BAR; PG8_WAIT_L(0); PG8_MMA(0, 0, At, B0); PG8_BAR; PG8_SCHED;
            PG8_LDB(B1, 1, 1); PG8_STAGE(PG8_SB(1, 0), b3, voffB);
            PG8_BAR; PG8_WAIT_L(0); PG8_MMA(0, 1, At, B1); PG8_BAR;
            PG8_LDA(At, 1, 1); PG8_STAGE(PG8_SA(1, 0), a3, voffA);
            PG8_BAR; PG8_WAIT_L(0); PG8_MMA(1, 0, At, B0); PG8_BAR; PG8_SCHED;
            PG8_STAGE(PG8_SB(1, 1), b3 + hstep, voffB);
            PG8_WAIT_V(6); PG8_BAR; PG8_MMA(1, 1, At, B1); PG8_BAR;
            }
        };
        kpair(ZTag<true>{}, 0);
        for (int t = 2; t < nt; t += 2) kpair(ZTag<false>{}, t);
        if constexpr (ALIGN_EPI) { if (wr == 0) PG8_BAR; }
        if constexpr (!Epi::AFTER_DRAIN) { E(acc, cur, wr, wc, fr, fq, pm0); S.done(cur); }
        if (!has_next) break;
        cur = nxt; cA = nA; cB = nB; ++ui;
        if constexpr (ALIGN_EPI) { if (wr == 1) PG8_BAR; }
    }
    PG8_WAIT_V(0);
    if constexpr (!ALIGN_EPI) { if (wr == 0) PG8_BAR; }
    PG8_BAR;
    if constexpr (Epi::AFTER_DRAIN) { E.fused(acc, cur, wr, wc, fr, fq, lds, wid, lane); S.done(cur); }
#undef PG8_SA
#undef PG8_SB
#undef PG8_SBR
#undef PG8_STAGE
#undef PG8_STAGE1
#undef PG8_LDA
#undef PG8_LDB
#undef PG8_MMA
#undef PG8_MMAZ
#undef PG8_WAIT_V
#undef PG8_WAIT_L
#undef PG8_BAR
#undef PG8_SCHED
}
template <class E0, class E1, class E2, class Sched, bool ALIGN_EPI = false, bool SP2 = false>
__device__ __forceinline__ void gemm_phase3(PG8_LAS unsigned char* lds, const Gemm g, const bf16_t* Bt1, const bf16_t* Bt2, const Sched& S, const E0& e0, const E1& e1, const E2& e2) {
    int tid_ = threadIdx.x; asm volatile("" : "+v"(tid_));
    const int tid = tid_, wid = __builtin_amdgcn_readfirstlane(tid >> 6), lane = tid & 63, wr = wid >> 2, wc = wid & 3, fr = lane & 15, fq = lane >> 4;
    constexpr bool RSTD_ = E0::RSTD; static_assert(E0::RSTD == E1::RSTD && E1::RSTD == E2::RSTD, "one rstd table"); const unsigned long long* SSQ_ = nullptr; if constexpr (RSTD_) SSQ_ = e0.ssq;
    const int K = g.K, nt = K / BK;
    unsigned voffA[2], voffB[2];
#pragma unroll
    for (int i = 0; i < 2; ++i) { int R, C; stage_rc(tid * 16 + i * 8192, R, C); const int Rb = E0::PERM ? ((R & ~31) + perm32(R & 31)) : R;
        voffA[i] = (unsigned)(R * K + C) * 2u; voffB[i] = (unsigned)(Rb * K + C) * 2u; }
    const size_t kstep = (size_t)(BK * 2);
    const size_t hstep = (size_t)HALF * K * 2;
    const size_t tstep = 2 * hstep;
    const unsigned ldsw = (unsigned)wid * 1024u;
    const unsigned ldsb = (unsigned)__builtin_amdgcn_readfirstlane((int)((unsigned)(size_t)lds + ldsw));
    const int aoff = lds_byte(wr * 64 + fr, fq * 8); int boff = lds_byte(wc * 32 + fr, fq * 8) + 4 * HTB;
    asm volatile("" : "+v"(boff));
#define PG8_SA(b, h) (((b) * 2 + (h)) * HTB)
#define PG8_SB(b, h) ((4 + (b) * 2 + (h)) * HTB)
#define PG8_SBR(b, h) (((b) * 2 + (h)) * HTB)
#define PG8_STAGE(bufoff, gbase, voff) do { _Pragma("unroll") for (int _i = 0; _i < 2; ++_i) \
        glds16_s((gbase), (voff)[_i], ldsb + (unsigned)((bufoff) + _i * 8192)); } while (0)
#define PG8_STAGE1(bufoff, gbase, voff, i) glds16_s((gbase), (voff)[i], ldsb + (unsigned)((bufoff) + (i) * 8192))
#define PG8_LDA(dst, b, h) do { _Pragma("unroll") for (int m = 0; m < 4; ++m) _Pragma("unroll") for (int k = 0; k < 2; ++k) dst[m][k] = *(const PG8_LAS bf16x8*)(lds + PG8_SA(b, h) + aoff + m * 2048 + k * 1024); } while (0)
#define PG8_LDB(dst, b, h) do { _Pragma("unroll") for (int n = 0; n < 2; ++n) _Pragma("unroll") for (int k = 0; k < 2; ++k) dst[n][k] = *(const PG8_LAS bf16x8*)(lds + PG8_SBR(b, h) + boff + n * 2048 + k * 1024); } while (0)
#define PG8_MMA(ai, bj, At, Bt) do { __builtin_amdgcn_s_setprio(1); _Pragma("unroll") for (int m = 0; m < 4; ++m) _Pragma("unroll") for (int n = 0; n < 2; ++n) _Pragma("unroll") for (int k = 0; k < 2; ++k) \
        acc[ai][bj][m][n] = __builtin_amdgcn_mfma_f32_16x16x32_bf16(Bt[n][k], At[m][k], acc[ai][bj][m][n], 0, 0, 0); __builtin_amdgcn_s_setprio(0); } while (0)
#define PG8_MMAZ(Z, ai, bj, At, Bt) do { if constexpr (Z) { __builtin_amdgcn_s_setprio(1); _Pragma("unroll") for (int m = 0; m < 4; ++m) _Pragma("unroll") for (int n = 0; n < 2; ++n) { \
        acc[ai][bj][m][n] = __builtin_amdgcn_mfma_f32_16x16x32_bf16(Bt[n][0], At[m][0], (f32x4){0.f, 0.f, 0.f, 0.f}, 0, 0, 0); acc[ai][bj][m][n] = __builtin_amdgcn_mfma_f32_16x16x32_bf16(Bt[n][1], At[m][1], acc[ai][bj][m][n], 0, 0, 0); } \
        __builtin_amdgcn_s_setprio(0); } else PG8_MMA(ai, bj, At, Bt); } while (0)
#define PG8_WAIT_V(n) asm volatile("s_waitcnt vmcnt(" #n ")" ::: "memory")
#define PG8_WAIT_L(n) asm volatile("s_waitcnt lgkmcnt(" #n ")" ::: "memory")
#define PG8_BAR __builtin_amdgcn_s_barrier()
#define PG8_SCHED __builtin_amdgcn_sched_barrier(0)
    Unit cur, nxt; int ui = 0;
    if (!S.next(0, cur)) return;
    f32x4 acc[2][2][4][2];
#pragma unroll
    for (int a = 0; a < 2; ++a)
#pragma unroll
        for (int b = 0; b < 2; ++b)
#pragma unroll
            for (int m = 0; m < 4; ++m)
#pragma unroll
                for (int n = 0; n < 2; ++n) acc[a][b][m][n] = (f32x4){0.f, 0.f, 0.f, 0.f};
    bf16x8 At[4][2], B0[2][2], B1[2][2];
    const char* cA = (const char*)g.A + (size_t)cur.pm * tstep; const char* cB = (const char*)g.Bt + (size_t)cur.pn * tstep;
    S.a_ready(cur);
    const int pm0 = cur.pm;
    unsigned long long sv_ = 0ull; if constexpr (RSTD_) sv_ = rstd_fetch(SSQ_, pm0 * BM + (tid & 255));
    if constexpr (SP2) {
        PG8_STAGE(PG8_SB(0, 0), cB, voffB); PG8_STAGE(PG8_SB(0, 1), cB + hstep, voffB); PG8_STAGE(PG8_SA(0, 0), cA, voffA); PG8_STAGE(PG8_SA(0, 1), cA + hstep, voffA);
        if (wr == 1) PG8_BAR;
        PG8_WAIT_V(2); PG8_BAR;
        if constexpr (RSTD_) { if (tid < 256) rstd_put(sv_, tid); }
        if (PG8_MV) { PG8_STAGE(PG8_SB(1, 0), cB + kstep, voffB); PG8_STAGE(PG8_SB(1, 1), cB + hstep + kstep, voffB); PG8_STAGE1(PG8_SA(1, 0), cA + kstep, voffA, 0); PG8_WAIT_V(5); }
        else { PG8_STAGE(PG8_SB(1, 0), cB + kstep, voffB); PG8_STAGE(PG8_SA(1, 0), cA + kstep, voffA); PG8_STAGE(PG8_SB(1, 1), cB + hstep + kstep, voffB); PG8_WAIT_V(6); }
        PG8_BAR;
    } else {
        PG8_STAGE(PG8_SB(0, 0), cB, voffB); PG8_STAGE(PG8_SA(0, 0), cA, voffA); PG8_STAGE(PG8_SB(0, 1), cB + hstep, voffB); PG8_STAGE(PG8_SA(0, 1), cA + hstep, voffA);
        if (wr == 1) PG8_BAR;
        PG8_WAIT_V(4); PG8_BAR;
        if constexpr (RSTD_) { if (tid < 256) rstd_put(sv_, tid); }
        PG8_STAGE(PG8_SB(1, 0), cB + kstep, voffB); PG8_STAGE(PG8_SA(1, 0), cA + kstep, voffA); PG8_STAGE(PG8_SB(1, 1), cB + hstep + kstep, voffB);
        PG8_WAIT_V(6); PG8_BAR;
    }
    static_assert(E0::PERM == E1::PERM && E1::PERM == E2::PERM && !E0::AFTER_DRAIN && !E1::AFTER_DRAIN && !E2::AFTER_DRAIN, "gemm_phase3: one staging order, in-loop epilogues");
    const char* cB1 = (const char*)Bt1 + (size_t)cur.pn * tstep; const char* cB2 = (const char*)Bt2 + (size_t)cur.pn * tstep;
    auto unit = [&](const auto& E, const char* nA, const char* nB, const bool has_next) __attribute__((always_inline)) {
            auto kpair = [&](auto ztag, const int t) __attribute__((always_inline)) {
                constexpr bool Z = decltype(ztag)::value;
                const bool last = (t == nt - 2);
                const char* a1 = cA + (size_t)(t + 1) * kstep;
                const char* a2 = last ? nA : cA + (size_t)(t + 2) * kstep; const char* b2 = last ? nB : cB + (size_t)(t + 2) * kstep;
                const char* a3 = a2 + kstep; const char* b3 = b2 + kstep;

                if constexpr (SP2) {
                PG8_LDB(B0, 0, 0); PG8_LDB(B1, 0, 1); PG8_SCHED; PG8_LDA(At, 0, 0); if (PG8_MV) PG8_STAGE1(PG8_SA(1, 0), a1, voffA, 1); PG8_STAGE(PG8_SA(1, 1), a1 + hstep, voffA);
                PG8_WAIT_V(8); PG8_WAIT_L(0); PG8_BAR; PG8_MMAZ(Z, 0, 0, At, B0); PG8_MMAZ(Z, 0, 1, At, B1); PG8_BAR; PG8_SCHED;
                PG8_LDA(At, 0, 1); PG8_STAGE(PG8_SB(0, 0), b2, voffB); PG8_STAGE(PG8_SB(0, 1), b2 + hstep, voffB); if (PG8_MV) PG8_STAGE1(PG8_SA(0, 0), a2, voffA, 0); else PG8_STAGE(PG8_SA(0, 0), a2, voffA);
                if (PG8_MV) PG8_WAIT_V(7); else PG8_WAIT_V(8); PG8_WAIT_L(0); PG8_BAR; PG8_MMAZ(Z, 1, 0, At, B0); PG8_MMAZ(Z, 1, 1, At, B1); PG8_BAR; PG8_SCHED;
                PG8_LDB(B0, 1, 0); PG8_LDB(B1, 1, 1); PG8_SCHED; PG8_LDA(At, 1, 0); if (PG8_MV) PG8_STAGE1(PG8_SA(0, 0), a2, voffA, 1); PG8_STAGE(PG8_SA(0, 1), a2 + hstep, voffA);
                PG8_WAIT_V(8); PG8_WAIT_L(0); PG8_BAR; PG8_MMA(0, 0, At, B0); PG8_MMA(0, 1, At, B1); PG8_BAR; PG8_SCHED;
                PG8_LDA(At, 1, 1); PG8_STAGE(PG8_SB(1, 0), b3, voffB); PG8_STAGE(PG8_SB(1, 1), b3 + hstep, voffB); if (PG8_MV) PG8_STAGE1(PG8_SA(1, 0), a3, voffA, 0); else PG8_STAGE(PG8_SA(1, 0), a3, voffA);
                if (PG8_MV) PG8_WAIT_V(7); else PG8_WAIT_V(8); PG8_WAIT_L(0); PG8_BAR; PG8_MMA(1, 0, At, B0); PG8_MMA(1, 1, At, B1); PG8_BAR; PG8_SCHED;
                } else {
                PG8_LDB(B0, 0, 0); PG8_SCHED; PG8_LDA(At, 0, 0); PG8_STAGE(PG8_SA(1, 1), a1 + hstep, voffA);
                PG8_WAIT_L(8); PG8_BAR; PG8_WAIT_L(0); PG8_MMAZ(Z, 0, 0, At, B0); PG8_BAR; PG8_SCHED;
                PG8_LDB(B1, 0, 1); PG8_STAGE(PG8_SB(0, 0), b2, voffB);
                PG8_BAR; PG8_WAIT_L(0); PG8_MMAZ(Z, 0, 1, At, B1); PG8_BAR;
                PG8_LDA(At, 0, 1); PG8_STAGE(PG8_SA(0, 0), a2, voffA);
                PG8_BAR; PG8_WAIT_L(0); PG8_MMAZ(Z, 1, 0, At, B0); PG8_BAR; PG8_SCHED;
                PG8_STAGE(PG8_SB(0, 1), b2 + hstep, voffB);
                PG8_WAIT_V(6); PG8_BAR; PG8_MMAZ(Z, 1, 1, At, B1); PG8_BAR;
                PG8_LDB(B0, 1, 0); PG8_SCHED; PG8_LDA(At, 1, 0); PG8_STAGE(PG8_SA(0, 1), a2 + hstep, voffA);
                PG8_WAIT_L(8); PG8_BAR; PG8_WAIT_L(0); PG8_MMA(0, 0, At, B0); PG8_BAR; PG8_SCHED;
                PG8_LDB(B1, 1, 1); PG8_STAGE(PG8_SB(1, 0), b3, voffB);
                PG8_BAR; PG8_WAIT_L(0); PG8_MMA(0, 1, At, B1); PG8_BAR;
                PG8_LDA(At, 1, 1); PG8_STAGE(PG8_SA(1, 0), a3, voffA);
                PG8_BAR; PG8_WAIT_L(0); PG8_MMA(1, 0, At, B0); PG8_BAR; PG8_SCHED;
                PG8_STAGE(PG8_SB(1, 1), b3 + hstep, voffB);
                PG8_WAIT_V(6); PG8_BAR; PG8_MMA(1, 1, At, B1); PG8_BAR;
                }
            };
            for (int t = 0; t < nt; t += 2) kpair(ZTag<false>{}, t);
            if constexpr (ALIGN_EPI) { if (wr == 0) PG8_BAR; }
            { const int ln_ = lane_now();
              E(acc, cur, wr, wc, ln_ & 15, ln_ >> 4, pm0); }
            if (!has_next) return;
    #pragma unroll
            for (int a = 0; a < 2; ++a)
    #pragma unroll
                for (int b = 0; b < 2; ++b)
    #pragma unroll
                    for (int m = 0; m < 4; ++m)
    #pragma unroll
                        for (int n = 0; n < 2; ++n) acc[a][b][m][n] = (f32x4){0.f, 0.f, 0.f, 0.f};
            cA = nA; cB = nB;
            if constexpr (ALIGN_EPI) { if (wr == 1) PG8_BAR; }
    };
    const char* cA1 = cA; const char* cA2 = cA; asm volatile("" : "+s"(cA1), "+s"(cA2));
    unit(e0, cA1, cB1, true); unit(e1, cA2, cB2, true); unit(e2, cA, cB, false);
    PG8_WAIT_V(0);
    if constexpr (!ALIGN_EPI) { if (wr == 0) PG8_BAR; }
    PG8_BAR;
#undef PG8_SA
#undef PG8_SB
#undef PG8_SBR
#undef PG8_STAGE
#undef PG8_STAGE1
#undef PG8_LDA
#undef PG8_LDB
#undef PG8_MMA
#undef PG8_MMAZ
#undef PG8_WAIT_V
#undef PG8_WAIT_L
#undef PG8_BAR
#undef PG8_SCHED
}
}

#ifndef PG8_SP2
#define PG8_SP2 true
#endif
#ifndef PG8_ALIGN1
#define PG8_ALIGN1 false
#endif
#ifndef PG8_ALIGN
#define PG8_ALIGN true
#endif
#include <hip/hip_bf16.h>
#include <cmath>
namespace attn_body {
using bf16=__hip_bfloat16;
using bf16x8=__attribute__((ext_vector_type(8)))short;
using s16x4=__attribute__((ext_vector_type(4)))short;
using f32x16=__attribute__((ext_vector_type(16)))float;
using u32x4=__attribute__((ext_vector_type(4)))unsigned;
constexpr int BATCH=1,NHEAD=32,SEQ=8192,D=64,DM=1024,OP=2048;
constexpr int NW=8,QBLK=32,QB=QBLK*NW,KVBLK=64,NQB=SEQ/QB;
constexpr int ATTN_PITCH=DM, ATTN_UNIT_ROWS=QB;
__device__ __forceinline__ int crow(int r,int hi){return (r&3)+8*(r>>2)+4*hi;}
#define SBAR() __builtin_amdgcn_sched_barrier(0)
__device__ __forceinline__ void cmask(f32x16&p0,f32x16&p1,int jb,int qrel,int hi){
  const float NEG=-INFINITY; int kb=64*jb+4*hi;
  #pragma unroll
  for(int r=0;r<16;++r){int kv=kb+(r&3)+8*(r>>2); if(kv>qrel)p0[r]=NEG; if(kv+32>qrel)p1[r]=NEG;}
}

constexpr int NSLOT=3, SLOTB=8192;
constexpr int LDS_K=0, LDS_V=NSLOT*SLOTB, LDS_WS=3*NSLOT*SLOTB, LDS_OST=LDS_WS+NW*64*4, LDS_BYTES=LDS_OST+NW*4096;
constexpr float C2=0.125f*1.4426950408889634f;
__device__ __forceinline__ void glds16(const void*gsrc,unsigned lds_dst){
  asm volatile("s_mov_b32 m0, %1\n\ts_nop 0\n\tglobal_load_lds_dwordx4 %0, off"::"v"(gsrc),"s"(lds_dst):"memory","m0");}
__device__ __forceinline__ float max3f(float a,float b,float c){float r;asm("v_max3_f32 %0, %1, %2, %3":"=v"(r):"v"(a),"v"(b),"v"(c));return r;}
__device__ __forceinline__ float max2f(float a,float b){float r;asm("v_max_f32_e32 %0, %1, %2":"=v"(r):"v"(a),"v"(b));return r;}
__device__ __forceinline__ float fadd_s(float a,float b){float r;asm("v_add_f32_e32 %0, %1, %2":"=v"(r):"v"(a),"v"(b));return r;}
__device__ __forceinline__ float fsub_s(float a,float b){float r;asm("v_sub_f32_e32 %0, %1, %2":"=v"(r):"v"(a),"v"(b));return r;}
typedef float f32x2_t __attribute__((ext_vector_type(2))); typedef __bf16 bf16x2_t __attribute__((ext_vector_type(2)));
__device__ __forceinline__ unsigned cvtpk_s(float lo,float hi){f32x2_t v={lo,hi};bf16x2_t b=__builtin_convertvector(v,bf16x2_t);return __builtin_bit_cast(unsigned,b);}
#define WAIT_BAR(N) asm volatile("s_waitcnt vmcnt(" #N ") lgkmcnt(0)\n\ts_barrier":::"memory")

__device__ __forceinline__ void qkt(f32x16&p0,f32x16&p1,const char*Kslot,const bf16x8*qr,const f32x16&negm,int r32,int hi){
  const char*kb=Kslot+hi*1024+r32*16;
  #pragma unroll
  for(int d0=0;d0<4;++d0){
    const bf16x8 b0=*reinterpret_cast<const bf16x8*>(kb+d0*2048);
    const bf16x8 b1=*reinterpret_cast<const bf16x8*>(kb+d0*2048+512);
    if(d0==0){p0=__builtin_amdgcn_mfma_f32_32x32x16_bf16(b0,qr[0],negm,0,0,0);p1=__builtin_amdgcn_mfma_f32_32x32x16_bf16(b1,qr[0],negm,0,0,0);}
    else{p0=__builtin_amdgcn_mfma_f32_32x32x16_bf16(b0,qr[d0],p0,0,0,0);p1=__builtin_amdgcn_mfma_f32_32x32x16_bf16(b1,qr[d0],p1,0,0,0);}}
}
typedef __attribute__((address_space(3))) const char* lds_cptr;
typedef short v4i16_t __attribute__((ext_vector_type(4)));
__device__ __forceinline__ void kload8(bf16x8*kf,lds_cptr kp){
  kf[0]=*(const __attribute__((address_space(3))) bf16x8*)(kp);      kf[1]=*(const __attribute__((address_space(3))) bf16x8*)(kp+512);
  kf[2]=*(const __attribute__((address_space(3))) bf16x8*)(kp+2048); kf[3]=*(const __attribute__((address_space(3))) bf16x8*)(kp+2560);
  kf[4]=*(const __attribute__((address_space(3))) bf16x8*)(kp+4096); kf[5]=*(const __attribute__((address_space(3))) bf16x8*)(kp+4608);
  kf[6]=*(const __attribute__((address_space(3))) bf16x8*)(kp+6144); kf[7]=*(const __attribute__((address_space(3))) bf16x8*)(kp+6656);
}
__device__ __forceinline__ void kload2(bf16x8*kf,lds_cptr kp,int j){ kf[2*j]=*(const __attribute__((address_space(3))) bf16x8*)(kp+j*2048); kf[2*j+1]=*(const __attribute__((address_space(3))) bf16x8*)(kp+j*2048+512); }
__device__ __forceinline__ s16x4 vtr(lds_cptr p){ return __builtin_bit_cast(s16x4,__builtin_amdgcn_ds_read_tr16_b64_v4i16((__attribute__((address_space(3))) v4i16_t*)p)); }
__device__ __forceinline__ float rowmax(const f32x16&p0,const f32x16&p1){
  float a=max3f(p0[0],p0[1],p1[0]),b=max3f(p0[2],p0[3],p1[1]);a=max3f(a,p1[2],p1[3]);
  #pragma unroll
  for(int r=4;r<16;r+=4){a=max3f(a,p0[r],p0[r+1]);b=max3f(b,p0[r+2],p0[r+3]);a=max3f(a,p1[r],p1[r+1]);b=max3f(b,p1[r+2],p1[r+3]);}
  const float m=max2f(a,b);
  auto rr=__builtin_amdgcn_permlane32_swap(__float_as_uint(m),__float_as_uint(m),false,false);
  return max2f(__uint_as_float(rr[0]),__uint_as_float(rr[1]));
}
__device__ __forceinline__ void pv(f32x16*o,int vb,bf16x8 pa0,bf16x8 pa1,bf16x8 pa2,bf16x8 pa3){
  #pragma unroll
  for(int d0=0;d0<4;++d0){s16x4 lo[4],hi[4];
    #pragma unroll
    for(int ks=0;ks<4;++ks){
      asm volatile("ds_read_b64_tr_b16 %0,%1 offset:%c2":"=&v"(lo[ks]):"v"(vb),"i"(d0*4096+ks*1024):"memory");
      asm volatile("ds_read_b64_tr_b16 %0,%1 offset:%c2":"=&v"(hi[ks]):"v"(vb),"i"(d0*4096+ks*1024+512):"memory");}
    asm volatile("s_waitcnt lgkmcnt(0)":::"memory");SBAR();
    #define PK(k) (bf16x8){lo[k][0],lo[k][1],lo[k][2],lo[k][3],hi[k][0],hi[k][1],hi[k][2],hi[k][3]}
    o[d0]=__builtin_amdgcn_mfma_f32_32x32x16_bf16(pa0,PK(0),o[d0],0,0,0);
    o[d0]=__builtin_amdgcn_mfma_f32_32x32x16_bf16(pa1,PK(1),o[d0],0,0,0);
    o[d0]=__builtin_amdgcn_mfma_f32_32x32x16_bf16(pa2,PK(2),o[d0],0,0,0);
    o[d0]=__builtin_amdgcn_mfma_f32_32x32x16_bf16(pa3,PK(3),o[d0],0,0,0);
    #undef PK
  }
}

#ifndef ATTN_STORE16
#define ATTN_STORE16(p,v) (*(u32x4*)(p)=(v))
#endif
template<int THRL> __device__ __forceinline__ void attn_unit(int qb,const bf16*Q,const bf16*__restrict__ K,const bf16*__restrict__ V,bf16*O,char*shm){
  int tid_=threadIdx.x; asm volatile("":"+v"(tid_)); const int tid=tid_,lane=tid&63,r32=lane&31,hi=lane>>5; const int wid=__builtin_amdgcn_readfirstlane(tid>>6);
  const int q0=qb*QB;
  const bf16*Qw=Q+(long)(q0+wid*QBLK)*DM;
  const bf16*Kh=K,*Vh=V;
  const unsigned lds0=(unsigned)(uintptr_t)shm;
  float*wsf=(float*)(shm+LDS_WS)+wid*64;
  const bf16*ksrc=Kh+(long)lane*DM+wid*8;
  const bf16*vsrc=Vh+(long)(16*(wid&3)+(lane>>2))*DM+(wid>>2)*32+(lane&3)*8;
  const unsigned kdst=lds0+LDS_K+wid*1024, vdst=lds0+LDS_V+wid*1024;
  #define DMA_K(t,slot) glds16(ksrc+(long)(t)*KVBLK*DM,(unsigned)__builtin_amdgcn_readfirstlane(kdst+(slot)))
  #define DMA_V(t,slot) do{ glds16(vsrc+(long)(t)*KVBLK*DM,(unsigned)__builtin_amdgcn_readfirstlane(vdst+2*(slot))); glds16(vsrc+(long)(t)*KVBLK*DM+64,(unsigned)__builtin_amdgcn_readfirstlane(vdst+2*(slot)+8192)); }while(0)
  const int vb0=(int)(lds0+LDS_V)+((lane>>4)&1)*32+(lane&3)*8+(4*hi+((lane&15)>>2))*64;
  const char*Kbase=shm+LDS_K; bf16x8 kf[8];
  const lds_cptr shm3=(lds_cptr)shm; const lds_cptr kp0=shm3+LDS_K+hi*1024+r32*16; const lds_cptr vp0=shm3+LDS_V+((lane>>4)&1)*32+(lane&3)*8+(4*hi+((lane&15)>>2))*64;
  const int NT=(q0+QB)/KVBLK;
  DMA_K(0,0);DMA_V(0,0);DMA_K(1,SLOTB);
  const lds_cptr qp0=shm3+LDS_OST+wid*4096+hi*512+r32*16;
  { bf16x8 qt[4];
  #pragma unroll
  for(int d0=0;d0<4;++d0)qt[d0]=*reinterpret_cast<const bf16x8*>(&Qw[(long)r32*DM+d0*16+hi*8]);
  #pragma unroll
  for(int d0=0;d0<4;++d0)*(__attribute__((address_space(3))) bf16x8*)(qp0+d0*1024)=qt[d0]; }
  #define QF(d0) (*(const __attribute__((address_space(3))) bf16x8*)(qp0+(d0)*1024))
  float mhat=0.f,l_reg=0.f;float zf_=0.f;asm volatile("":"+v"(zf_));
  f32x16 o[4];f32x16 negm;
  #pragma unroll
  for(int r=0;r<16;++r){o[0][r]=zf_;o[1][r]=zf_;o[2][r]=zf_;o[3][r]=zf_;negm[r]=zf_;}asm volatile("":"+v"(negm));
  const int qrel=wid*QBLK+r32;
  #define CMASK(P0,P1,t) do{int jb_=(t)-(NT-4); if(jb_>=0)cmask(P0,P1,jb_,qrel,hi);}while(0)
  bool resc=false;
  #define START(P0,P1) do{ const float rm=rowmax(P0,P1); resc=false; \
    { const float dl=rm; mhat=fadd_s(mhat,dl); \
      _Pragma("unroll") for(int r=0;r<16;++r){P0[r]=fsub_s(P0[r],dl);P1[r]=fsub_s(P1[r],dl);} \
      _Pragma("unroll") for(int r=0;r<16;++r)negm[r]=-mhat; asm volatile("":"+v"(negm)); } \
    _Pragma("unroll") for(int r=0;r<16;++r)P0[r]=__builtin_amdgcn_exp2f(P0[r]); }while(0)
  #define RESC() do{ if(resc){ asm volatile("s_waitcnt lgkmcnt(0)":::"memory"); \
      _Pragma("unroll") for(int d_=0;d_<4;++d_) _Pragma("unroll") for(int r=0;r<16;++r)o[d_][r]*=wsf[crow(r,hi)]; } }while(0)
  f32x16 pA0,pA1,pB0,pB1;
  int sl_prev=0,sl_cur=0,sl_next=SLOTB;
  #define ROT() do{sl_prev=sl_cur;sl_cur=sl_next;sl_next=(sl_next==(NSLOT-1)*SLOTB)?0:sl_next+SLOTB;}while(0)
  DMA_K(2,2*SLOTB);
  const bf16x8 qf0=QF(0);
  WAIT_BAR(4);
  { const bf16x8 qq[4]={qf0,QF(1),QF(2),QF(3)}; qkt(pA0,pA1,Kbase,qq,negm,r32,hi); }asm volatile("s_nop 15\n\ts_nop 7":"+v"(pA0),"+v"(pA1));CMASK(pA0,pA1,0);
  START(pA0,pA1);
  _Pragma("unroll") for(int r=0;r<16;++r)pA1[r]=__builtin_amdgcn_exp2f(pA1[r]);
  WAIT_BAR(0);
  DMA_K(3,0);DMA_V(1,SLOTB);
  ROT();
  kload8(kf,kp0+sl_cur);
  WAIT_BAR(3);
  s16x4 vlo[8],vhi[8]; u32x4 pw0,pw1,pw2,pw3;
  #define PKW(P,B) cvtpk_s(P[B],P[B+1])
  #define PAF(k) __builtin_bit_cast(bf16x8,pw##k)
  #define VFR(i) (bf16x8){vlo[i][0],vlo[i][1],vlo[i][2],vlo[i][3],vhi[i][0],vhi[i][1],vhi[i][2],vhi[i][3]}
  #define PIN(x) asm volatile("":"+v"(x))
  #define MX3(a,b,c) __builtin_fmaxf(__builtin_fmaxf((a),(b)),(c))
  #define GAPA(MF,A0,A1,A2,A3,W0,W1,PW) do{ MF; sacc+=A0; sacc+=A1; sacc+=A2; sacc+=A3; PIN(sacc); W0; W1; PIN(PW); SBAR(); }while(0)
  #define EX(v) __builtin_amdgcn_exp2f(v)
  #define VRDF(s,f) do{ vlo[s]=vtr(vp_+(((f)>>2)*4096+((f)&3)*1024)); vhi[s]=vtr(vp_+(((f)>>2)*4096+((f)&3)*1024+512)); }while(0)
  #define KRD(G,j) do{ if(G){ kload2(kf,kp0+sl_next,j); SBAR(); } }while(0)
  #define GAPB2(MF,X,B) do{ MF; X[B]=EX(X[B]); X[B+1]=EX(X[B+1]); PIN(X); SBAR(); }while(0)
  #define MF32(a,b,c) __builtin_amdgcn_mfma_f32_32x32x16_bf16(a,b,c,0,0,0)
  #define STEP(C0,C1,P0,P1,t,GK,GV,GL) do{ SBAR(); \
    const lds_cptr vp_=vp0+2*sl_prev; bf16x8 qa,qb; \
    VRDF(0,0); qb=QF(1); SBAR(); float sacc=(P0[0]+P0[1]); \
    GAPA(C0=MF32(kf[0],qf0,negm), P0[2],P0[3],P0[4],P0[5],     pw0[0]=PKW(P0,0), pw0[1]=PKW(P0,2), pw0); \
    VRDF(1,4); SBAR(); GAPA(C1=MF32(kf[1],qf0,negm), P0[6],P0[7],P0[8],P0[9],     pw0[2]=PKW(P0,4), pw0[3]=PKW(P0,6), pw0); \
    VRDF(2,8); qa=QF(2); SBAR(); GAPA(C0=MF32(kf[2],qb,C0),   P0[10],P0[11],P0[12],P0[13], pw1[0]=PKW(P0,8), pw1[1]=PKW(P0,10), pw1); \
    VRDF(3,12); SBAR(); GAPA(C1=MF32(kf[3],qb,C1),   P0[14],P0[15],P1[0],P1[1],   pw1[2]=PKW(P0,12),pw1[3]=PKW(P0,14), pw1); \
    VRDF(4,1); qb=QF(3); SBAR(); GAPA(C0=MF32(kf[4],qa,C0),   P1[2],P1[3],P1[4],P1[5],     pw2[0]=PKW(P1,0), pw2[1]=PKW(P1,2), pw2); \
    VRDF(5,5); SBAR(); GAPA(C1=MF32(kf[5],qa,C1),   P1[6],P1[7],P1[8],P1[9],     pw2[2]=PKW(P1,4), pw2[3]=PKW(P1,6), pw2); \
    VRDF(6,9); SBAR(); GAPA(C0=MF32(kf[6],qb,C0),   P1[10],P1[11],P1[12],P1[13], pw3[0]=PKW(P1,8), pw3[1]=PKW(P1,10), pw3); \
    VRDF(7,13); SBAR(); GAPA(C1=MF32(kf[7],qb,C1),   P1[14],P1[15],0.f,0.f,       pw3[2]=PKW(P1,12),pw3[3]=PKW(P1,14), pw3); \
    l_reg+=sacc; \
    if(GK){DMA_K((t)+3,sl_cur);} if(GV){DMA_V((t)+1,sl_next);} \
    CMASK(C0,C1,t); \
    { float a=MX3(C0[0],C0[1],C1[0]),b=MX3(C0[2],C0[3],C1[1]); a=MX3(a,C1[2],C1[3]); \
      _Pragma("unroll") for(int r=4;r<16;r+=4){a=MX3(a,C0[r],C0[r+1]);b=MX3(b,C0[r+2],C0[r+3]);a=MX3(a,C1[r],C1[r+1]);b=MX3(b,C1[r+2],C1[r+3]);} \
      float rm=__builtin_fmaxf(a,b); { auto rr=__builtin_amdgcn_permlane32_swap(__float_as_uint(rm),__float_as_uint(rm),false,false); rm=__builtin_fmaxf(__uint_as_float(rr[0]),__uint_as_float(rr[1])); } \
      resc=false; \
      if(__builtin_expect(__any(rm>(float)THRL),0)){ const float dl=__builtin_fmaxf(rm,0.f); mhat+=dl; \
        _Pragma("unroll") for(int r=0;r<16;++r){C0[r]-=dl;C1[r]-=dl;} \
        _Pragma("unroll") for(int r=0;r<16;++r)negm[r]=-mhat; asm volatile("":"+v"(negm)); \
        const float f=__builtin_amdgcn_exp2f(-dl); l_reg*=f; if(hi==0)wsf[r32]=f; resc=true; } } \
    SBAR(); \
    GAPB2(o[0]=MF32(PAF(0),VFR(0),o[0]), C0,0);  VRDF(0,2);  SBAR(); \
    GAPB2(o[1]=MF32(PAF(0),VFR(1),o[1]), C0,2);  VRDF(1,6);  SBAR(); \
    KRD(GL,0); GAPB2(o[2]=MF32(PAF(0),VFR(2),o[2]), C0,4);  VRDF(2,10); SBAR(); \
    GAPB2(o[3]=MF32(PAF(0),VFR(3),o[3]), C0,6);  VRDF(3,14); SBAR(); \
    KRD(GL,1); GAPB2(o[0]=MF32(PAF(1),VFR(4),o[0]), C0,8);  VRDF(4,3);  SBAR(); \
    GAPB2(o[1]=MF32(PAF(1),VFR(5),o[1]), C0,10); VRDF(5,7);  SBAR(); \
    KRD(GL,2); GAPB2(o[2]=MF32(PAF(1),VFR(6),o[2]), C0,12); VRDF(6,11); SBAR(); \
    GAPB2(o[3]=MF32(PAF(1),VFR(7),o[3]), C0,14); VRDF(7,15); SBAR(); \
    KRD(GL,3); GAPB2(o[0]=MF32(PAF(2),VFR(0),o[0]), C1,0); \
    GAPB2(o[1]=MF32(PAF(2),VFR(1),o[1]), C1,2); \
    GAPB2(o[2]=MF32(PAF(2),VFR(2),o[2]), C1,4); \
    GAPB2(o[3]=MF32(PAF(2),VFR(3),o[3]), C1,6); \
    GAPB2(o[0]=MF32(PAF(3),VFR(4),o[0]), C1,8); \
    GAPB2(o[1]=MF32(PAF(3),VFR(5),o[1]), C1,10); \
    GAPB2(o[2]=MF32(PAF(3),VFR(6),o[2]), C1,12); \
    GAPB2(o[3]=MF32(PAF(3),VFR(7),o[3]), C1,14); \
    }while(0)
  int t=1;
  #undef CMASK
  #define CMASK(P0,P1,t) do{}while(0)
  for(;t+5<NT;t+=2){
    STEP(pB0,pB1,pA0,pA1,t,true,true,true);     WAIT_BAR(3); RESC(); ROT();
    STEP(pA0,pA1,pB0,pB1,t+1,true,true,true);   WAIT_BAR(3); RESC(); ROT();
  }
  #undef CMASK
  #define CMASK(P0,P1,t) do{int jb_=(t)-(NT-4); if(jb_>=0)cmask(P0,P1,jb_,qrel,hi);}while(0)
  #define ENDW(tt) do{ if((tt)+3<NT){WAIT_BAR(3);} else if((tt)+2<NT){WAIT_BAR(2);} else {WAIT_BAR(0);} }while(0)
  for(;t+1<NT;t+=2){
    STEP(pB0,pB1,pA0,pA1,t,(t+3<NT),(t+1<NT),(t+1<NT));       ENDW(t);   RESC(); ROT();
    STEP(pA0,pA1,pB0,pB1,t+1,(t+4<NT),(t+2<NT),(t+2<NT));     ENDW(t+1); RESC(); ROT();
  }
  STEP(pB0,pB1,pA0,pA1,NT-1,false,false,false); RESC();
  { float sacc=pB0[0]+pB0[1]; _Pragma("unroll") for(int r=2;r<16;++r)sacc+=pB0[r]; _Pragma("unroll") for(int r=0;r<16;++r)sacc+=pB1[r]; l_reg+=sacc;
    pw0=(u32x4){PKW(pB0,0),PKW(pB0,2),PKW(pB0,4),PKW(pB0,6)};pw1=(u32x4){PKW(pB0,8),PKW(pB0,10),PKW(pB0,12),PKW(pB0,14)};pw2=(u32x4){PKW(pB1,0),PKW(pB1,2),PKW(pB1,4),PKW(pB1,6)};pw3=(u32x4){PKW(pB1,8),PKW(pB1,10),PKW(pB1,12),PKW(pB1,14)};
    SBAR(); pv(o,vb0+2*sl_cur,PAF(0),PAF(1),PAF(2),PAF(3)); }
  #undef PKW
  #undef PAF
  #undef VFR
  #undef PIN
  #undef MX3
  #undef GAPA
  #undef GAPB2
  #undef MF32
  #undef EX
  #undef VRDF
  #undef KRD
  #undef STEP
  #undef ENDW
  {auto rr=__builtin_amdgcn_permlane32_swap(__float_as_uint(l_reg),__float_as_uint(l_reg),false,false);l_reg=__uint_as_float(rr[0])+__uint_as_float(rr[1]);}
  if(hi==0)wsf[32+r32]=l_reg;asm volatile("s_waitcnt lgkmcnt(0)":::"memory");
  float rli[16];
  #pragma unroll
  for(int r=0;r<16;++r)rli[r]=__builtin_amdgcn_rcpf(wsf[32+crow(r,hi)]);
  bf16*Ow=O+(long)(q0+wid*QBLK)*OP;
  { bf16*stg=(bf16*)(shm+LDS_OST)+wid*2048;
    #pragma unroll
    for(int p=0;p<2;++p){
      #pragma unroll
      for(int r=0;r<16;++r){const int orow=crow(r,hi);
        #pragma unroll
        for(int d0=0;d0<2;++d0)stg[orow*64+d0*32+r32]=__float2bfloat16(o[2*p+d0][r]*rli[r]);}
      asm volatile("s_waitcnt lgkmcnt(0)":::"memory");
      #pragma unroll
      for(int i=0;i<4;++i){const int row=i*8+(lane>>3),ch=lane&7; const u32x4 v=*(const u32x4*)(stg+row*64+ch*8); ATTN_STORE16(Ow+(long)row*OP+p*64+ch*8,v);}
      asm volatile("s_waitcnt lgkmcnt(0)":::"memory");
    } }
  asm volatile("s_waitcnt lgkmcnt(0)\n\ts_barrier":::"memory");
  #undef DMA_K
  #undef DMA_V
  #undef CMASK
  #undef START
  #undef RESC
  #undef ROT
}
constexpr int ATTN_LDS_BYTES=LDS_BYTES;
struct AttnTensors { const bf16* Q; const bf16* K; const bf16* V; bf16* O; };
struct AttnUnit { int bh; int qb; };
struct StaticOrder {
  int vcu;
  __device__ __forceinline__ explicit StaticOrder(int grid,int block):vcu((block%8)*(grid/8)+block/8){}
  __device__ __forceinline__ bool next(int i,AttnUnit&u)const{ if(i>=2)return false; const int s=vcu&15; u.bh=vcu>>4; u.qb=(i==0)?31-s:s; return true; }
  __device__ __forceinline__ void a_ready(const AttnUnit&)const{}
  __device__ __forceinline__ void done(const AttnUnit&)const{}
};
template<class Sched,int THRL=8> __device__ __forceinline__ void attn_phase(char*lds,const AttnTensors&T,const Sched&S){
  AttnUnit u;
  for(int i=0;S.next(i,u);++i){ S.a_ready(u); { const int p=u.bh;   attn_unit<THRL>(u.qb,T.Q+p*64,T.K+p*64,T.V+(p>>1)*128,T.O+(p&1)*1024+(p>>1)*128,lds); } S.done(u); }
}
#undef SBAR
#undef WAIT_BAR
}
#ifndef FILLER
#define FILLER 1
#endif
#ifndef PROBE_SLEEP
#define PROBE_SLEEP 0
#endif
#ifndef WIN_SPLIT
#define WIN_SPLIT 0
#endif
#ifndef LOCAL_BAR
#define LOCAL_BAR 1
#endif
#ifndef PROBE_CLK
#define PROBE_CLK 0
#endif
#ifndef PROBE_DUP
#define PROBE_DUP 0
#endif
constexpr int NWAVES = 8;
constexpr int M = 8192, D = 2048, FF = 5632, NIN = 6144, DEPTH = 4;
constexpr float EPS = 1e-5f;
__device__ const float INV_FREQ[8] = {1.0f, 0.1939227432012558f, 0.03760603070259094f, 0.007292664609849453f, 0.0014142135623842478f, 0.00027424818836152554f, 5.3182957344688475e-05f, 1.0313385246263351e-05f};
__device__ const float LAM_INIT[4] = {0.2f, 0.35550906759096934f, 0.4707130183435842f, 0.5560582041556406f};
constexpr size_t MiB = 1u << 20;
constexpr size_t WS_CTL = 0, CTL_ZERO_BYTES = 3 * MiB;
constexpr size_t WS_CS = 1 * MiB;
constexpr size_t WS_SSQ = 2 * MiB;
constexpr size_t WS_W = 3 * MiB;
constexpr size_t WO_GU1 = 0, WO_D1 = 44 * MiB, WO_IN = 66 * MiB, WO_OUT = 90 * MiB, WO_GU2 = 98 * MiB, WO_D2 = 142 * MiB, W_LAYER = 164 * MiB;
constexpr size_t WS_XB = WS_W + DEPTH * W_LAYER;
constexpr size_t WS_ACT = WS_XB + 32 * MiB;
constexpr size_t WS_Q = WS_ACT + 88 * MiB, WS_K = WS_Q + 16 * MiB, WS_V = WS_K + 16 * MiB, WS_GB = WS_V + 16 * MiB, WS_CU = WS_GB + 16 * MiB;
constexpr size_t WS_O = WS_CU + 16 * MiB;
constexpr size_t WS_MIX = WS_O + 32 * MiB;
constexpr size_t WS_END = WS_MIX + 32 * MiB;
static_assert((size_t)2 * FF * D * 2 == 44 * MiB && (size_t)FF * D * 2 == 22 * MiB && (size_t)NIN * D * 2 == 24 * MiB && (size_t)D * D * 2 == 8 * MiB && (size_t)M * FF * 2 == 88 * MiB, "d_ws map");
constexpr int CW_BAR = 4096;
constexpr int RING_OFF = 0, RING_BYTES = 131072;
constexpr int LDSCTL_OFF = RING_BYTES, MISC_OFF = LDSCTL_OFF + 320;
constexpr int LDS_BYTES = 147456;
static_assert(MISC_OFF + 128 <= pg8::RSTD_OFF && pg8::RSTD_OFF == LDSCTL_OFF + 1024 && pg8::RSTD_OFF + 1024 <= LDS_BYTES, "LDS map");
#define GAS __attribute__((address_space(1)))
#define LAS __attribute__((address_space(3)))
typedef unsigned short bf16;
typedef unsigned v4u __attribute__((ext_vector_type(4)));
typedef float f32x4 __attribute__((ext_vector_type(4)));
typedef short bf16x8 __attribute__((ext_vector_type(8)));
typedef GAS unsigned gu32;
typedef GAS unsigned long long gu64;
#define RLX_AGENT __ATOMIC_RELAXED, __HIP_MEMORY_SCOPE_AGENT
#define LDS_WAIT() asm volatile("s_waitcnt lgkmcnt(0)" ::: "memory")
#define VM_WAIT() asm volatile("s_waitcnt vmcnt(0)" ::: "memory")
__device__ __forceinline__ unsigned long long rt() { return __builtin_amdgcn_s_memrealtime(); }
__device__ __forceinline__ unsigned f2bf(float f) { unsigned u = __builtin_bit_cast(unsigned, f); return (u + 0x7fffu + ((u >> 16) & 1u)) >> 16; }
__device__ __forceinline__ unsigned pk2(float lo, float hi) { return f2bf(lo) | (f2bf(hi) << 16); }

#define XB_TMO      128
#define XB_XCNT(j)  (256  + 64 * (j))
#define XB_XSUB(j)  (1280 + 64 * (j))
#define XB_XGEN(j)  (2304 + 64 * (j))
#define XB_TOP      3328
#define XB_TOPGEN   3392
#define XCD_BAR_WORDS 3456
#define XB_SPIN_CAP (1u << 18)

__device__ __forceinline__ unsigned xb_ld(unsigned* p)              { return __hip_atomic_load(p, __ATOMIC_RELAXED, __HIP_MEMORY_SCOPE_AGENT); }
__device__ __forceinline__ unsigned xb_add(unsigned* p, unsigned v) { return __hip_atomic_fetch_add(p, v, __ATOMIC_RELAXED, __HIP_MEMORY_SCOPE_AGENT); }
__device__ __forceinline__ unsigned xb_xcc_id() { return (unsigned)__builtin_amdgcn_s_getreg((3 << 11) | 20) & 0xFu; }
#define XB_SPIN(cond, bar) do { unsigned _sp = 0; while (cond) { __builtin_amdgcn_s_sleep(1); \
    if ((++_sp & 255u) == 0u) { if (xb_ld(&(bar)[XB_TMO])) break; if (_sp > XB_SPIN_CAP) { atomicAdd(&(bar)[XB_TMO], 1u); break; } } } } while (0)

struct XcdBarrier {
    unsigned* bar; unsigned x;
    volatile LAS unsigned* st;
};

__device__ __forceinline__ XcdBarrier xcd_barrier_post(unsigned* bar, volatile LAS unsigned* st) {
    XcdBarrier b; b.bar = bar; b.x = xb_xcc_id(); b.st = st;
    if (threadIdx.x == 0) (void)xb_add(&bar[XB_XCNT(b.x)], 1u);
    return b;
}
__device__ __forceinline__ void xcd_barrier_complete(unsigned* bar, unsigned x, unsigned& nloc, unsigned& nx) {
    const unsigned G = gridDim.x * gridDim.y * gridDim.z;
    unsigned sum, cnt, mine, sp = 0u;
    for (;;) {
        sum = 0u; cnt = 0u; mine = 0u;
#pragma unroll
        for (unsigned j = 0; j < 16; ++j) { const unsigned c = xb_ld(&bar[XB_XCNT(j)]); sum += c; cnt += (c > 0u) ? 1u : 0u; mine = (j == x) ? c : mine; }
        if (sum == G) break;
        __builtin_amdgcn_s_sleep(1);
        if ((++sp & 255u) == 0u) { if (xb_ld(&bar[XB_TMO])) break; if (sp > XB_SPIN_CAP) { atomicAdd(&bar[XB_TMO], 1u); break; } }
    }
    nloc = mine > 0u ? mine : 1u; nx = cnt > 0u ? cnt : 1u;
}

__device__ __forceinline__ void xcd_barrier(const XcdBarrier& b) {
    asm volatile("s_waitcnt vmcnt(0)" ::: "memory");
    __syncthreads();
    if (threadIdx.x == 0) {
        unsigned* bar = b.bar;
        __builtin_amdgcn_s_waitcnt(0);
        unsigned nloc = b.st[0], nx = b.st[1];
        if (nloc == 0u) { xcd_barrier_complete(bar, b.x, nloc, nx); b.st[0] = nloc; b.st[1] = nx; }
        const unsigned old = xb_add(&bar[XB_XSUB(b.x)], 1u);
        const unsigned gen = old / nloc;
        if (old + 1u == (gen + 1u) * nloc) {
            __builtin_amdgcn_fence(__ATOMIC_RELEASE, "agent");
            asm volatile("s_waitcnt vmcnt(0)" ::: "memory");
            const unsigned og = xb_add(&bar[XB_TOP], 1u);
            const unsigned tg = og / nx;
            if (og + 1u == (tg + 1u) * nx) xb_add(&bar[XB_TOPGEN], 1u);
            else XB_SPIN(xb_ld(&bar[XB_TOPGEN]) == tg, bar);
            __builtin_amdgcn_fence(__ATOMIC_ACQUIRE, "agent");
            xb_add(&bar[XB_XGEN(b.x)], 1u);
            asm volatile("s_waitcnt vmcnt(0)" ::: "memory");
        } else {
            XB_SPIN(xb_ld(&bar[XB_XGEN(b.x)]) == gen, bar);
            __builtin_amdgcn_fence(__ATOMIC_ACQUIRE, "agent");
            asm volatile("s_waitcnt vmcnt(0)" ::: "memory");
        }
    }
    __syncthreads();
}

#define XB_LSUB(j)  (3456 + 64 * (j))
#define XB_LGEN(j)  (4480 + 64 * (j))
__device__ __forceinline__ void xcd_barrier_local(const XcdBarrier& b) {
    asm volatile("s_waitcnt vmcnt(0)" ::: "memory");
    __syncthreads();
    if (threadIdx.x == 0) {
        unsigned* bar = b.bar; const unsigned nloc = b.st[0];
        const unsigned old = xb_add(&bar[XB_LSUB(b.x)], 1u); const unsigned gen = old / nloc;
        if (old + 1u == (gen + 1u) * nloc) xb_add(&bar[XB_LGEN(b.x)], 1u);
        else XB_SPIN(xb_ld(&bar[XB_LGEN(b.x)]) == gen, bar);
        __builtin_amdgcn_fence(__ATOMIC_ACQUIRE, "agent");
        asm volatile("s_waitcnt vmcnt(0)" ::: "memory");
    }
    __syncthreads();
}

struct Frame {
    LAS unsigned char* lds;
    volatile LAS unsigned* MISC;
    gu32* ctl;
    int tid, lane, wave;
    int vcu, G;
};

__device__ __forceinline__ float shx(float v, int lane, int mask) { return __int_as_float(__builtin_amdgcn_ds_bpermute((lane ^ mask) << 2, __float_as_int(v))); }
__device__ __forceinline__ float wave_sum(float v, int lane) {
#pragma unroll
    for (int o = 1; o < 64; o <<= 1) v += shx(v, lane, o);
    return v;
}
__device__ __forceinline__ float bflo(unsigned w) { return __uint_as_float(w << 16); }
__device__ __forceinline__ float bfhi(unsigned w) { return __uint_as_float(w & 0xffff0000u); }

__device__ __forceinline__ int dst_row(int kind, int ns) {
    if (kind == 0) return ns;
    if (kind == 1) return 256 * (ns >> 7) + (ns & 127);
    if (kind == 2) return 256 * (ns >> 7) + 128 + (ns & 127);
    if (ns < 2048) { const int d = ns & 63; const int c = d < 8 ? 2 * d : d < 16 ? 2 * (d - 8) + 1 : d; return (ns & ~63) + c; }
    if (ns < 4096) return ns;
    if (ns < 5120) { const int j = ns - 4096; return 4096 + 256 * (j >> 7) + (j & 127); }
    { const int j = ns - 5120; return 4096 + 256 * (j >> 7) + 128 + (j & 127); }
}
struct CvtItem { const float* W; bf16* WT; const float* gain; int K, N, kind, r; };
__device__ __forceinline__ void cvt_load(const CvtItem& c, int lane, float (&t)[32]) {
    const int nblk = c.N / 32, kb = c.r / nblk, nb = c.r % nblk;
    const float* src = c.W + (size_t)(64 * kb + (lane >> 5)) * c.N + 32 * nb + (lane & 31);
#pragma unroll
    for (int i = 0; i < 32; ++i) t[i] = __builtin_nontemporal_load(src + (size_t)(2 * i) * c.N);
}
__device__ __forceinline__ void cvt_store(const CvtItem& c, int lane, LAS float* scr) {
    const int nblk = c.N / 32, kb = c.r / nblk, nb = c.r % nblk, k0 = 64 * kb, n0 = 32 * nb;
    const int ch = lane & 7;
    f32x4 ga = (f32x4){1.f, 1.f, 1.f, 1.f}, gb = ga;
    if (c.gain) { ga = *(const f32x4*)(c.gain + k0 + 8 * ch); gb = *(const f32x4*)(c.gain + k0 + 8 * ch + 4); }
#pragma unroll
    for (int j = 0; j < 4; ++j) { const int n = (lane >> 3) + 8 * j; const LAS float* s = scr + (8 * ch) * 33 + n;
        v4u o; o.x = pk2(s[0 * 33] * ga[0], s[1 * 33] * ga[1]); o.y = pk2(s[2 * 33] * ga[2], s[3 * 33] * ga[3]); o.z = pk2(s[4 * 33] * gb[0], s[5 * 33] * gb[1]); o.w = pk2(s[6 * 33] * gb[2], s[7 * 33] * gb[3]);
        *(GAS v4u*)(c.WT + (size_t)dst_row(c.kind, n0 + n) * c.K + k0 + 8 * ch) = o; }
}

__device__ __forceinline__ void stats_phase(Frame& F, const float* x, bf16* XB, unsigned long long* SSQ) {
    const int gw = F.vcu * NWAVES + F.wave, NGW = F.G * NWAVES;
    for (int m = gw; m < M; m += NGW) {
        const float* xr = x + (size_t)m * D; f32x4 v[8]; float s = 0.f;
#pragma unroll
        for (int j = 0; j < 4; ++j) { v[2 * j] = *(const GAS f32x4*)(xr + 512 * j + 8 * F.lane); v[2 * j + 1] = *(const GAS f32x4*)(xr + 512 * j + 8 * F.lane + 4); }
#pragma unroll
        for (int j = 0; j < 8; ++j) s += (v[j].x * v[j].x + v[j].y * v[j].y) + (v[j].z * v[j].z + v[j].w * v[j].w);
        s = wave_sum(s, F.lane);
        if (F.lane == 0) SSQ[m] = (unsigned long long)(s * 16777216.0f);
        bf16* hr = XB + (size_t)m * D;
#pragma unroll
        for (int j = 0; j < 4; ++j) { const f32x4 a = v[2 * j], b = v[2 * j + 1];
            v4u o; o.x = pk2(a.x, a.y); o.y = pk2(a.z, a.w); o.z = pk2(b.x, b.y); o.w = pk2(b.z, b.w);
            *(GAS v4u*)(hr + 512 * j + 8 * F.lane) = o; }
    }
}
__device__ __forceinline__ void final_norm_phase(Frame& F, const bf16* xb, const float* g, float* out) {
    const int gw = F.vcu * NWAVES + F.wave, NGW = F.G * NWAVES;
    f32x4 gv[8];
#pragma unroll
    for (int j = 0; j < 4; ++j) { gv[2 * j] = *(const f32x4*)(g + 512 * j + 8 * F.lane); gv[2 * j + 1] = *(const f32x4*)(g + 512 * j + 8 * F.lane + 4); }
    for (int m = gw; m < M; m += NGW) {
        v4u v[4]; float s = 0.f;
#pragma unroll
        for (int j = 0; j < 4; ++j) v[j] = *(const GAS v4u*)(xb + (size_t)m * D + 512 * j + 8 * F.lane);
#pragma unroll
        for (int j = 0; j < 4; ++j)
#pragma unroll
            for (int q = 0; q < 4; ++q) { const float lo = bflo(v[j][q]), hi = bfhi(v[j][q]); s += lo * lo + hi * hi; }
        const float rstd = 1.0f / sqrtf(wave_sum(s, F.lane) * (1.f / D) + EPS);
        float* orow = out + (size_t)m * D;
#pragma unroll
        for (int j = 0; j < 4; ++j) {
            const f32x4 a = (f32x4){bflo(v[j][0]), bfhi(v[j][0]), bflo(v[j][1]), bfhi(v[j][1])} * rstd * gv[2 * j], b = (f32x4){bflo(v[j][2]), bfhi(v[j][2]), bflo(v[j][3]), bfhi(v[j][3])} * rstd * gv[2 * j + 1];
            *(GAS f32x4*)(orow + 512 * j + 8 * F.lane) = a; *(GAS f32x4*)(orow + 512 * j + 8 * F.lane + 4) = b; }
    }
}
__device__ __forceinline__ void fin_phase(Frame& F, const bf16* O, const bf16* GB, const bf16* CU, bf16* MIX, const float* lq1, const float* lk1, const float* lq2, const float* lk2,
                                          const float* subw, const float* convw, float lam_init) {
    const int gw = F.vcu * NWAVES + F.wave, NGW = F.G * NWAVES, lane = F.lane;
    const float lam = expf(wave_sum(lq1[lane] * lk1[lane], lane)) - expf(wave_sum(lq2[lane] * lk2[lane], lane)) + lam_init;
    const float om = 1.0f - lam_init;
    const int c0 = 16 * lane;
    float sw[16], w0[16], w1[16], w2[16];
#pragma unroll
    for (int j = 0; j < 16; ++j) { sw[j] = subw[(c0 & 127) + j] * om; w0[j] = convw[c0 + j]; w1[j] = convw[1024 + c0 + j]; w2[j] = convw[2048 + c0 + j]; }
    for (int mb = 512 * (gw >> 8) + (gw & 255); mb < 512 * (gw >> 8) + 512; mb += 256) {
        v4u a0[2], a1[2], b0[2], b1[2], g0[2], g1[2], x0[2], x1[2], y0[2], y1[2], u0[2], u1[2];
        const v4u z = (v4u){0u, 0u, 0u, 0u};
#pragma unroll
        for (int k = 0; k < 2; ++k) { const int m = 2 * mb + k;
            a0[k] = *(const GAS v4u*)(O + (size_t)m * 2048 + c0); a1[k] = *(const GAS v4u*)(O + (size_t)m * 2048 + c0 + 8);
            b0[k] = *(const GAS v4u*)(O + (size_t)m * 2048 + 1024 + c0); b1[k] = *(const GAS v4u*)(O + (size_t)m * 2048 + 1024 + c0 + 8);
            g0[k] = *(const GAS v4u*)(GB + (size_t)m * 1024 + c0); g1[k] = *(const GAS v4u*)(GB + (size_t)m * 1024 + c0 + 8);
            x0[k] = *(const GAS v4u*)(CU + (size_t)m * 1024 + c0); x1[k] = *(const GAS v4u*)(CU + (size_t)m * 1024 + c0 + 8); }
        y0[1] = x0[0]; y1[1] = x1[0];
        y0[0] = mb >= 1 ? *(const GAS v4u*)(CU + (size_t)(2 * mb - 1) * 1024 + c0) : z; y1[0] = mb >= 1 ? *(const GAS v4u*)(CU + (size_t)(2 * mb - 1) * 1024 + c0 + 8) : z;
        u0[1] = y0[0]; u1[1] = y1[0];
        u0[0] = mb >= 1 ? *(const GAS v4u*)(CU + (size_t)(2 * mb - 2) * 1024 + c0) : z; u1[0] = mb >= 1 ? *(const GAS v4u*)(CU + (size_t)(2 * mb - 2) * 1024 + c0 + 8) : z;
#pragma unroll
        for (int k = 0; k < 2; ++k) { const int m = 2 * mb + k;
            float d[16]; float ss = 0.f;
#pragma unroll
            for (int q = 0; q < 4; ++q) { d[2 * q] = bflo(a0[k][q]) - lam * bflo(b0[k][q]); d[2 * q + 1] = bfhi(a0[k][q]) - lam * bfhi(b0[k][q]); d[8 + 2 * q] = bflo(a1[k][q]) - lam * bflo(b1[k][q]); d[8 + 2 * q + 1] = bfhi(a1[k][q]) - lam * bfhi(b1[k][q]); }
#pragma unroll
            for (int j = 0; j < 16; ++j) ss += d[j] * d[j];
            ss += shx(ss, lane, 1); ss += shx(ss, lane, 2); ss += shx(ss, lane, 4);
            const float rs = 1.0f / sqrtf(ss * (1.f / 128.f) + EPS);
            v4u o0, o1;
#pragma unroll
            for (int q = 0; q < 4; ++q) { o0[q] = pk2(d[2 * q] * rs * sw[2 * q], d[2 * q + 1] * rs * sw[2 * q + 1]); o1[q] = pk2(d[8 + 2 * q] * rs * sw[8 + 2 * q], d[8 + 2 * q + 1] * rs * sw[8 + 2 * q + 1]); }
            *(GAS v4u*)(MIX + (size_t)m * 2048 + c0) = o0; *(GAS v4u*)(MIX + (size_t)m * 2048 + c0 + 8) = o1;
            v4u p0, p1;
#pragma unroll
            for (int q = 0; q < 4; ++q) {
                const float e0 = bflo(g0[k][q]) * (w0[2 * q] * bflo(u0[k][q]) + w1[2 * q] * bflo(y0[k][q]) + w2[2 * q] * bflo(x0[k][q]));
                const float e1 = bfhi(g0[k][q]) * (w0[2 * q + 1] * bfhi(u0[k][q]) + w1[2 * q + 1] * bfhi(y0[k][q]) + w2[2 * q + 1] * bfhi(x0[k][q]));
                const float e2 = bflo(g1[k][q]) * (w0[8 + 2 * q] * bflo(u1[k][q]) + w1[8 + 2 * q] * bflo(y1[k][q]) + w2[8 + 2 * q] * bflo(x1[k][q]));
                const float e3 = bfhi(g1[k][q]) * (w0[8 + 2 * q + 1] * bfhi(u1[k][q]) + w1[8 + 2 * q + 1] * bfhi(y1[k][q]) + w2[8 + 2 * q + 1] * bfhi(x1[k][q]));
                p0[q] = pk2(e0, e1); p1[q] = pk2(e2, e3); }
            *(GAS v4u*)(MIX + (size_t)m * 2048 + 1024 + c0) = p0; *(GAS v4u*)(MIX + (size_t)m * 2048 + 1024 + c0 + 8) = p1; }
    }
}

struct Args { const float* in[19]; float* out; unsigned char* ws; };
typedef const __attribute__((address_space(4))) Args* cargs_t;
__device__ __forceinline__ cargs_t get_args() { cargs_t p = (cargs_t)__builtin_amdgcn_kernarg_segment_ptr(); asm volatile("" : "+s"(p)); return p; }
__device__ __forceinline__ int bid_o() { int b = (int)__builtin_amdgcn_readfirstlane((int)*(volatile LAS unsigned*)(size_t)(MISC_OFF + 40)); asm volatile("" : "+s"(b)); return b; }
__device__ __forceinline__ int gdim_o() { int g = gridDim.x; asm volatile("" : "+s"(g)); return g; }
__device__ __forceinline__ void make_frame(Frame& F, unsigned char* lds) {
    F.lds = (LAS unsigned char*)lds; F.MISC = (volatile LAS unsigned*)(F.lds + MISC_OFF);
    { int t_ = threadIdx.x; asm volatile("" : "+v"(t_)); F.tid = t_; } F.lane = F.tid & 63; F.wave = __builtin_amdgcn_readfirstlane(F.tid >> 6);
    F.G = gdim_o(); { const int bx = bid_o(); F.vcu = (F.G % 8 == 0) ? (bx % 8) * (F.G / 8) + bx / 8 : bx; }
    F.ctl = (gu32*)(get_args()->ws + WS_CTL);
}
__device__ __forceinline__ void grid_bar(unsigned char* lds) {
    XcdBarrier b; b.bar = (unsigned*)(get_args()->ws + WS_CTL) + CW_BAR; b.x = xb_xcc_id(); b.st = (volatile LAS unsigned*)((LAS unsigned char*)lds + MISC_OFF) + 8;
    xcd_barrier(b);
#if PROBE_BAR2
    xcd_barrier(b);
#endif
#if PROBE_SLEEP
    { const unsigned long long t0 = __builtin_amdgcn_s_memrealtime(); while (__builtin_amdgcn_s_memrealtime() - t0 < 1000ull) __builtin_amdgcn_s_sleep(32); }
#endif
}
__device__ __forceinline__ void grid_bar_local(unsigned char* lds) {
#if LOCAL_BAR
    if (*((volatile LAS unsigned*)((LAS unsigned char*)lds + MISC_OFF) + 11) == 0u) { grid_bar(lds); return; }
    XcdBarrier b; b.bar = (unsigned*)(get_args()->ws + WS_CTL) + CW_BAR; b.x = xb_xcc_id(); b.st = (volatile LAS unsigned*)((LAS unsigned char*)lds + MISC_OFF) + 8;
    xcd_barrier_local(b);
#else
    grid_bar(lds);
#endif
}
__device__ __forceinline__ unsigned char* wlayer(cargs_t a, int l) { return a->ws + WS_W + (size_t)l * W_LAYER; }

constexpr int I_G = (D / 64) * (FF / 32), I_D = (FF / 64) * (D / 32), I_IN = (D / 64) * (NIN / 32), I_OUT = (D / 64) * (D / 32), I_LAYER = 4 * I_G + 2 * I_D + I_IN + I_OUT;
constexpr int CVT_B0 = 2 * I_G, CVT_UP2 = 4 * I_G + I_D + I_IN + I_OUT;
__device__ __forceinline__ int cvt_end(int s) { const int e = CVT_UP2 + s * (I_LAYER / 2); return e < DEPTH * I_LAYER ? e : DEPTH * I_LAYER; }
__device__ __forceinline__ void cvt_decode(cargs_t a, int l, int it, CvtItem& c) {
    unsigned char* wl = a->ws + WS_W + (size_t)l * W_LAYER; int r = it;
    if (r < I_G) { c = CvtItem{a->in[2] + (size_t)l * D * FF, (bf16*)(wl + WO_GU1), a->in[1] + (size_t)l * D, D, FF, 1, r}; return; } r -= I_G;
    if (r < I_G) { c = CvtItem{a->in[3] + (size_t)l * D * FF, (bf16*)(wl + WO_GU1), a->in[1] + (size_t)l * D, D, FF, 2, r}; return; } r -= I_G;
    if (r < I_D) { c = CvtItem{a->in[4] + (size_t)l * FF * D, (bf16*)(wl + WO_D1), nullptr, FF, D, 0, r}; return; } r -= I_D;
    if (r < I_IN) { c = CvtItem{a->in[6] + (size_t)l * D * NIN, (bf16*)(wl + WO_IN), a->in[5] + (size_t)l * D, D, NIN, 3, r}; return; } r -= I_IN;
    if (r < I_OUT) { c = CvtItem{a->in[13] + (size_t)l * D * D, (bf16*)(wl + WO_OUT), nullptr, D, D, 0, r}; return; } r -= I_OUT;
    if (r < I_G) { c = CvtItem{a->in[15] + (size_t)l * D * FF, (bf16*)(wl + WO_GU2), a->in[14] + (size_t)l * D, D, FF, 1, r}; return; } r -= I_G;
    if (r < I_G) { c = CvtItem{a->in[16] + (size_t)l * D * FF, (bf16*)(wl + WO_GU2), a->in[14] + (size_t)l * D, D, FF, 2, r}; return; } r -= I_G;
    c = CvtItem{a->in[17] + (size_t)l * FF * D, (bf16*)(wl + WO_D2), nullptr, FF, D, 0, r};
}
__device__ __forceinline__ void convert_items(unsigned char* lds, int lo, int hi, int worker, int nworkers) {
    Frame F; make_frame(F, lds); cargs_t a = get_args();
    LAS float* scr = (LAS float*)(F.lds + RING_OFF + F.wave * 16384);
    int it = lo + worker; if (it >= hi) return;
    CvtItem cur, nxt; float t[32];
    cvt_decode(a, it / I_LAYER, it % I_LAYER, cur); cvt_load(cur, F.lane, t);
    for (;;) {
#pragma unroll
        for (int i = 0; i < 32; ++i) scr[(2 * i + (F.lane >> 5)) * 33 + (F.lane & 31)] = t[i];
        LDS_WAIT(); asm volatile("" ::: "memory");
        const int ni = it + nworkers; const bool more = ni < hi;
        if (more) { cvt_decode(a, ni / I_LAYER, ni % I_LAYER, nxt); cvt_load(nxt, F.lane, t); }
        cvt_store(cur, F.lane, scr);
        LDS_WAIT(); asm volatile("" ::: "memory");
        if (!more) break;
        cur = nxt; it = ni;
    }
}
__device__ __forceinline__ void ph_prologue(unsigned char* lds) {
    Frame F; make_frame(F, lds);
    convert_items(lds, 0, FILLER ? CVT_B0 : DEPTH * I_LAYER, F.vcu * NWAVES + F.wave, F.G * NWAVES);
    cargs_t a = get_args(); unsigned char* ws = a->ws;
    float* CS = (float*)(ws + WS_CS);
    for (int i = bid_o() * (NWAVES * 64) + F.tid; i < M * 8; i += F.G * NWAVES * 64) {
        const int pos = i >> 3, fi = i & 7; const float ang = (float)pos * INV_FREQ[fi];
        CS[(size_t)pos * 16 + fi] = cosf(ang); CS[(size_t)pos * 16 + 8 + fi] = sinf(ang); }
    stats_phase(F, a->in[0], (bf16*)(ws + WS_XB), (unsigned long long*)(ws + WS_SSQ));
}
__device__ __forceinline__ void ph_gateup(unsigned char* lds, int l, int second) {
    { cargs_t a = get_args(); unsigned char* ws = a->ws;
      pg8::Gemm g{(const bf16*)(ws + WS_XB), (const bf16*)(wlayer(a, l) + (second ? WO_GU2 : WO_GU1)), M, 2 * FF, D}; pg8::StaticOrder S; S.init(M, 2 * FF, gdim_o(), bid_o());
      pg8::EpiSwiGLU E{(bf16*)(ws + WS_ACT), FF, (const unsigned long long*)(ws + WS_SSQ) + (3 * l + (second ? 2 : 0)) * M};
#if PROBE_CLK == 1
      unsigned long long c0_ = __builtin_amdgcn_s_memtime(), r0_ = __builtin_amdgcn_s_memrealtime();
#endif
      pg8::gemm_phase<pg8::EpiSwiGLU, pg8::StaticOrder, PG8_ALIGN, PG8_SP2>((LAS unsigned char*)lds + RING_OFF, g, S, E);
#if PROBE_CLK == 1
      { const unsigned long long c1_ = __builtin_amdgcn_s_memtime(), r1_ = __builtin_amdgcn_s_memrealtime(); volatile LAS unsigned* MISC = (volatile LAS unsigned*)((LAS unsigned char*)lds + MISC_OFF);
        if (threadIdx.x == 0) { MISC[14] += (unsigned)((c1_ - c0_) >> 4); MISC[15] += (unsigned)(r1_ - r0_); } }
#endif
      }
    const int bx = bid_o();
    if (FILLER && bx >= 128 && gdim_o() == 256) {
        int t_ = threadIdx.x; asm volatile("" : "+v"(t_)); const int wave = __builtin_amdgcn_readfirstlane(t_ >> 6);
        const int s = 2 * l + second;
        convert_items(lds, s == 0 ? CVT_B0 : cvt_end(s - 1), cvt_end(s), (bx - 128) * NWAVES + wave, 128 * NWAVES);
#if PROBE_DUP == 5
        convert_items(lds, s == 0 ? CVT_B0 : cvt_end(s - 1), cvt_end(s), (bx - 128) * NWAVES + wave, 128 * NWAVES);
#endif
    }
}
__device__ __forceinline__ void ph_down(unsigned char* lds, int l, int second, int dummy = 0) {
    cargs_t a = get_args(); unsigned char* ws = a->ws;
    pg8::Gemm g{(const bf16*)(ws + WS_ACT), (const bf16*)(wlayer(a, l) + (second ? WO_D2 : WO_D1)), M, D, FF}; pg8::StaticOrder S; S.init(M, D, gdim_o(), bid_o());
    pg8::EpiResidual E{(bf16*)(ws + WS_XB), D, 0.5f, (unsigned long long*)(ws + WS_SSQ) + (3 * l + (second ? 3 : 1)) * M};
    pg8::gemm_phase<pg8::EpiResidual, pg8::StaticOrder, PG8_ALIGN1, PG8_SP2>((LAS unsigned char*)lds + RING_OFF, g, S, E);
}
template <int MODE> __device__ __forceinline__ void ph_win_part(unsigned char* lds, int l) {
    cargs_t a = get_args(); unsigned char* ws = a->ws;
    pg8::Gemm g{(const bf16*)(ws + WS_XB), (const bf16*)(wlayer(a, l) + WO_IN) + (size_t)MODE * 2048 * D, M, D, D}; pg8::StaticOrder S; S.init(M, D, gdim_o(), bid_o());
    pg8::EpiWin<MODE> E{(bf16*)(ws + (MODE == 0 ? WS_Q : MODE == 1 ? WS_V : WS_CU)), (bf16*)(ws + (MODE == 0 ? WS_K : WS_GB)), (const float*)(ws + WS_CS), attn_body::C2, (const unsigned long long*)(ws + WS_SSQ) + (3 * l + 1) * M};
    pg8::gemm_phase<pg8::EpiWin<MODE>, pg8::StaticOrder, PG8_ALIGN, PG8_SP2>((LAS unsigned char*)lds + RING_OFF, g, S, E);
}
#if WIN_SPLIT
__device__ __forceinline__ void ph_win(unsigned char* lds, int l) { ph_win_part<0>(lds, l); ph_win_part<1>(lds, l); ph_win_part<2>(lds, l); }
#else
__device__ __forceinline__ void ph_win(unsigned char* lds, int l) {
    cargs_t a = get_args(); unsigned char* ws = a->ws;
    const bf16* W = (const bf16*)(wlayer(a, l) + WO_IN);
    pg8::Gemm g{(const bf16*)(ws + WS_XB), W, M, D, D}; pg8::StaticOrder S; S.init(M, D, gdim_o(), bid_o());
    const float* cs = (const float*)(ws + WS_CS); const unsigned long long* ssq = (const unsigned long long*)(ws + WS_SSQ) + (3 * l + 1) * M;
    pg8::EpiWin<0> E0{(bf16*)(ws + WS_Q), (bf16*)(ws + WS_K), cs, attn_body::C2, ssq};
    pg8::EpiWin<1> E1{(bf16*)(ws + WS_V), (bf16*)(ws + WS_GB), cs, attn_body::C2, ssq};
    pg8::EpiWin<2> E2{(bf16*)(ws + WS_CU), (bf16*)(ws + WS_GB), cs, attn_body::C2, ssq};
    const bf16* W1 = W + (size_t)2048 * D; const bf16* W2 = W + (size_t)4096 * D;
    asm volatile("" : "+s"(W1), "+s"(W2));
    pg8::gemm_phase3<pg8::EpiWin<0>, pg8::EpiWin<1>, pg8::EpiWin<2>, pg8::StaticOrder, PG8_ALIGN, PG8_SP2>((LAS unsigned char*)lds + RING_OFF, g, W1, W2, S, E0, E1, E2);
}

#endif
__device__ __forceinline__ void ph_attn(unsigned char* lds) {
    unsigned char* ws = get_args()->ws;
    const attn_body::AttnTensors AT{(const attn_body::bf16*)(ws + WS_Q), (const attn_body::bf16*)(ws + WS_K), (const attn_body::bf16*)(ws + WS_V), (attn_body::bf16*)(ws + WS_O)};
    const attn_body::StaticOrder S(gdim_o(), bid_o());
    attn_body::attn_phase<attn_body::StaticOrder>((char*)lds + RING_OFF, AT, S);
}
__device__ __forceinline__ void ph_fin(unsigned char* lds, int l) {
    Frame F; make_frame(F, lds); cargs_t a = get_args(); unsigned char* ws = a->ws;
    fin_phase(F, (const bf16*)(ws + WS_O), (const bf16*)(ws + WS_GB), (const bf16*)(ws + WS_CU), (bf16*)(ws + WS_MIX), a->in[8] + l * 64, a->in[9] + l * 64, a->in[10] + l * 64, a->in[11] + l * 64,
              a->in[12] + l * 128, a->in[7] + (size_t)l * 3 * 1024, LAM_INIT[l]);
}
__device__ __forceinline__ void ph_wout(unsigned char* lds, int l) {
    cargs_t a = get_args(); unsigned char* ws = a->ws;
    pg8::Gemm g{(const bf16*)(ws + WS_MIX), (const bf16*)(wlayer(a, l) + WO_OUT), M, D, D}; pg8::StaticOrder S; S.init(M, D, gdim_o(), bid_o());
    pg8::EpiResidual E{(bf16*)(ws + WS_XB), D, 1.0f, (unsigned long long*)(ws + WS_SSQ) + (3 * l + 2) * M};
    pg8::gemm_phase<pg8::EpiResidual, pg8::StaticOrder, PG8_ALIGN1, PG8_SP2>((LAS unsigned char*)lds + RING_OFF, g, S, E);
}
__device__ __forceinline__ void ph_final(unsigned char* lds) {
    Frame F; make_frame(F, lds); cargs_t a = get_args();
    final_norm_phase(F, (const bf16*)(a->ws + WS_XB), a->in[18], a->out);
}

__global__ void __launch_bounds__(NWAVES * 64, 2) mk_fwd(Args args) {
    extern __shared__ __attribute__((aligned(16))) unsigned char lds[];
    for (int u = threadIdx.x; u < (LDS_BYTES - LDSCTL_OFF) / 4; u += NWAVES * 64) ((LAS unsigned*)((LAS unsigned char*)lds + LDSCTL_OFF))[u] = 0u;
    __syncthreads();
    { volatile LAS unsigned* MISC = (volatile LAS unsigned*)((LAS unsigned char*)lds + MISC_OFF);
      if (threadIdx.x == 0) { unsigned* bar = (unsigned*)(get_args()->ws + WS_CTL) + CW_BAR; MISC[12] = xb_add(&bar[XB_XCNT(xb_xcc_id())], 1u); MISC[10] = blockIdx.x; }
      __syncthreads(); }
    ph_prologue(lds);
    grid_bar(lds);
    { volatile LAS unsigned* MISC = (volatile LAS unsigned*)((LAS unsigned char*)lds + MISC_OFF);
      if (threadIdx.x == 0) { unsigned* bar = (unsigned*)(get_args()->ws + WS_CTL) + CW_BAR; const unsigned x = xb_xcc_id(); bool ok = gridDim.x == 256u; unsigned npop = 0u, below = 0u;
          for (unsigned j = 0; j < 16u; ++j) { const unsigned c = xb_ld(&bar[XB_XCNT(j)]); if (c != 0u && c != 32u) ok = false; if (c == 32u) { ++npop; if (j < x) ++below; } }
          if (ok && npop == 8u && LOCAL_BAR) { MISC[10] = MISC[12] * 8u + below; MISC[11] = 1u; } }
      __syncthreads(); }
#if PROBE_DUP == 4
    ph_prologue(lds);
    grid_bar(lds);
#endif
#pragma unroll 1
    for (int l = 0; l < DEPTH; ++l) {
        ph_gateup(lds, l, 0); grid_bar(lds);
#if PROBE_DUP == 1
        ph_gateup(lds, l, 0); grid_bar(lds);
#endif
        ph_down(lds, l, 0); grid_bar_local(lds);
        ph_win(lds, l); grid_bar(lds);
#if PROBE_DUP == 3
        ph_win(lds, l); grid_bar(lds);
#endif
#if PROBE_CLK == 2
        { const unsigned long long c0_ = __builtin_amdgcn_s_memtime(), r0_ = __builtin_amdgcn_s_memrealtime();
          ph_attn(lds);
          const unsigned long long c1_ = __builtin_amdgcn_s_memtime(), r1_ = __builtin_amdgcn_s_memrealtime(); volatile LAS unsigned* MISC = (volatile LAS unsigned*)((LAS unsigned char*)lds + MISC_OFF);
          if (threadIdx.x == 0) { MISC[14] += (unsigned)((c1_ - c0_) >> 4); MISC[15] += (unsigned)(r1_ - r0_); } }
        grid_bar(lds);
#else
        ph_attn(lds); grid_bar(lds);
#endif
#if PROBE_DUP == 2
        ph_attn(lds); grid_bar(lds);
#endif
        ph_fin(lds, l); grid_bar_local(lds);
        ph_wout(lds, l); grid_bar_local(lds);
        ph_gateup(lds, l, 1); grid_bar(lds);
        ph_down(lds, l, 1); if (l + 1 < DEPTH) grid_bar_local(lds); else grid_bar(lds);
    }
    ph_final(lds);
#if PROBE_CLK
    { volatile LAS unsigned* MISC = (volatile LAS unsigned*)((LAS unsigned char*)lds + MISC_OFF);
      if (blockIdx.x == 0 && threadIdx.x == 0) { const unsigned long long tgt = (unsigned long long)MISC[14] * 16ull * 5000ull / (unsigned long long)(MISC[15] ? MISC[15] : 1u);
          const unsigned long long t0 = __builtin_amdgcn_s_memrealtime(); while (__builtin_amdgcn_s_memrealtime() - t0 < tgt) __builtin_amdgcn_s_sleep(32); } }
#endif
}

extern "C" void kernel_launch(void* const* d_in, const int* in_sizes, int n_in, void* d_out, int out_size, void* d_ws, size_t ws_size, hipStream_t stream) {
    static int grid = 0;
    if (grid == 0) {
        if (n_in != 19 || in_sizes[0] != M * D || out_size != M * D || ws_size < WS_END) { fprintf(stderr, "kernel_launch: built for 19 inputs, x and out of %d floats, >= %zu bytes of workspace; got n_in %d, in0 %d, out %d, ws %zu; nothing launched\n", M * D, (size_t)WS_END, n_in, n_in > 0 ? in_sizes[0] : -1, out_size, ws_size); grid = -1; return; }
        int dev = 0, cus = 0, per_cu = 0;
        if (hipGetDevice(&dev) != hipSuccess || hipDeviceGetAttribute(&cus, hipDeviceAttributeMultiprocessorCount, dev) != hipSuccess) { fprintf(stderr, "kernel_launch: hipGetDevice / hipDeviceGetAttribute failed; nothing launched\n"); grid = -1; return; }
        if (hipFuncSetAttribute((const void*)mk_fwd, hipFuncAttributeMaxDynamicSharedMemorySize, LDS_BYTES) != hipSuccess) { fprintf(stderr, "kernel_launch: hipFuncSetAttribute failed\n"); grid = -1; return; }
        if (hipOccupancyMaxActiveBlocksPerMultiprocessor(&per_cu, (const void*)mk_fwd, NWAVES * 64, LDS_BYTES) != hipSuccess || per_cu < 1)
            fprintf(stderr, "kernel_launch: note: the occupancy query reports %d workgroups per CU\n", per_cu);
        (void)hipGetLastError();
        grid = 256;
        if (cus != 256) fprintf(stderr, "kernel_launch: device has %d CUs; this kernel is built for 256\n", cus);
    }
    if (grid < 0) return;
    if (hipMemsetAsync((char*)d_ws + WS_CTL, 0, CTL_ZERO_BYTES, stream) != hipSuccess) { fprintf(stderr, "kernel_launch: hipMemsetAsync of the control words failed; nothing launched\n"); return; }
    Args a{};
    for (int i = 0; i < 19; ++i) a.in[i] = (const float*)d_in[i];
    a.out = (float*)d_out; a.ws = (unsigned char*)d_ws;
    hipLaunchKernelGGL(mk_fwd, dim3(grid), dim3(NWAVES * 64), LDS_BYTES, stream, a);
    const hipError_t le = hipPeekAtLastError();
    if (le != hipSuccess) fprintf(stderr, "kernel_launch: launch failed: %s\n", hipGetErrorName(le));
}
```

```cpp
#define PG8_MV 1
#define PG8_PRIO_M 0
#define PG8_PRIO_L 1
#include <hip/hip_runtime.h>
#include <cstdio>
#include <cstdint>
#ifndef PG8_WGM
#define PG8_WGM 4
#endif
namespace pg8 {
#define PG8_LAS __attribute__((address_space(3)))
typedef unsigned short bf16_t;
typedef short bf16x8 __attribute__((ext_vector_type(8)));
typedef float f32x4 __attribute__((ext_vector_type(4)));
typedef unsigned u32x4 __attribute__((ext_vector_type(4)));
constexpr int BM = 256, BK = 64, HALF = 128, HTB = HALF * BK * 2  , STAGE_BYTES = 8 * HTB, NXCD = 8, WGM = PG8_WGM;

__host__ __device__ __forceinline__ int lds_byte(int r, int c) { const int st = (r >> 4) * 2 + (c >> 5), rr = r & 15, cc = c & 31, ob = rr * 64 + cc * 2; return st * 1024 + (ob ^ (((ob >> 9) & 1) << 5)); }
__host__ __device__ __forceinline__ void stage_rc(int b, int& R, int& C) { const int st = b / 1024, sb = b % 1024, swz = sb ^ (((sb >> 9) & 1) << 5); R = (st >> 1) * 16 + swz / 64; C = (st & 1) * 32 + (swz % 64) / 2; }
__host__ __device__ __forceinline__ int perm32(int rho) { const int n = rho >> 4, i = rho & 15; return 8 * (i >> 2) + 4 * n + (i & 3); }

struct Unit { int pm, pn; };
struct Gemm { const bf16_t* A; const bf16_t* Bt; int M, N, K; };

struct StaticOrder {
    int nM, nN, nwg, G, c;
    __host__ __device__ void init(int M, int N, int G_, int c_) { nM = M / BM; nN = N / BM; nwg = nM * nN; G = G_; c = c_; }
    __host__ __device__ bool next(int i, Unit& u) const {
        const long L = (long)i * G + c; if (L >= nwg) return false;
        int wgid = (int)L; { const int q = nwg / NXCD, r = nwg % NXCD, xcd = wgid % NXCD, off = wgid / NXCD; wgid = (xcd < r ? xcd * (q + 1) : r * (q + 1) + (xcd - r) * q) + off; }
        const int nig = WGM * nN, gid = wgid / nig, fm = gid * WGM, gsz = (nM - fm) < WGM ? (nM - fm) : WGM;
        u.pm = fm + ((wgid % nig) % gsz); u.pn = (wgid % nig) / gsz; return true;
    }
    __device__ __forceinline__ void a_ready(const Unit&) const {}
    __device__ __forceinline__ void done(const Unit&) const {}
};

__device__ __forceinline__ unsigned cvt_pk_bf16(float lo, float hi) { unsigned r; asm volatile("v_cvt_pk_bf16_f32 %0, %1, %2" : "=v"(r) : "v"(lo), "v"(hi)); return r; }
typedef float f32x2 __attribute__((ext_vector_type(2)));
#define PG8_GAS __attribute__((address_space(1)))
__device__ __forceinline__ int lane_now() { int l; asm volatile("v_mbcnt_lo_u32_b32 %0, -1, 0\n\tv_mbcnt_hi_u32_b32 %0, -1, %0" : "=v"(l)); return l; }
__device__ __forceinline__ float sum_fq(float s, int fr, int fq) { const int l4 = (fr + 16 * fq) << 2;
    s += __int_as_float(__builtin_amdgcn_ds_bpermute(l4 ^ 64, __float_as_int(s))); s += __int_as_float(__builtin_amdgcn_ds_bpermute(l4 ^ 128, __float_as_int(s))); return s; }
__device__ __forceinline__ float silu_f(float g) { const float e = __builtin_amdgcn_exp2f(g * -1.4426950408889634f); return g * __builtin_amdgcn_rcpf(1.0f + e); }

__device__ __forceinline__ void row_rstd(const unsigned long long* ssq, int row0, float (&rs)[2][4]) {
#pragma unroll
    for (int ai = 0; ai < 2; ++ai)
#pragma unroll
        for (int m = 0; m < 4; ++m) { const unsigned long long v = *(const PG8_GAS unsigned long long*)(ssq + (unsigned)(row0 + ai * HALF + m * 16));
            const float s = (float)(unsigned)(v >> 24) + (float)((unsigned)v & 0xffffffu) * (1.0f / 16777216.0f);
            rs[ai][m] = __builtin_amdgcn_rsqf(s * (1.0f / 2048.0f) + 1e-5f); }
}
constexpr int RSTD_OFF = 131072 + 1024;
__device__ __forceinline__ unsigned long long rstd_fetch(const unsigned long long* ssq, int row) { return *(const PG8_GAS unsigned long long*)(ssq + (unsigned)row); }
__device__ __forceinline__ void rstd_put(unsigned long long v, int slot) {
    const float s = (float)(unsigned)(v >> 24) + (float)((unsigned)v & 0xffffffu) * (1.0f / 16777216.0f);
    *(PG8_LAS float*)(size_t)(RSTD_OFF + 4 * slot) = __builtin_amdgcn_rsqf(s * (1.0f / 2048.0f) + 1e-5f);
}
__device__ __forceinline__ void row_rstd_tab(int rl0, float (&rs)[2][4]) {
#pragma unroll
    for (int ai = 0; ai < 2; ++ai)
#pragma unroll
        for (int m = 0; m < 4; ++m) rs[ai][m] = *(const PG8_LAS float*)(size_t)(RSTD_OFF + 4 * (rl0 + ai * HALF + m * 16));
}
__device__ __forceinline__ void pin_acc(f32x4 (&acc)[2][2][4][2]) {
#pragma unroll
    for (int ai = 0; ai < 2; ++ai)
#pragma unroll
        for (int m = 0; m < 4; ++m) asm volatile("" : "+v"(acc[ai][0][m][0]), "+v"(acc[ai][0][m][1]), "+v"(acc[ai][1][m][0]), "+v"(acc[ai][1][m][1]));
}
struct EpiSwiGLU {
    static constexpr bool PERM = true, AFTER_DRAIN = false, RSTD = true;
    bf16_t* O; int ldc; const unsigned long long* ssq;
    __device__ __forceinline__ void operator()(f32x4 (&acc)[2][2][4][2], const Unit& u, int wr, int wc, int fr, int fq, int pm_tab) const {
        const int row0 = u.pm * BM + wr * 64 + fr, col0 = u.pn * HALF + wc * 32 + 8 * fq;
        float rs[2][4]; if (u.pm == pm_tab) row_rstd_tab(wr * 64 + fr, rs); else row_rstd(ssq, row0, rs);
#pragma unroll
        for (int ai = 0; ai < 2; ++ai)
#pragma unroll
            for (int m = 0; m < 4; ++m) { bf16_t* rowp = O + (unsigned)((row0 + ai * HALF + m * 16) * ldc + col0);
                const float r_ = rs[ai][m]; const f32x2 ce = (f32x2){r_, r_} * -1.4426950408889634f, r2 = (f32x2){r_, r_} * (f32x2){r_, r_};
                u32x4 w;
#pragma unroll
                for (int h = 0; h < 4; ++h) { const f32x4 gq = acc[ai][0][m][h >> 1], uq = acc[ai][1][m][h >> 1];
                    const f32x2 g = (h & 1) ? (f32x2){gq[2], gq[3]} : (f32x2){gq[0], gq[1]}, u2 = (h & 1) ? (f32x2){uq[2], uq[3]} : (f32x2){uq[0], uq[1]};
                    f32x2 e = g * ce; e = (f32x2){__builtin_amdgcn_exp2f(e[0]), __builtin_amdgcn_exp2f(e[1])} + 1.0f; e = (f32x2){__builtin_amdgcn_rcpf(e[0]), __builtin_amdgcn_rcpf(e[1])};
                    const f32x2 o = (g * u2) * (r2 * e); w[h] = cvt_pk_bf16(o[0], o[1]); }
                *(PG8_GAS u32x4*)rowp = w; __builtin_amdgcn_sched_barrier(0); }
    }
};
struct EpiResidual {
    static constexpr bool PERM = true, AFTER_DRAIN = false, RSTD = false;
    bf16_t* xb; int ldc; float scale; unsigned long long* ssq;
    __device__ __forceinline__ void operator()(f32x4 (&acc)[2][2][4][2], const Unit& u, int wr, int wc, int fr, int fq, int pm_tab) const {
        const int row0 = u.pm * BM + wr * 64 + fr, col0 = u.pn * BM + wc * 32 + 8 * fq;
        u32x4 nb[2][2];
#pragma unroll
        for (int p = 0; p < 2; ++p)
#pragma unroll
            for (int bj = 0; bj < 2; ++bj) nb[p][bj] = *(const PG8_GAS u32x4*)(xb + (unsigned)((row0 + p * 16) * ldc + col0 + bj * HALF));
#pragma unroll
        for (int g = 0; g < 8; ++g) { const int ai = g >> 2, m = g & 3;
            u32x4 cb[2];
#pragma unroll
            for (int bj = 0; bj < 2; ++bj) cb[bj] = nb[g & 1][bj];
            asm volatile("" ::: "memory");
            if (g < 6) { const unsigned off = (unsigned)((row0 + ((g + 2) >> 2) * HALF + ((g + 2) & 3) * 16) * ldc + col0);
#pragma unroll
                for (int bj = 0; bj < 2; ++bj) nb[g & 1][bj] = *(const PG8_GAS u32x4*)(xb + (off + bj * HALF)); }
#pragma unroll
            for (int bj = 0; bj < 2; ++bj) { const u32x4 x = cb[bj];
                acc[ai][bj][m][0] = (f32x4){__uint_as_float(x.x << 16), __uint_as_float(x.x & 0xffff0000u), __uint_as_float(x.y << 16), __uint_as_float(x.y & 0xffff0000u)} + acc[ai][bj][m][0] * scale;
                acc[ai][bj][m][1] = (f32x4){__uint_as_float(x.z << 16), __uint_as_float(x.z & 0xffff0000u), __uint_as_float(x.w << 16), __uint_as_float(x.w & 0xffff0000u)} + acc[ai][bj][m][1] * scale; }
            asm volatile("" : "+v"(acc[ai][0][m][0]), "+v"(acc[ai][0][m][1]), "+v"(acc[ai][1][m][0]), "+v"(acc[ai][1][m][1])); }
        asm volatile("" ::: "memory");
#pragma unroll
        for (int ai = 0; ai < 2; ++ai)
#pragma unroll
            for (int m = 0; m < 4; ++m) { const int row = row0 + ai * HALF + m * 16; const unsigned off = (unsigned)(row * ldc + col0); float s = 0.f;
#pragma unroll
                for (int bj = 0; bj < 2; ++bj) { const f32x4 a0 = acc[ai][bj][m][0], a1 = acc[ai][bj][m][1];
                    u32x4 w; w.x = cvt_pk_bf16(a0[0], a0[1]); w.y = cvt_pk_bf16(a0[2], a0[3]); w.z = cvt_pk_bf16(a1[0], a1[1]); w.w = cvt_pk_bf16(a1[2], a1[3]);
                    *(PG8_GAS u32x4*)(xb + (off + bj * HALF)) = w;
#pragma unroll
                    for (int q = 0; q < 4; ++q) { const float lo = __uint_as_float(w[q] << 16), hi = __uint_as_float(w[q] & 0xffff0000u); s += lo * lo + hi * hi; } }
                s = sum_fq(s, fr, fq);
                if (fq == 0) (void)__hip_atomic_fetch_add(ssq + (unsigned)row, (unsigned long long)(s * 16777216.0f), __ATOMIC_RELAXED, __HIP_MEMORY_SCOPE_AGENT); }
    }
};
template <int MODE> struct EpiWin {
    static constexpr bool PERM = true, AFTER_DRAIN = false, RSTD = true;
    bf16_t *O0, *O1; const float* cs; float qscale; const unsigned long long* ssq;
    __device__ __forceinline__ void operator()(f32x4 (&acc)[2][2][4][2], const Unit& u, int wr, int wc, int fr, int fq, int pm_tab) const {
        const int row0 = u.pm * BM + wr * 64 + fr; const int pn = u.pn;
        float rs[2][4]; if (u.pm == pm_tab) row_rstd_tab(wr * 64 + fr, rs); else row_rstd(ssq, row0, rs);
        if constexpr (MODE == 2) {
            const int col0 = pn * HALF + wc * 32 + 8 * fq;
#pragma unroll
            for (int ai = 0; ai < 2; ++ai)
#pragma unroll
                for (int m = 0; m < 4; ++m) { bf16_t* rowp = O0 + (unsigned)((row0 + ai * HALF + m * 16) * 1024 + col0);
                    const float r2 = rs[ai][m] * rs[ai][m]; const f32x4 a0 = acc[ai][0][m][0] * acc[ai][1][m][0] * r2, a1 = acc[ai][0][m][1] * acc[ai][1][m][1] * r2;
                    u32x4 w; w.x = cvt_pk_bf16(a0[0], a0[1]); w.y = cvt_pk_bf16(a0[2], a0[3]); w.z = cvt_pk_bf16(a1[0], a1[1]); w.w = cvt_pk_bf16(a1[2], a1[3]);
                    *(PG8_GAS u32x4*)rowp = w; }
        } else {
            const int col0 = (pn & 3) * BM + wc * 32 + 8 * fq;
            bf16_t* base = pn < 4 ? O0 : O1; const float sc = (MODE == 0 && pn < 4) ? qscale : 1.0f;
            if constexpr (MODE == 0) {
                const bool rope = ((wc & 1) == 0) && (fq < 2); const int fo = 4 * (fq & 1);
#pragma unroll
                for (int ai = 0; ai < 2; ++ai) { f32x4 c[4], s[4];
#pragma unroll
                    for (int m = 0; m < 4; ++m) { const int row = row0 + ai * HALF + m * 16; c[m] = *(const PG8_GAS f32x4*)(cs + (unsigned)(row * 16 + fo)); s[m] = *(const PG8_GAS f32x4*)(cs + (unsigned)(row * 16 + 8 + fo));
                        if (!rope) { c[m] = (f32x4){1.f, 1.f, 1.f, 1.f}; s[m] = (f32x4){0.f, 0.f, 0.f, 0.f}; } }
#pragma unroll
                    for (int m = 0; m < 4; ++m) {
#pragma unroll
                        for (int bj = 0; bj < 2; ++bj) { const f32x4 v0 = acc[ai][bj][m][0], v1 = acc[ai][bj][m][1], cc = c[m], ss = s[m]; f32x4 o0, o1;
                            o0[0] = v0[0] * cc[0] - v0[1] * ss[0]; o0[1] = v0[1] * cc[0] + v0[0] * ss[0]; o0[2] = v0[2] * cc[1] - v0[3] * ss[1]; o0[3] = v0[3] * cc[1] + v0[2] * ss[1];
                            o1[0] = v1[0] * cc[2] - v1[1] * ss[2]; o1[1] = v1[1] * cc[2] + v1[0] * ss[2]; o1[2] = v1[2] * cc[3] - v1[3] * ss[3]; o1[3] = v1[3] * cc[3] + v1[2] * ss[3];
                            acc[ai][bj][m][0] = o0; acc[ai][bj][m][1] = o1; }
                        asm volatile("" : "+v"(acc[ai][0][m][0]), "+v"(acc[ai][0][m][1]), "+v"(acc[ai][1][m][0]), "+v"(acc[ai][1][m][1])); }
                    asm volatile("" ::: "memory"); }
            }
#pragma unroll
            for (int ai = 0; ai < 2; ++ai)
#pragma unroll
                for (int m = 0; m < 4; ++m) { const int row = row0 + ai * HALF + m * 16; bf16_t* rowp = base + (unsigned)(row * 1024 + col0); const float f = sc * rs[ai][m];
#pragma unroll
                    for (int bj = 0; bj < 2; ++bj) { const f32x4 o0 = acc[ai][bj][m][0] * f, o1 = acc[ai][bj][m][1] * f;
                        u32x4 w; w.x = cvt_pk_bf16(o0[0], o0[1]); w.y = cvt_pk_bf16(o0[2], o0[3]); w.z = cvt_pk_bf16(o1[0], o1[1]); w.w = cvt_pk_bf16(o1[2], o1[3]);
                        *(PG8_GAS u32x4*)(rowp + bj * HALF) = w; } }
        }
    }
};

#ifndef PG8_PRIO_M
#define PG8_PRIO_M 1
#endif
#ifndef PG8_PRIO_L
#define PG8_PRIO_L 0
#endif
#ifndef PG8_MV
#define PG8_MV 0
#endif
__device__ __forceinline__ void glds16_s(const void* gbase, unsigned voff, unsigned lds_dst) {
    asm volatile("s_mov_b32 m0, %2\n\ts_nop 0\n\tglobal_load_lds_dwordx4 %0, %1" :: "v"(voff), "s"(gbase), "s"(lds_dst) : "memory", "m0");
}
template <bool B> struct ZTag { static constexpr bool value = B; };
template <class Epi, class Sched, bool ALIGN_EPI = false, bool SP2 = false>
__device__ __forceinline__ void gemm_phase(PG8_LAS unsigned char* lds, const Gemm g, const Sched& S, const Epi& E) {
    int tid_ = threadIdx.x; asm volatile("" : "+v"(tid_));
    const int tid = tid_, wid = __builtin_amdgcn_readfirstlane(tid >> 6), lane = tid & 63, wr = wid >> 2, wc = wid & 3, fr = lane & 15, fq = lane >> 4;
    constexpr bool RSTD_ = Epi::RSTD; const unsigned long long* SSQ_ = nullptr; if constexpr (RSTD_) SSQ_ = E.ssq;
    const int K = g.K, nt = K / BK;
    unsigned voffA[2], voffB[2];
#pragma unroll
    for (int i = 0; i < 2; ++i) { int R, C; stage_rc(tid * 16 + i * 8192, R, C); const int Rb = Epi::PERM ? ((R & ~31) + perm32(R & 31)) : R;
        voffA[i] = (unsigned)(R * K + C) * 2u; voffB[i] = (unsigned)(Rb * K + C) * 2u; }
    const size_t kstep = (size_t)(BK * 2);
    const size_t hstep = (size_t)HALF * K * 2;
    const size_t tstep = 2 * hstep;
    const unsigned ldsw = (unsigned)wid * 1024u;
    const unsigned ldsb = (unsigned)__builtin_amdgcn_readfirstlane((int)((unsigned)(size_t)lds + ldsw));
    const int aoff = lds_byte(wr * 64 + fr, fq * 8); int boff = lds_byte(wc * 32 + fr, fq * 8) + 4 * HTB;
    asm volatile("" : "+v"(boff));
#define PG8_SA(b, h) (((b) * 2 + (h)) * HTB)
#define PG8_SB(b, h) ((4 + (b) * 2 + (h)) * HTB)
#define PG8_SBR(b, h) (((b) * 2 + (h)) * HTB)
#define PG8_STAGE(bufoff, gbase, voff) do { _Pragma("unroll") for (int _i = 0; _i < 2; ++_i) \
        glds16_s((gbase), (voff)[_i], ldsb + (unsigned)((bufoff) + _i * 8192)); } while (0)
#define PG8_STAGE1(bufoff, gbase, voff, i) glds16_s((gbase), (voff)[i], ldsb + (unsigned)((bufoff) + (i) * 8192))
#define PG8_LDA(dst, b, h) do { _Pragma("unroll") for (int m = 0; m < 4; ++m) _Pragma("unroll") for (int k = 0; k < 2; ++k) dst[m][k] = *(const PG8_LAS bf16x8*)(lds + PG8_SA(b, h) + aoff + m * 2048 + k * 1024); } while (0)
#define PG8_LDB(dst, b, h) do { _Pragma("unroll") for (int n = 0; n < 2; ++n) _Pragma("unroll") for (int k = 0; k < 2; ++k) dst[n][k] = *(const PG8_LAS bf16x8*)(lds + PG8_SBR(b, h) + boff + n * 2048 + k * 1024); } while (0)
#define PG8_MMA(ai, bj, At, Bt) do { __builtin_amdgcn_s_setprio(PG8_PRIO_M); _Pragma("unroll") for (int m = 0; m < 4; ++m) _Pragma("unroll") for (int n = 0; n < 2; ++n) _Pragma("unroll") for (int k = 0; k < 2; ++k) \
        acc[ai][bj][m][n] = __builtin_amdgcn_mfma_f32_16x16x32_bf16(Bt[n][k], At[m][k], acc[ai][bj][m][n], 0, 0, 0); __builtin_amdgcn_s_setprio(PG8_PRIO_L); } while (0)
#define PG8_MMAZ(Z, ai, bj, At, Bt) do { if constexpr (Z) { __builtin_amdgcn_s_setprio(PG8_PRIO_M); _Pragma("unroll") for (int m = 0; m < 4; ++m) _Pragma("unroll") for (int n = 0; n < 2; ++n) { \
        acc[ai][bj][m][n] = __builtin_amdgcn_mfma_f32_16x16x32_bf16(Bt[n][0], At[m][0], (f32x4){0.f, 0.f, 0.f, 0.f}, 0, 0, 0); acc[ai][bj][m][n] = __builtin_amdgcn_mfma_f32_16x16x32_bf16(Bt[n][1], At[m][1], acc[ai][bj][m][n], 0, 0, 0); } \
        __builtin_amdgcn_s_setprio(PG8_PRIO_L); } else PG8_MMA(ai, bj, At, Bt); } while (0)
#define PG8_WAIT_V(n) asm volatile("s_waitcnt vmcnt(" #n ")" ::: "memory")
#define PG8_WAIT_L(n) asm volatile("s_waitcnt lgkmcnt(" #n ")" ::: "memory")
#define PG8_BAR __builtin_amdgcn_s_barrier()
#define PG8_SCHED __builtin_amdgcn_sched_barrier(0)
    Unit cur, nxt; int ui = 0;
    if (!S.next(0, cur)) return;
    f32x4 acc[2][2][4][2];
    bf16x8 At[4][2], B0[2][2], B1[2][2];
    const char* cA = (const char*)g.A + (size_t)cur.pm * tstep; const char* cB = (const char*)g.Bt + (size_t)cur.pn * tstep;
    S.a_ready(cur);
    const int pm0 = cur.pm;
    unsigned long long sv_ = 0ull; if constexpr (RSTD_) sv_ = rstd_fetch(SSQ_, pm0 * BM + (tid & 255));
    if constexpr (SP2) {
        PG8_STAGE(PG8_SB(0, 0), cB, voffB); PG8_STAGE(PG8_SB(0, 1), cB + hstep, voffB); PG8_STAGE(PG8_SA(0, 0), cA, voffA); PG8_STAGE(PG8_SA(0, 1), cA + hstep, voffA);
        if (wr == 1) PG8_BAR;
        PG8_WAIT_V(2); PG8_BAR;
        if constexpr (RSTD_) { if (tid < 256) rstd_put(sv_, tid); }
        if (PG8_MV == 2) { PG8_STAGE(PG8_SB(1, 0), cB + kstep, voffB); PG8_STAGE(PG8_SB(1, 1), cB + hstep + kstep, voffB); PG8_WAIT_V(4); }
        else if (PG8_MV) { PG8_STAGE(PG8_SB(1, 0), cB + kstep, voffB); PG8_STAGE(PG8_SB(1, 1), cB + hstep + kstep, voffB); PG8_STAGE1(PG8_SA(1, 0), cA + kstep, voffA, 0); PG8_WAIT_V(5); }
        else { PG8_STAGE(PG8_SB(1, 0), cB + kstep, voffB); PG8_STAGE(PG8_SA(1, 0), cA + kstep, voffA); PG8_STAGE(PG8_SB(1, 1), cB + hstep + kstep, voffB); PG8_WAIT_V(6); }
        PG8_BAR;
    } else {
        PG8_STAGE(PG8_SB(0, 0), cB, voffB); PG8_STAGE(PG8_SA(0, 0), cA, voffA); PG8_STAGE(PG8_SB(0, 1), cB + hstep, voffB); PG8_STAGE(PG8_SA(0, 1), cA + hstep, voffA);
        if (wr == 1) PG8_BAR;
        PG8_WAIT_V(4); PG8_BAR;
        if constexpr (RSTD_) { if (tid < 256) rstd_put(sv_, tid); }
        PG8_STAGE(PG8_SB(1, 0), cB + kstep, voffB); PG8_STAGE(PG8_SA(1, 0), cA + kstep, voffA); PG8_STAGE(PG8_SB(1, 1), cB + hstep + kstep, voffB);
        PG8_WAIT_V(6); PG8_BAR;
    }
    for (;;) {
        const bool has_next = S.next(ui + 1, nxt);
        const char* nA = has_next ? (const char*)g.A + (size_t)nxt.pm * tstep : cA; const char* nB = has_next ? (const char*)g.Bt + (size_t)nxt.pn * tstep : cB;
        auto kpair = [&](auto ztag, const int t) __attribute__((always_inline)) {
            constexpr bool Z = decltype(ztag)::value;
            const bool last = (t == nt - 2);
            const char* a1 = cA + (size_t)(t + 1) * kstep;
            const char* a2 = last ? nA : cA + (size_t)(t + 2) * kstep; const char* b2 = last ? nB : cB + (size_t)(t + 2) * kstep;
            const char* a3 = a2 + kstep; const char* b3 = b2 + kstep;
            if (last && has_next) S.a_ready(nxt);
            if constexpr (SP2) {
            PG8_LDB(B0, 0, 0); PG8_LDB(B1, 0, 1); PG8_SCHED; PG8_LDA(At, 0, 0); if (PG8_MV == 2) PG8_STAGE(PG8_SA(1, 0), a1, voffA); else if (PG8_MV) PG8_STAGE1(PG8_SA(1, 0), a1, voffA, 1); PG8_STAGE(PG8_SA(1, 1), a1 + hstep, voffA);
            PG8_WAIT_V(8); PG8_WAIT_L(0); PG8_BAR; PG8_MMAZ(Z, 0, 0, At, B0); PG8_MMAZ(Z, 0, 1, At, B1); PG8_BAR; PG8_SCHED;
            PG8_LDA(At, 0, 1); PG8_STAGE(PG8_SB(0, 0), b2, voffB); PG8_STAGE(PG8_SB(0, 1), b2 + hstep, voffB); if (PG8_MV == 2) {} else if (PG8_MV) PG8_STAGE1(PG8_SA(0, 0), a2, voffA, 0); else PG8_STAGE(PG8_SA(0, 0), a2, voffA);
            if (PG8_MV == 2) PG8_WAIT_V(6); else if (PG8_MV) PG8_WAIT_V(7); else PG8_WAIT_V(8); PG8_WAIT_L(0); PG8_BAR; PG8_MMAZ(Z, 1, 0, At, B0); PG8_MMAZ(Z, 1, 1, At, B1); PG8_BAR; PG8_SCHED;
            PG8_LDB(B0, 1, 0); PG8_LDB(B1, 1, 1); PG8_SCHED; PG8_LDA(At, 1, 0); if (PG8_MV == 2) PG8_STAGE(PG8_SA(0, 0), a2, voffA); else if (PG8_MV) PG8_STAGE1(PG8_SA(0, 0), a2, voffA, 1); PG8_STAGE(PG8_SA(0, 1), a2 + hstep, voffA);
            PG8_WAIT_V(8); PG8_WAIT_L(0); PG8_BAR; PG8_MMA(0, 0, At, B0); PG8_MMA(0, 1, At, B1); PG8_BAR; PG8_SCHED;
            PG8_LDA(At, 1, 1); PG8_STAGE(PG8_SB(1, 0), b3, voffB); PG8_STAGE(PG8_SB(1, 1), b3 + hstep, voffB); if (PG8_MV == 2) {} else if (PG8_MV) PG8_STAGE1(PG8_SA(1, 0), a3, voffA, 0); else PG8_STAGE(PG8_SA(1, 0), a3, voffA);
            if (PG8_MV == 2) PG8_WAIT_V(6); else if (PG8_MV) PG8_WAIT_V(7); else PG8_WAIT_V(8); PG8_WAIT_L(0); PG8_BAR; PG8_MMA(1, 0, At, B0); PG8_MMA(1, 1, At, B1); PG8_BAR; PG8_SCHED;
            } else {
            PG8_LDB(B0, 0, 0); PG8_SCHED; PG8_LDA(At, 0, 0); PG8_STAGE(PG8_SA(1, 1), a1 + hstep, voffA);
            PG8_WAIT_L(8); PG8_BAR; PG8_WAIT_L(0); PG8_MMAZ(Z, 0, 0, At, B0); PG8_BAR; PG8_SCHED;
            PG8_LDB(B1, 0, 1); PG8_STAGE(PG8_SB(0, 0), b2, voffB);
            PG8_BAR; PG8_WAIT_L(0); PG8_MMAZ(Z, 0, 1, At, B1); PG8_BAR;
            PG8_LDA(At, 0, 1); PG8_STAGE(PG8_SA(0, 0), a2, voffA);
            PG8_BAR; PG8_WAIT_L(0); PG8_MMAZ(Z, 1, 0, At, B0); PG8_BAR; PG8_SCHED;
            PG8_STAGE(PG8_SB(0, 1), b2 + hstep, voffB);
            PG8_WAIT_V(6); PG8_BAR; PG8_MMAZ(Z, 1, 1, At, B1); PG8_BAR;
            PG8_LDB(B0, 1, 0); PG8_SCHED; PG8_LDA(At, 1, 0); PG8_STAGE(PG8_SA(0, 1), a2 + hstep, voffA);
            PG8_WAIT_L(8); PG8_BAR; PG8_WAIT_L(0); PG8_MMA(0, 0, At, B0); PG8_BAR; PG8_SCHED;
            PG8_LDB(B1, 1, 1); PG8_STAGE(PG8_SB(1, 0), b3, voffB);
            PG8_BAR; PG8_WAIT_L(0); PG8_MMA(0, 1, At, B1); PG8_BAR;
            PG8_LDA(At, 1, 1); PG8_STAGE(PG8_SA(1, 0), a3, voffA);
            PG8_BAR; PG8_WAIT_L(0); PG8_MMA(1, 0, At, B0); PG8_BAR; PG8_SCHED;
            PG8_STAGE(PG8_SB(1, 1), b3 + hstep, voffB);
            PG8_WAIT_V(6); PG8_BAR; PG8_MMA(1, 1, At, B1); PG8_BAR;
            }
        };
        kpair(ZTag<true>{}, 0);
        for (int t = 2; t < nt; t += 2) kpair(ZTag<false>{}, t);
        if constexpr (ALIGN_EPI) { if (wr == 0) PG8_BAR; }
        if constexpr (!Epi::AFTER_DRAIN) { E(acc, cur, wr, wc, fr, fq, pm0); S.done(cur); }
        if (!has_next) break;
        cur = nxt; cA = nA; cB = nB; ++ui;
        if constexpr (ALIGN_EPI) { if (wr == 1) PG8_BAR; }
    }
    PG8_WAIT_V(0);
    if constexpr (!ALIGN_EPI) { if (wr == 0) PG8_BAR; }
    PG8_BAR;
    if constexpr (Epi::AFTER_DRAIN) { E.fused(acc, cur, wr, wc, fr, fq, lds, wid, lane); S.done(cur); }
#undef PG8_SA
#undef PG8_SB
#undef PG8_SBR
#undef PG8_STAGE
#undef PG8_STAGE1
#undef PG8_LDA
#undef PG8_LDB
#undef PG8_MMA
#undef PG8_MMAZ
#undef PG8_WAIT_V
#undef PG8_WAIT_L
#undef PG8_BAR
#undef PG8_SCHED
}
template <class E0, class E1, class E2, class Sched, bool ALIGN_EPI = false, bool SP2 = false>
__device__ __forceinline__ void gemm_phase3(PG8_LAS unsigned char* lds, const Gemm g, const bf16_t* Bt1, const bf16_t* Bt2, const Sched& S, const E0& e0, const E1& e1, const E2& e2) {
    int tid_ = threadIdx.x; asm volatile("" : "+v"(tid_));
    const int tid = tid_, wid = __builtin_amdgcn_readfirstlane(tid >> 6), lane = tid & 63, wr = wid >> 2, wc = wid & 3, fr = lane & 15, fq = lane >> 4;
    constexpr bool RSTD_ = E0::RSTD; static_assert(E0::RSTD == E1::RSTD && E1::RSTD == E2::RSTD, "one rstd table"); const unsigned long long* SSQ_ = nullptr; if constexpr (RSTD_) SSQ_ = e0.ssq;
    const int K = g.K, nt = K / BK;
    unsigned voffA[2], voffB[2];
#pragma unroll
    for (int i = 0; i < 2; ++i) { int R, C; stage_rc(tid * 16 + i * 8192, R, C); const int Rb = E0::PERM ? ((R & ~31) + perm32(R & 31)) : R;
        voffA[i] = (unsigned)(R * K + C) * 2u; voffB[i] = (unsigned)(Rb * K + C) * 2u; }
    const size_t kstep = (size_t)(BK * 2);
    const size_t hstep = (size_t)HALF * K * 2;
    const size_t tstep = 2 * hstep;
    const unsigned ldsw = (unsigned)wid * 1024u;
    const unsigned ldsb = (unsigned)__builtin_amdgcn_readfirstlane((int)((unsigned)(size_t)lds + ldsw));
    const int aoff = lds_byte(wr * 64 + fr, fq * 8); int boff = lds_byte(wc * 32 + fr, fq * 8) + 4 * HTB;
    asm volatile("" : "+v"(boff));
#define PG8_SA(b, h) (((b) * 2 + (h)) * HTB)
#define PG8_SB(b, h) ((4 + (b) * 2 + (h)) * HTB)
#define PG8_SBR(b, h) (((b) * 2 + (h)) * HTB)
#define PG8_STAGE(bufoff, gbase, voff) do { _Pragma("unroll") for (int _i = 0; _i < 2; ++_i) \
        glds16_s((gbase), (voff)[_i], ldsb + (unsigned)((bufoff) + _i * 8192)); } while (0)
#define PG8_STAGE1(bufoff, gbase, voff, i) glds16_s((gbase), (voff)[i], ldsb + (unsigned)((bufoff) + (i) * 8192))
#define PG8_LDA(dst, b, h) do { _Pragma("unroll") for (int m = 0; m < 4; ++m) _Pragma("unroll") for (int k = 0; k < 2; ++k) dst[m][k] = *(const PG8_LAS bf16x8*)(lds + PG8_SA(b, h) + aoff + m * 2048 + k * 1024); } while (0)
#define PG8_LDB(dst, b, h) do { _Pragma("unroll") for (int n = 0; n < 2; ++n) _Pragma("unroll") for (int k = 0; k < 2; ++k) dst[n][k] = *(const PG8_LAS bf16x8*)(lds + PG8_SBR(b, h) + boff + n * 2048 + k * 1024); } while (0)
#define PG8_MMA(ai, bj, At, Bt) do { __builtin_amdgcn_s_setprio(PG8_PRIO_M); _Pragma("unroll") for (int m = 0; m < 4; ++m) _Pragma("unroll") for (int n = 0; n < 2; ++n) _Pragma("unroll") for (int k = 0; k < 2; ++k) \
        acc[ai][bj][m][n] = __builtin_amdgcn_mfma_f32_16x16x32_bf16(Bt[n][k], At[m][k], acc[ai][bj][m][n], 0, 0, 0); __builtin_amdgcn_s_setprio(PG8_PRIO_L); } while (0)
#define PG8_MMAZ(Z, ai, bj, At, Bt) do { if constexpr (Z) { __builtin_amdgcn_s_setprio(PG8_PRIO_M); _Pragma("unroll") for (int m = 0; m < 4; ++m) _Pragma("unroll") for (int n = 0; n < 2; ++n) { \
        acc[ai][bj][m][n] = __builtin_amdgcn_mfma_f32_16x16x32_bf16(Bt[n][0], At[m][0], (f32x4){0.f, 0.f, 0.f, 0.f}, 0, 0, 0); acc[ai][bj][m][n] = __builtin_amdgcn_mfma_f32_16x16x32_bf16(Bt[n][1], At[m][1], acc[ai][bj][m][n], 0, 0, 0); } \
        __builtin_amdgcn_s_setprio(PG8_PRIO_L); } else PG8_MMA(ai, bj, At, Bt); } while (0)
#define PG8_WAIT_V(n) asm volatile("s_waitcnt vmcnt(" #n ")" ::: "memory")
#define PG8_WAIT_L(n) asm volatile("s_waitcnt lgkmcnt(" #n ")" ::: "memory")
#define PG8_BAR __builtin_amdgcn_s_barrier()
#define PG8_SCHED __builtin_amdgcn_sched_barrier(0)
    Unit cur, nxt; int ui = 0;
    if (!S.next(0, cur)) return;
    f32x4 acc[2][2][4][2];
#pragma unroll
    for (int a = 0; a < 2; ++a)
#pragma unroll
        for (int b = 0; b < 2; ++b)
#pragma unroll
            for (int m = 0; m < 4; ++m)
#pragma unroll
                for (int n = 0; n < 2; ++n) acc[a][b][m][n] = (f32x4){0.f, 0.f, 0.f, 0.f};
    bf16x8 At[4][2], B0[2][2], B1[2][2];
    const char* cA = (const char*)g.A + (size_t)cur.pm * tstep; const char* cB = (const char*)g.Bt + (size_t)cur.pn * tstep;
    S.a_ready(cur);
    const int pm0 = cur.pm;
    unsigned long long sv_ = 0ull; if constexpr (RSTD_) sv_ = rstd_fetch(SSQ_, pm0 * BM + (tid & 255));
    if constexpr (SP2) {
        PG8_STAGE(PG8_SB(0, 0), cB, voffB); PG8_STAGE(PG8_SB(0, 1), cB + hstep, voffB); PG8_STAGE(PG8_SA(0, 0), cA, voffA); PG8_STAGE(PG8_SA(0, 1), cA + hstep, voffA);
        if (wr == 1) PG8_BAR;
        PG8_WAIT_V(2); PG8_BAR;
        if constexpr (RSTD_) { if (tid < 256) rstd_put(sv_, tid); }
        if (PG8_MV == 2) { PG8_STAGE(PG8_SB(1, 0), cB + kstep, voffB); PG8_STAGE(PG8_SB(1, 1), cB + hstep + kstep, voffB); PG8_WAIT_V(4); }
        else if (PG8_MV) { PG8_STAGE(PG8_SB(1, 0), cB + kstep, voffB); PG8_STAGE(PG8_SB(1, 1), cB + hstep + kstep, voffB); PG8_STAGE1(PG8_SA(1, 0), cA + kstep, voffA, 0); PG8_WAIT_V(5); }
        else { PG8_STAGE(PG8_SB(1, 0), cB + kstep, voffB); PG8_STAGE(PG8_SA(1, 0), cA + kstep, voffA); PG8_STAGE(PG8_SB(1, 1), cB + hstep + kstep, voffB); PG8_WAIT_V(6); }
        PG8_BAR;
    } else {
        PG8_STAGE(PG8_SB(0, 0), cB, voffB); PG8_STAGE(PG8_SA(0, 0), cA, voffA); PG8_STAGE(PG8_SB(0, 1), cB + hstep, voffB); PG8_STAGE(PG8_SA(0, 1), cA + hstep, voffA);
        if (wr == 1) PG8_BAR;
        PG8_WAIT_V(4); PG8_BAR;
        if constexpr (RSTD_) { if (tid < 256) rstd_put(sv_, tid); }
        PG8_STAGE(PG8_SB(1, 0), cB + kstep, voffB); PG8_STAGE(PG8_SA(1, 0), cA + kstep, voffA); PG8_STAGE(PG8_SB(1, 1), cB + hstep + kstep, voffB);
        PG8_WAIT_V(6); PG8_BAR;
    }
    static_assert(E0::PERM == E1::PERM && E1::PERM == E2::PERM && !E0::AFTER_DRAIN && !E1::AFTER_DRAIN && !E2::AFTER_DRAIN, "gemm_phase3: one staging order, in-loop epilogues");
    const char* cB1 = (const char*)Bt1 + (size_t)cur.pn * tstep; const char* cB2 = (const char*)Bt2 + (size_t)cur.pn * tstep;
    auto unit = [&](const auto& E, const char* nA, const char* nB, const bool has_next) __attribute__((always_inline)) {
            auto kpair = [&](auto ztag, const int t) __attribute__((always_inline)) {
                constexpr bool Z = decltype(ztag)::value;
                const bool last = (t == nt - 2);
                const char* a1 = cA + (size_t)(t + 1) * kstep;
                const char* a2 = last ? nA : cA + (size_t)(t + 2) * kstep; const char* b2 = last ? nB : cB + (size_t)(t + 2) * kstep;
                const char* a3 = a2 + kstep; const char* b3 = b2 + kstep;

                if constexpr (SP2) {
                PG8_LDB(B0, 0, 0); PG8_LDB(B1, 0, 1); PG8_SCHED; PG8_LDA(At, 0, 0); if (PG8_MV == 2) PG8_STAGE(PG8_SA(1, 0), a1, voffA); else if (PG8_MV) PG8_STAGE1(PG8_SA(1, 0), a1, voffA, 1); PG8_STAGE(PG8_SA(1, 1), a1 + hstep, voffA);
                PG8_WAIT_V(8); PG8_WAIT_L(0); PG8_BAR; PG8_MMAZ(Z, 0, 0, At, B0); PG8_MMAZ(Z, 0, 1, At, B1); PG8_BAR; PG8_SCHED;
                PG8_LDA(At, 0, 1); PG8_STAGE(PG8_SB(0, 0), b2, voffB); PG8_STAGE(PG8_SB(0, 1), b2 + hstep, voffB); if (PG8_MV == 2) {} else if (PG8_MV) PG8_STAGE1(PG8_SA(0, 0), a2, voffA, 0); else PG8_STAGE(PG8_SA(0, 0), a2, voffA);
                if (PG8_MV == 2) PG8_WAIT_V(6); else if (PG8_MV) PG8_WAIT_V(7); else PG8_WAIT_V(8); PG8_WAIT_L(0); PG8_BAR; PG8_MMAZ(Z, 1, 0, At, B0); PG8_MMAZ(Z, 1, 1, At, B1); PG8_BAR; PG8_SCHED;
                PG8_LDB(B0, 1, 0); PG8_LDB(B1, 1, 1); PG8_SCHED; PG8_LDA(At, 1, 0); if (PG8_MV == 2) PG8_STAGE(PG8_SA(0, 0), a2, voffA); else if (PG8_MV) PG8_STAGE1(PG8_SA(0, 0), a2, voffA, 1); PG8_STAGE(PG8_SA(0, 1), a2 + hstep, voffA);
                PG8_WAIT_V(8); PG8_WAIT_L(0); PG8_BAR; PG8_MMA(0, 0, At, B0); PG8_MMA(0, 1, At, B1); PG8_BAR; PG8_SCHED;
                PG8_LDA(At, 1, 1); PG8_STAGE(PG8_SB(1, 0), b3, voffB); PG8_STAGE(PG8_SB(1, 1), b3 + hstep, voffB); if (PG8_MV == 2) {} else if (PG8_MV) PG8_STAGE1(PG8_SA(1, 0), a3, voffA, 0); else PG8_STAGE(PG8_SA(1, 0), a3, voffA);
                if (PG8_MV == 2) PG8_WAIT_V(6); else if (PG8_MV) PG8_WAIT_V(7); else PG8_WAIT_V(8); PG8_WAIT_L(0); PG8_BAR; PG8_MMA(1, 0, At, B0); PG8_MMA(1, 1, At, B1); PG8_BAR; PG8_SCHED;
                } else {
                PG8_LDB(B0, 0, 0); PG8_SCHED; PG8_LDA(At, 0, 0); PG8_STAGE(PG8_SA(1, 1), a1 + hstep, voffA);
                PG8_WAIT_L(8); PG8_BAR; PG8_WAIT_L(0); PG8_MMAZ(Z, 0, 0, At, B0); PG8_BAR; PG8_SCHED;
                PG8_LDB(B1, 0, 1); PG8_STAGE(PG8_SB(0, 0), b2, voffB);
                PG8_BAR; PG8_WAIT_L(0); PG8_MMAZ(Z, 0, 1, At, B1); PG8_BAR;
                PG8_LDA(At, 0, 1); PG8_STAGE(PG8_SA(0, 0), a2, voffA);
                PG8_BAR; PG8_WAIT_L(0); PG8_MMAZ(Z, 1, 0, At, B0); PG8_BAR; PG8_SCHED;
                PG8_STAGE(PG8_SB(0, 1), b2 + hstep, voffB);
                PG8_WAIT_V(6); PG8_BAR; PG8_MMAZ(Z, 1, 1, At, B1); PG8_BAR;
                PG8_LDB(B0, 1, 0); PG8_SCHED; PG8_LDA(At, 1, 0); PG8_STAGE(PG8_SA(0, 1), a2 + hstep, voffA);
                PG8_WAIT_L(8); PG8_BAR; PG8_WAIT_L(0); PG8_MMA(0, 0, At, B0); PG8_BAR; PG8_SCHED;
                PG8_LDB(B1, 1, 1); PG8_STAGE(PG8_SB(1, 0), b3, voffB);
                PG8_BAR; PG8_WAIT_L(0); PG8_MMA(0, 1, At, B1); PG8_BAR;
                PG8_LDA(At, 1, 1); PG8_STAGE(PG8_SA(1, 0), a3, voffA);
                PG8_BAR; PG8_WAIT_L(0); PG8_MMA(1, 0, At, B0); PG8_BAR; PG8_SCHED;
                PG8_STAGE(PG8_SB(1, 1), b3 + hstep, voffB);
                PG8_WAIT_V(6); PG8_BAR; PG8_MMA(1, 1, At, B1); PG8_BAR;
                }
            };
            for (int t = 0; t < nt; t += 2) kpair(ZTag<false>{}, t);
            if constexpr (ALIGN_EPI) { if (wr == 0) PG8_BAR; }
            { const int ln_ = lane_now();
              E(acc, cur, wr, wc, ln_ & 15, ln_ >> 4, pm0); }
            if (!has_next) return;
    #pragma unroll
            for (int a = 0; a < 2; ++a)
    #pragma unroll
                for (int b = 0; b < 2; ++b)
    #pragma unroll
                    for (int m = 0; m < 4; ++m)
    #pragma unroll
                        for (int n = 0; n < 2; ++n) acc[a][b][m][n] = (f32x4){0.f, 0.f, 0.f, 0.f};
            cA = nA; cB = nB;
            if constexpr (ALIGN_EPI) { if (wr == 1) PG8_BAR; }
    };
    const char* cA1 = cA; const char* cA2 = cA; asm volatile("" : "+s"(cA1), "+s"(cA2));
    unit(e0, cA1, cB1, true); unit(e1, cA2, cB2, true); unit(e2, cA, cB, false);
    PG8_WAIT_V(0);
    if constexpr (!ALIGN_EPI) { if (wr == 0) PG8_BAR; }
    PG8_BAR;
#undef PG8_SA
#undef PG8_SB
#undef PG8_SBR
#undef PG8_STAGE
#undef PG8_STAGE1
#undef PG8_LDA
#undef PG8_LDB
#undef PG8_MMA
#undef PG8_MMAZ
#undef PG8_WAIT_V
#undef PG8_WAIT_L
#undef PG8_BAR
#undef PG8_SCHED
}
}

#ifndef PG8_SP2
#define PG8_SP2 true
#endif
#ifndef PG8_ALIGN1
#define PG8_ALIGN1 false
#endif
#ifndef PG8_ALIGN
#define PG8_ALIGN true
#endif
#include <hip/hip_bf16.h>
#include <cmath>
namespace attn_body {
using bf16=__hip_bfloat16;
using bf16x8=__attribute__((ext_vector_type(8)))short;
using s16x4=__attribute__((ext_vector_type(4)))short;
using f32x16=__attribute__((ext_vector_type(16)))float;
using u32x4=__attribute__((ext_vector_type(4)))unsigned;
constexpr int BATCH=1,NHEAD=32,SEQ=8192,D=64,DM=1024,OP=2048;
constexpr int NW=8,QBLK=32,QB=QBLK*NW,KVBLK=64,NQB=SEQ/QB;
constexpr int ATTN_PITCH=DM, ATTN_UNIT_ROWS=QB;
__device__ __forceinline__ int crow(int r,int hi){return (r&3)+8*(r>>2)+4*hi;}
#define SBAR() __builtin_amdgcn_sched_barrier(0)
__device__ __forceinline__ void cmask(f32x16&p0,f32x16&p1,int jb,int qrel,int hi){
  const float NEG=-INFINITY; int kb=64*jb+4*hi;
  #pragma unroll
  for(int r=0;r<16;++r){int kv=kb+(r&3)+8*(r>>2); if(kv>qrel)p0[r]=NEG; if(kv+32>qrel)p1[r]=NEG;}
}

constexpr int NSLOT=3, SLOTB=8192;
constexpr int LDS_K=0, LDS_V=NSLOT*SLOTB, LDS_WS=3*NSLOT*SLOTB, LDS_OST=LDS_WS+NW*64*4, LDS_BYTES=LDS_OST+NW*4096;
constexpr float C2=0.125f*1.4426950408889634f;
__device__ __forceinline__ void glds16(const void*gsrc,unsigned lds_dst){
  asm volatile("s_mov_b32 m0, %1\n\ts_nop 0\n\tglobal_load_lds_dwordx4 %0, off"::"v"(gsrc),"s"(lds_dst):"memory","m0");}
__device__ __forceinline__ float max3f(float a,float b,float c){float r;asm("v_max3_f32 %0, %1, %2, %3":"=v"(r):"v"(a),"v"(b),"v"(c));return r;}
__device__ __forceinline__ float max2f(float a,float b){float r;asm("v_max_f32_e32 %0, %1, %2":"=v"(r):"v"(a),"v"(b));return r;}
__device__ __forceinline__ float fadd_s(float a,float b){float r;asm("v_add_f32_e32 %0, %1, %2":"=v"(r):"v"(a),"v"(b));return r;}
__device__ __forceinline__ float fsub_s(float a,float b){float r;asm("v_sub_f32_e32 %0, %1, %2":"=v"(r):"v"(a),"v"(b));return r;}
typedef float f32x2_t __attribute__((ext_vector_type(2))); typedef __bf16 bf16x2_t __attribute__((ext_vector_type(2)));
__device__ __forceinline__ unsigned cvtpk_s(float lo,float hi){f32x2_t v={lo,hi};bf16x2_t b=__builtin_convertvector(v,bf16x2_t);return __builtin_bit_cast(unsigned,b);}
#define WAIT_BAR(N) asm volatile("s_waitcnt vmcnt(" #N ") lgkmcnt(0)\n\ts_barrier":::"memory")

__device__ __forceinline__ void qkt(f32x16&p0,f32x16&p1,const char*Kslot,const bf16x8*qr,const f32x16&negm,int r32,int hi){
  const char*kb=Kslot+hi*1024+r32*16;
  #pragma unroll
  for(int d0=0;d0<4;++d0){
    const bf16x8 b0=*reinterpret_cast<const bf16x8*>(kb+d0*2048);
    const bf16x8 b1=*reinterpret_cast<const bf16x8*>(kb+d0*2048+512);
    if(d0==0){p0=__builtin_amdgcn_mfma_f32_32x32x16_bf16(b0,qr[0],negm,0,0,0);p1=__builtin_amdgcn_mfma_f32_32x32x16_bf16(b1,qr[0],negm,0,0,0);}
    else{p0=__builtin_amdgcn_mfma_f32_32x32x16_bf16(b0,qr[d0],p0,0,0,0);p1=__builtin_amdgcn_mfma_f32_32x32x16_bf16(b1,qr[d0],p1,0,0,0);}}
}
typedef __attribute__((address_space(3))) const char* lds_cptr;
typedef short v4i16_t __attribute__((ext_vector_type(4)));
__device__ __forceinline__ void kload8(bf16x8*kf,lds_cptr kp){
  kf[0]=*(const __attribute__((address_space(3))) bf16x8*)(kp);      kf[1]=*(const __attribute__((address_space(3))) bf16x8*)(kp+512);
  kf[2]=*(const __attribute__((address_space(3))) bf16x8*)(kp+2048); kf[3]=*(const __attribute__((address_space(3))) bf16x8*)(kp+2560);
  kf[4]=*(const __attribute__((address_space(3))) bf16x8*)(kp+4096); kf[5]=*(const __attribute__((address_space(3))) bf16x8*)(kp+4608);
  kf[6]=*(const __attribute__((address_space(3))) bf16x8*)(kp+6144); kf[7]=*(const __attribute__((address_space(3))) bf16x8*)(kp+6656);
}
__device__ __forceinline__ void kload2(bf16x8*kf,lds_cptr kp,int j){ kf[2*j]=*(const __attribute__((address_space(3))) bf16x8*)(kp+j*2048); kf[2*j+1]=*(const __attribute__((address_space(3))) bf16x8*)(kp+j*2048+512); }
__device__ __forceinline__ s16x4 vtr(lds_cptr p){ return __builtin_bit_cast(s16x4,__builtin_amdgcn_ds_read_tr16_b64_v4i16((__attribute__((address_space(3))) v4i16_t*)p)); }
__device__ __forceinline__ float rowmax(const f32x16&p0,const f32x16&p1){
  float a=max3f(p0[0],p0[1],p1[0]),b=max3f(p0[2],p0[3],p1[1]);a=max3f(a,p1[2],p1[3]);
  #pragma unroll
  for(int r=4;r<16;r+=4){a=max3f(a,p0[r],p0[r+1]);b=max3f(b,p0[r+2],p0[r+3]);a=max3f(a,p1[r],p1[r+1]);b=max3f(b,p1[r+2],p1[r+3]);}
  const float m=max2f(a,b);
  auto rr=__builtin_amdgcn_permlane32_swap(__float_as_uint(m),__float_as_uint(m),false,false);
  return max2f(__uint_as_float(rr[0]),__uint_as_float(rr[1]));
}
__device__ __forceinline__ void pv(f32x16*o,int vb,bf16x8 pa0,bf16x8 pa1,bf16x8 pa2,bf16x8 pa3){
  #pragma unroll
  for(int d0=0;d0<4;++d0){s16x4 lo[4],hi[4];
    #pragma unroll
    for(int ks=0;ks<4;++ks){
      asm volatile("ds_read_b64_tr_b16 %0,%1 offset:%c2":"=&v"(lo[ks]):"v"(vb),"i"(d0*4096+ks*1024):"memory");
      asm volatile("ds_read_b64_tr_b16 %0,%1 offset:%c2":"=&v"(hi[ks]):"v"(vb),"i"(d0*4096+ks*1024+512):"memory");}
    asm volatile("s_waitcnt lgkmcnt(0)":::"memory");SBAR();
    #define PK(k) (bf16x8){lo[k][0],lo[k][1],lo[k][2],lo[k][3],hi[k][0],hi[k][1],hi[k][2],hi[k][3]}
    o[d0]=__builtin_amdgcn_mfma_f32_32x32x16_bf16(pa0,PK(0),o[d0],0,0,0);
    o[d0]=__builtin_amdgcn_mfma_f32_32x32x16_bf16(pa1,PK(1),o[d0],0,0,0);
    o[d0]=__builtin_amdgcn_mfma_f32_32x32x16_bf16(pa2,PK(2),o[d0],0,0,0);
    o[d0]=__builtin_amdgcn_mfma_f32_32x32x16_bf16(pa3,PK(3),o[d0],0,0,0);
    #undef PK
  }
}

#ifndef ATTN_STORE16
#define ATTN_STORE16(p,v) (*(u32x4*)(p)=(v))
#endif
template<int THRL> __device__ __forceinline__ void attn_unit(int qb,const bf16*Q,const bf16*__restrict__ K,const bf16*__restrict__ V,bf16*O,char*shm){
  int tid_=threadIdx.x; asm volatile("":"+v"(tid_)); const int tid=tid_,lane=tid&63,r32=lane&31,hi=lane>>5; const int wid=__builtin_amdgcn_readfirstlane(tid>>6);
  const int q0=qb*QB;
  const bf16*Qw=Q+(long)(q0+wid*QBLK)*DM;
  const bf16*Kh=K,*Vh=V;
  const unsigned lds0=(unsigned)(uintptr_t)shm;
  float*wsf=(float*)(shm+LDS_WS)+wid*64;
  const bf16*ksrc=Kh+(long)lane*DM+wid*8;
  const bf16*vsrc=Vh+(long)(16*(wid&3)+(lane>>2))*DM+(wid>>2)*32+(lane&3)*8;
  const unsigned kdst=lds0+LDS_K+wid*1024, vdst=lds0+LDS_V+wid*1024;
  #define DMA_K(t,slot) glds16(ksrc+(long)(t)*KVBLK*DM,(unsigned)__builtin_amdgcn_readfirstlane(kdst+(slot)))
  #define DMA_V(t,slot) do{ glds16(vsrc+(long)(t)*KVBLK*DM,(unsigned)__builtin_amdgcn_readfirstlane(vdst+2*(slot))); glds16(vsrc+(long)(t)*KVBLK*DM+64,(unsigned)__builtin_amdgcn_readfirstlane(vdst+2*(slot)+8192)); }while(0)
  const int vb0=(int)(lds0+LDS_V)+((lane>>4)&1)*32+(lane&3)*8+(4*hi+((lane&15)>>2))*64;
  const char*Kbase=shm+LDS_K; bf16x8 kf[8];
  const lds_cptr shm3=(lds_cptr)shm; const lds_cptr kp0=shm3+LDS_K+hi*1024+r32*16; const lds_cptr vp0=shm3+LDS_V+((lane>>4)&1)*32+(lane&3)*8+(4*hi+((lane&15)>>2))*64;
  const int NT=(q0+QB)/KVBLK;
  DMA_K(0,0);DMA_V(0,0);DMA_K(1,SLOTB);
  const lds_cptr qp0=shm3+LDS_OST+wid*4096+hi*512+r32*16;
  { bf16x8 qt[4];
  #pragma unroll
  for(int d0=0;d0<4;++d0)qt[d0]=*reinterpret_cast<const bf16x8*>(&Qw[(long)r32*DM+d0*16+hi*8]);
  #pragma unroll
  for(int d0=0;d0<4;++d0)*(__attribute__((address_space(3))) bf16x8*)(qp0+d0*1024)=qt[d0]; }
  #define QF(d0) (*(const __attribute__((address_space(3))) bf16x8*)(qp0+(d0)*1024))
  float mhat=0.f,l_reg=0.f;float zf_=0.f;asm volatile("":"+v"(zf_));
  f32x16 o[4];f32x16 negm;
  #pragma unroll
  for(int r=0;r<16;++r){o[0][r]=zf_;o[1][r]=zf_;o[2][r]=zf_;o[3][r]=zf_;negm[r]=zf_;}asm volatile("":"+v"(negm));
  const int qrel=wid*QBLK+r32;
  #define CMASK(P0,P1,t) do{int jb_=(t)-(NT-4); if(jb_>=0)cmask(P0,P1,jb_,qrel,hi);}while(0)
  bool resc=false;
  #define START(P0,P1) do{ const float rm=rowmax(P0,P1); resc=false; \
    { const float dl=rm; mhat=fadd_s(mhat,dl); \
      _Pragma("unroll") for(int r=0;r<16;++r){P0[r]=fsub_s(P0[r],dl);P1[r]=fsub_s(P1[r],dl);} \
      _Pragma("unroll") for(int r=0;r<16;++r)negm[r]=-mhat; asm volatile("":"+v"(negm)); } \
    _Pragma("unroll") for(int r=0;r<16;++r)P0[r]=__builtin_amdgcn_exp2f(P0[r]); }while(0)
  #define RESC() do{ if(resc){ asm volatile("s_waitcnt lgkmcnt(0)":::"memory"); \
      _Pragma("unroll") for(int d_=0;d_<4;++d_) _Pragma("unroll") for(int r=0;r<16;++r)o[d_][r]*=wsf[crow(r,hi)]; } }while(0)
  f32x16 pA0,pA1,pB0,pB1;
  int sl_prev=0,sl_cur=0,sl_next=SLOTB;
  #define ROT() do{sl_prev=sl_cur;sl_cur=sl_next;sl_next=(sl_next==(NSLOT-1)*SLOTB)?0:sl_next+SLOTB;}while(0)
  DMA_K(2,2*SLOTB);
  const bf16x8 qf0=QF(0);
  WAIT_BAR(4);
  { const bf16x8 qq[4]={qf0,QF(1),QF(2),QF(3)}; qkt(pA0,pA1,Kbase,qq,negm,r32,hi); }asm volatile("s_nop 15\n\ts_nop 7":"+v"(pA0),"+v"(pA1));CMASK(pA0,pA1,0);
  START(pA0,pA1);
  _Pragma("unroll") for(int r=0;r<16;++r)pA1[r]=__builtin_amdgcn_exp2f(pA1[r]);
  WAIT_BAR(0);
  DMA_K(3,0);DMA_V(1,SLOTB);
  ROT();
  kload8(kf,kp0+sl_cur);
  WAIT_BAR(3);
  s16x4 vlo[8],vhi[8]; u32x4 pw0,pw1,pw2,pw3;
  #define PKW(P,B) cvtpk_s(P[B],P[B+1])
  #define PAF(k) __builtin_bit_cast(bf16x8,pw##k)
  #define VFR(i) (bf16x8){vlo[i][0],vlo[i][1],vlo[i][2],vlo[i][3],vhi[i][0],vhi[i][1],vhi[i][2],vhi[i][3]}
  #define PIN(x) asm volatile("":"+v"(x))
  #define MX3(a,b,c) __builtin_fmaxf(__builtin_fmaxf((a),(b)),(c))
  #define GAPA(MF,A0,A1,A2,A3,W0,W1,PW) do{ MF; sacc+=A0; sacc+=A1; sacc+=A2; sacc+=A3; PIN(sacc); W0; W1; PIN(PW); SBAR(); }while(0)
  #define EX(v) __builtin_amdgcn_exp2f(v)
  #define VRDF(s,f) do{ vlo[s]=vtr(vp_+(((f)>>2)*4096+((f)&3)*1024)); vhi[s]=vtr(vp_+(((f)>>2)*4096+((f)&3)*1024+512)); }while(0)
  #define KRD(G,j) do{ if(G){ kload2(kf,kp0+sl_next,j); SBAR(); } }while(0)
  #define GAPB2(MF,X,B) do{ MF; X[B]=EX(X[B]); X[B+1]=EX(X[B+1]); PIN(X); SBAR(); }while(0)
  #define MF32(a,b,c) __builtin_amdgcn_mfma_f32_32x32x16_bf16(a,b,c,0,0,0)
  #define STEP(C0,C1,P0,P1,t,GK,GV,GL) do{ SBAR(); \
    const lds_cptr vp_=vp0+2*sl_prev; bf16x8 qa,qb; \
    VRDF(0,0); qb=QF(1); SBAR(); float sacc=(P0[0]+P0[1]); \
    GAPA(C0=MF32(kf[0],qf0,negm), P0[2],P0[3],P0[4],P0[5],     pw0[0]=PKW(P0,0), pw0[1]=PKW(P0,2), pw0); \
    VRDF(1,4); SBAR(); GAPA(C1=MF32(kf[1],qf0,negm), P0[6],P0[7],P0[8],P0[9],     pw0[2]=PKW(P0,4), pw0[3]=PKW(P0,6), pw0); \
    VRDF(2,8); qa=QF(2); SBAR(); GAPA(C0=MF32(kf[2],qb,C0),   P0[10],P0[11],P0[12],P0[13], pw1[0]=PKW(P0,8), pw1[1]=PKW(P0,10), pw1); \
    VRDF(3,12); SBAR(); GAPA(C1=MF32(kf[3],qb,C1),   P0[14],P0[15],P1[0],P1[1],   pw1[2]=PKW(P0,12),pw1[3]=PKW(P0,14), pw1); \
    VRDF(4,1); qb=QF(3); SBAR(); GAPA(C0=MF32(kf[4],qa,C0),   P1[2],P1[3],P1[4],P1[5],     pw2[0]=PKW(P1,0), pw2[1]=PKW(P1,2), pw2); \
    VRDF(5,5); SBAR(); GAPA(C1=MF32(kf[5],qa,C1),   P1[6],P1[7],P1[8],P1[9],     pw2[2]=PKW(P1,4), pw2[3]=PKW(P1,6), pw2); \
    VRDF(6,9); SBAR(); GAPA(C0=MF32(kf[6],qb,C0),   P1[10],P1[11],P1[12],P1[13], pw3[0]=PKW(P1,8), pw3[1]=PKW(P1,10), pw3); \
    VRDF(7,13); SBAR(); GAPA(C1=MF32(kf[7],qb,C1),   P1[14],P1[15],0.f,0.f,       pw3[2]=PKW(P1,12),pw3[3]=PKW(P1,14), pw3); \
    l_reg+=sacc; \
    if(GK){DMA_K((t)+3,sl_cur);} if(GV){DMA_V((t)+1,sl_next);} \
    CMASK(C0,C1,t); \
    { float a=MX3(C0[0],C0[1],C1[0]),b=MX3(C0[2],C0[3],C1[1]); a=MX3(a,C1[2],C1[3]); \
      _Pragma("unroll") for(int r=4;r<16;r+=4){a=MX3(a,C0[r],C0[r+1]);b=MX3(b,C0[r+2],C0[r+3]);a=MX3(a,C1[r],C1[r+1]);b=MX3(b,C1[r+2],C1[r+3]);} \
      float rm=__builtin_fmaxf(a,b); { auto rr=__builtin_amdgcn_permlane32_swap(__float_as_uint(rm),__float_as_uint(rm),false,false); rm=__builtin_fmaxf(__uint_as_float(rr[0]),__uint_as_float(rr[1])); } \
      resc=false; \
      if(__builtin_expect(__any(rm>(float)THRL),0)){ const float dl=__builtin_fmaxf(rm,0.f); mhat+=dl; \
        _Pragma("unroll") for(int r=0;r<16;++r){C0[r]-=dl;C1[r]-=dl;} \
        _Pragma("unroll") for(int r=0;r<16;++r)negm[r]=-mhat; asm volatile("":"+v"(negm)); \
        const float f=__builtin_amdgcn_exp2f(-dl); l_reg*=f; if(hi==0)wsf[r32]=f; resc=true; } } \
    SBAR(); \
    GAPB2(o[0]=MF32(PAF(0),VFR(0),o[0]), C0,0);  VRDF(0,2);  SBAR(); \
    GAPB2(o[1]=MF32(PAF(0),VFR(1),o[1]), C0,2);  VRDF(1,6);  SBAR(); \
    KRD(GL,0); GAPB2(o[2]=MF32(PAF(0),VFR(2),o[2]), C0,4);  VRDF(2,10); SBAR(); \
    GAPB2(o[3]=MF32(PAF(0),VFR(3),o[3]), C0,6);  VRDF(3,14); SBAR(); \
    KRD(GL,1); GAPB2(o[0]=MF32(PAF(1),VFR(4),o[0]), C0,8);  VRDF(4,3);  SBAR(); \
    GAPB2(o[1]=MF32(PAF(1),VFR(5),o[1]), C0,10); VRDF(5,7);  SBAR(); \
    KRD(GL,2); GAPB2(o[2]=MF32(PAF(1),VFR(6),o[2]), C0,12); VRDF(6,11); SBAR(); \
    GAPB2(o[3]=MF32(PAF(1),VFR(7),o[3]), C0,14); VRDF(7,15); SBAR(); \
    KRD(GL,3); GAPB2(o[0]=MF32(PAF(2),VFR(0),o[0]), C1,0); \
    GAPB2(o[1]=MF32(PAF(2),VFR(1),o[1]), C1,2); \
    GAPB2(o[2]=MF32(PAF(2),VFR(2),o[2]), C1,4); \
    GAPB2(o[3]=MF32(PAF(2),VFR(3),o[3]), C1,6); \
    GAPB2(o[0]=MF32(PAF(3),VFR(4),o[0]), C1,8); \
    GAPB2(o[1]=MF32(PAF(3),VFR(5),o[1]), C1,10); \
    GAPB2(o[2]=MF32(PAF(3),VFR(6),o[2]), C1,12); \
    GAPB2(o[3]=MF32(PAF(3),VFR(7),o[3]), C1,14); \
    }while(0)
  int t=1;
  #undef CMASK
  #define CMASK(P0,P1,t) do{}while(0)
  for(;t+5<NT;t+=2){
    STEP(pB0,pB1,pA0,pA1,t,true,true,true);     WAIT_BAR(3); RESC(); ROT();
    STEP(pA0,pA1,pB0,pB1,t+1,true,true,true);   WAIT_BAR(3); RESC(); ROT();
  }
  #undef CMASK
  #define CMASK(P0,P1,t) do{int jb_=(t)-(NT-4); if(jb_>=0)cmask(P0,P1,jb_,qrel,hi);}while(0)
  #define ENDW(tt) do{ if((tt)+3<NT){WAIT_BAR(3);} else if((tt)+2<NT){WAIT_BAR(2);} else {WAIT_BAR(0);} }while(0)
  for(;t+1<NT;t+=2){
    STEP(pB0,pB1,pA0,pA1,t,(t+3<NT),(t+1<NT),(t+1<NT));       ENDW(t);   RESC(); ROT();
    STEP(pA0,pA1,pB0,pB1,t+1,(t+4<NT),(t+2<NT),(t+2<NT));     ENDW(t+1); RESC(); ROT();
  }
  STEP(pB0,pB1,pA0,pA1,NT-1,false,false,false); RESC();
  { float sacc=pB0[0]+pB0[1]; _Pragma("unroll") for(int r=2;r<16;++r)sacc+=pB0[r]; _Pragma("unroll") for(int r=0;r<16;++r)sacc+=pB1[r]; l_reg+=sacc;
    pw0=(u32x4){PKW(pB0,0),PKW(pB0,2),PKW(pB0,4),PKW(pB0,6)};pw1=(u32x4){PKW(pB0,8),PKW(pB0,10),PKW(pB0,12),PKW(pB0,14)};pw2=(u32x4){PKW(pB1,0),PKW(pB1,2),PKW(pB1,4),PKW(pB1,6)};pw3=(u32x4){PKW(pB1,8),PKW(pB1,10),PKW(pB1,12),PKW(pB1,14)};
    SBAR(); pv(o,vb0+2*sl_cur,PAF(0),PAF(1),PAF(2),PAF(3)); }
  #undef PKW
  #undef PAF
  #undef VFR
  #undef PIN
  #undef MX3
  #undef GAPA
  #undef GAPB2
  #undef MF32
  #undef EX
  #undef VRDF
  #undef KRD
  #undef STEP
  #undef ENDW
  {auto rr=__builtin_amdgcn_permlane32_swap(__float_as_uint(l_reg),__float_as_uint(l_reg),false,false);l_reg=__uint_as_float(rr[0])+__uint_as_float(rr[1]);}
  if(hi==0)wsf[32+r32]=l_reg;asm volatile("s_waitcnt lgkmcnt(0)":::"memory");
  float rli[16];
  #pragma unroll
  for(int r=0;r<16;++r)rli[r]=__builtin_amdgcn_rcpf(wsf[32+crow(r,hi)]);
  bf16*Ow=O+(long)(q0+wid*QBLK)*OP;
  { bf16*stg=(bf16*)(shm+LDS_OST)+wid*2048;
    #pragma unroll
    for(int p=0;p<2;++p){
      #pragma unroll
      for(int r=0;r<16;++r){const int orow=crow(r,hi);
        #pragma unroll
        for(int d0=0;d0<2;++d0)stg[orow*64+d0*32+r32]=__float2bfloat16(o[2*p+d0][r]*rli[r]);}
      asm volatile("s_waitcnt lgkmcnt(0)":::"memory");
      #pragma unroll
      for(int i=0;i<4;++i){const int row=i*8+(lane>>3),ch=lane&7; const u32x4 v=*(const u32x4*)(stg+row*64+ch*8); ATTN_STORE16(Ow+(long)row*OP+p*64+ch*8,v);}
      asm volatile("s_waitcnt lgkmcnt(0)":::"memory");
    } }
  asm volatile("s_waitcnt lgkmcnt(0)\n\ts_barrier":::"memory");
  #undef DMA_K
  #undef DMA_V
  #undef CMASK
  #undef START
  #undef RESC
  #undef ROT
}
constexpr int ATTN_LDS_BYTES=LDS_BYTES;
struct AttnTensors { const bf16* Q; const bf16* K; const bf16* V; bf16* O; };
struct AttnUnit { int bh; int qb; };
struct StaticOrder {
  int vcu;
  __device__ __forceinline__ explicit StaticOrder(int grid,int block):vcu((block%8)*(grid/8)+block/8){}
  __device__ __forceinline__ bool next(int i,AttnUnit&u)const{ if(i>=2)return false; const int s=vcu&15; u.bh=vcu>>4; u.qb=(i==0)?31-s:s; return true; }
  __device__ __forceinline__ void a_ready(const AttnUnit&)const{}
  __device__ __forceinline__ void done(const AttnUnit&)const{}
};
template<class Sched,int THRL=8> __device__ __forceinline__ void attn_phase(char*lds,const AttnTensors&T,const Sched&S){
  AttnUnit u;
  for(int i=0;S.next(i,u);++i){ S.a_ready(u); { const int p=u.bh;   attn_unit<THRL>(u.qb,T.Q+p*64,T.K+p*64,T.V+(p>>1)*128,T.O+(p&1)*1024+(p>>1)*128,lds); } S.done(u); }
}
#undef SBAR
#undef WAIT_BAR
}
#ifndef FILLER
#define FILLER 1
#endif
#ifndef PROBE_SLEEP
#define PROBE_SLEEP 0
#endif
#ifndef WIN_SPLIT
#define WIN_SPLIT 0
#endif
#ifndef LOCAL_BAR
#define LOCAL_BAR 1
#endif
#ifndef PROBE_CLK
#define PROBE_CLK 0
#endif
#ifndef PROBE_DUP
#define PROBE_DUP 0
#endif
constexpr int NWAVES = 8;
constexpr int M = 8192, D = 2048, FF = 5632, NIN = 6144, DEPTH = 4;
constexpr float EPS = 1e-5f;
__device__ const float INV_FREQ[8] = {1.0f, 0.1939227432012558f, 0.03760603070259094f, 0.007292664609849453f, 0.0014142135623842478f, 0.00027424818836152554f, 5.3182957344688475e-05f, 1.0313385246263351e-05f};
__device__ const float LAM_INIT[4] = {0.2f, 0.35550906759096934f, 0.4707130183435842f, 0.5560582041556406f};
constexpr size_t MiB = 1u << 20;
constexpr size_t WS_CTL = 0, CTL_ZERO_BYTES = 3 * MiB;
constexpr size_t WS_CS = 1 * MiB;
constexpr size_t WS_SSQ = 2 * MiB;
constexpr size_t WS_W = 3 * MiB;
constexpr size_t WO_GU1 = 0, WO_D1 = 44 * MiB, WO_IN = 66 * MiB, WO_OUT = 90 * MiB, WO_GU2 = 98 * MiB, WO_D2 = 142 * MiB, W_LAYER = 164 * MiB;
constexpr size_t WS_XB = WS_W + DEPTH * W_LAYER;
constexpr size_t WS_ACT = WS_XB + 32 * MiB;
constexpr size_t WS_Q = WS_ACT + 88 * MiB, WS_K = WS_Q + 16 * MiB, WS_V = WS_K + 16 * MiB, WS_GB = WS_V + 16 * MiB, WS_CU = WS_GB + 16 * MiB;
constexpr size_t WS_O = WS_CU + 16 * MiB;
constexpr size_t WS_MIX = WS_O + 32 * MiB;
constexpr size_t WS_END = WS_MIX + 32 * MiB;
static_assert((size_t)2 * FF * D * 2 == 44 * MiB && (size_t)FF * D * 2 == 22 * MiB && (size_t)NIN * D * 2 == 24 * MiB && (size_t)D * D * 2 == 8 * MiB && (size_t)M * FF * 2 == 88 * MiB, "d_ws map");
constexpr int CW_BAR = 4096;
constexpr int RING_OFF = 0, RING_BYTES = 131072;
constexpr int LDSCTL_OFF = RING_BYTES, MISC_OFF = LDSCTL_OFF + 320;
constexpr int LDS_BYTES = 147456;
static_assert(MISC_OFF + 128 <= pg8::RSTD_OFF && pg8::RSTD_OFF == LDSCTL_OFF + 1024 && pg8::RSTD_OFF + 1024 <= LDS_BYTES, "LDS map");
#define GAS __attribute__((address_space(1)))
#define LAS __attribute__((address_space(3)))
typedef unsigned short bf16;
typedef unsigned v4u __attribute__((ext_vector_type(4)));
typedef float f32x4 __attribute__((ext_vector_type(4)));
typedef short bf16x8 __attribute__((ext_vector_type(8)));
typedef GAS unsigned gu32;
typedef GAS unsigned long long gu64;
#define RLX_AGENT __ATOMIC_RELAXED, __HIP_MEMORY_SCOPE_AGENT
#define LDS_WAIT() asm volatile("s_waitcnt lgkmcnt(0)" ::: "memory")
#define VM_WAIT() asm volatile("s_waitcnt vmcnt(0)" ::: "memory")
__device__ __forceinline__ unsigned long long rt() { return __builtin_amdgcn_s_memrealtime(); }
__device__ __forceinline__ unsigned f2bf(float f) { unsigned u = __builtin_bit_cast(unsigned, f); return (u + 0x7fffu + ((u >> 16) & 1u)) >> 16; }
__device__ __forceinline__ unsigned pk2(float lo, float hi) { return f2bf(lo) | (f2bf(hi) << 16); }

#define XB_TMO      128
#define XB_XCNT(j)  (256  + 64 * (j))
#define XB_XSUB(j)  (1280 + 64 * (j))
#define XB_XGEN(j)  (2304 + 64 * (j))
#define XB_TOP      3328
#define XB_TOPGEN   3392
#define XCD_BAR_WORDS 3456
#define XB_SPIN_CAP (1u << 18)

__device__ __forceinline__ unsigned xb_ld(unsigned* p)              { return __hip_atomic_load(p, __ATOMIC_RELAXED, __HIP_MEMORY_SCOPE_AGENT); }
__device__ __forceinline__ unsigned xb_add(unsigned* p, unsigned v) { return __hip_atomic_fetch_add(p, v, __ATOMIC_RELAXED, __HIP_MEMORY_SCOPE_AGENT); }
__device__ __forceinline__ unsigned xb_xcc_id() { return (unsigned)__builtin_amdgcn_s_getreg((3 << 11) | 20) & 0xFu; }
#define XB_SPIN(cond, bar) do { unsigned _sp = 0; while (cond) { __builtin_amdgcn_s_sleep(1); \
    if ((++_sp & 255u) == 0u) { if (xb_ld(&(bar)[XB_TMO])) break; if (_sp > XB_SPIN_CAP) { atomicAdd(&(bar)[XB_TMO], 1u); break; } } } } while (0)

struct XcdBarrier {
    unsigned* bar; unsigned x;
    volatile LAS unsigned* st;
};

__device__ __forceinline__ XcdBarrier xcd_barrier_post(unsigned* bar, volatile LAS unsigned* st) {
    XcdBarrier b; b.bar = bar; b.x = xb_xcc_id(); b.st = st;
    if (threadIdx.x == 0) (void)xb_add(&bar[XB_XCNT(b.x)], 1u);
    return b;
}
__device__ __forceinline__ void xcd_barrier_complete(unsigned* bar, unsigned x, unsigned& nloc, unsigned& nx) {
    const unsigned G = gridDim.x * gridDim.y * gridDim.z;
    unsigned sum, cnt, mine, sp = 0u;
    for (;;) {
        sum = 0u; cnt = 0u; mine = 0u;
#pragma unroll
        for (unsigned j = 0; j < 16; ++j) { const unsigned c = xb_ld(&bar[XB_XCNT(j)]); sum += c; cnt += (c > 0u) ? 1u : 0u; mine = (j == x) ? c : mine; }
        if (sum == G) break;
        __builtin_amdgcn_s_sleep(1);
        if ((++sp & 255u) == 0u) { if (xb_ld(&bar[XB_TMO])) break; if (sp > XB_SPIN_CAP) { atomicAdd(&bar[XB_TMO], 1u); break; } }
    }
    nloc = mine > 0u ? mine : 1u; nx = cnt > 0u ? cnt : 1u;
}

__device__ __forceinline__ void xcd_barrier(const XcdBarrier& b) {
    asm volatile("s_waitcnt vmcnt(0)" ::: "memory");
    __syncthreads();
    if (threadIdx.x == 0) {
        unsigned* bar = b.bar;
        __builtin_amdgcn_s_waitcnt(0);
        unsigned nloc = b.st[0], nx = b.st[1];
        if (nloc == 0u) { xcd_barrier_complete(bar, b.x, nloc, nx); b.st[0] = nloc; b.st[1] = nx; }
        const unsigned old = xb_add(&bar[XB_XSUB(b.x)], 1u);
        const unsigned gen = old / nloc;
        if (old + 1u == (gen + 1u) * nloc) {
            __builtin_amdgcn_fence(__ATOMIC_RELEASE, "agent");
            asm volatile("s_waitcnt vmcnt(0)" ::: "memory");
            const unsigned og = xb_add(&bar[XB_TOP], 1u);
            const unsigned tg = og / nx;
            if (og + 1u == (tg + 1u) * nx) xb_add(&bar[XB_TOPGEN], 1u);
            else XB_SPIN(xb_ld(&bar[XB_TOPGEN]) == tg, bar);
            __builtin_amdgcn_fence(__ATOMIC_ACQUIRE, "agent");
            xb_add(&bar[XB_XGEN(b.x)], 1u);
            asm volatile("s_waitcnt vmcnt(0)" ::: "memory");
        } else {
            XB_SPIN(xb_ld(&bar[XB_XGEN(b.x)]) == gen, bar);
            __builtin_amdgcn_fence(__ATOMIC_ACQUIRE, "agent");
            asm volatile("s_waitcnt vmcnt(0)" ::: "memory");
        }
    }
    __syncthreads();
}

#define XB_LSUB(j)  (3456 + 64 * (j))
#define XB_LGEN(j)  (4480 + 64 * (j))
__device__ __forceinline__ void xcd_barrier_local(const XcdBarrier& b) {
    asm volatile("s_waitcnt vmcnt(0)" ::: "memory");
    __syncthreads();
    if (threadIdx.x == 0) {
        unsigned* bar = b.bar; const unsigned nloc = b.st[0];
        const unsigned old = xb_add(&bar[XB_LSUB(b.x)], 1u); const unsigned gen = old / nloc;
        if (old + 1u == (gen + 1u) * nloc) xb_add(&bar[XB_LGEN(b.x)], 1u);
        else XB_SPIN(xb_ld(&bar[XB_LGEN(b.x)]) == gen, bar);
        __builtin_amdgcn_fence(__ATOMIC_ACQUIRE, "agent");
        asm volatile("s_waitcnt vmcnt(0)" ::: "memory");
    }
    __syncthreads();
}

struct Frame {
    LAS unsigned char* lds;
    volatile LAS unsigned* MISC;
    gu32* ctl;
    int tid, lane, wave;
    int vcu, G;
};

__device__ __forceinline__ float shx(float v, int lane, int mask) { return __int_as_float(__builtin_amdgcn_ds_bpermute((lane ^ mask) << 2, __float_as_int(v))); }
__device__ __forceinline__ float wave_sum(float v, int lane) {
#pragma unroll
    for (int o = 1; o < 64; o <<= 1) v += shx(v, lane, o);
    return v;
}
__device__ __forceinline__ float bflo(unsigned w) { return __uint_as_float(w << 16); }
__device__ __forceinline__ float bfhi(unsigned w) { return __uint_as_float(w & 0xffff0000u); }

__device__ __forceinline__ int dst_row(int kind, int ns) {
    if (kind == 0) return ns;
    if (kind == 1) return 256 * (ns >> 7) + (ns & 127);
    if (kind == 2) return 256 * (ns >> 7) + 128 + (ns & 127);
    if (ns < 2048) { const int d = ns & 63; const int c = d < 8 ? 2 * d : d < 16 ? 2 * (d - 8) + 1 : d; return (ns & ~63) + c; }
    if (ns < 4096) return ns;
    if (ns < 5120) { const int j = ns - 4096; return 4096 + 256 * (j >> 7) + (j & 127); }
    { const int j = ns - 5120; return 4096 + 256 * (j >> 7) + 128 + (j & 127); }
}
struct CvtItem { const float* W; bf16* WT; const float* gain; int K, N, kind, r; };
__device__ __forceinline__ void cvt_load(const CvtItem& c, int lane, float (&t)[32]) {
    const int nblk = c.N / 32, kb = c.r / nblk, nb = c.r % nblk;
    const float* src = c.W + (size_t)(64 * kb + (lane >> 5)) * c.N + 32 * nb + (lane & 31);
#pragma unroll
    for (int i = 0; i < 32; ++i) t[i] = __builtin_nontemporal_load(src + (size_t)(2 * i) * c.N);
}
__device__ __forceinline__ void cvt_store(const CvtItem& c, int lane, LAS float* scr) {
    const int nblk = c.N / 32, kb = c.r / nblk, nb = c.r % nblk, k0 = 64 * kb, n0 = 32 * nb;
    const int ch = lane & 7;
    f32x4 ga = (f32x4){1.f, 1.f, 1.f, 1.f}, gb = ga;
    if (c.gain) { ga = *(const f32x4*)(c.gain + k0 + 8 * ch); gb = *(const f32x4*)(c.gain + k0 + 8 * ch + 4); }
#pragma unroll
    for (int j = 0; j < 4; ++j) { const int n = (lane >> 3) + 8 * j; const LAS float* s = scr + (8 * ch) * 33 + n;
        v4u o; o.x = pk2(s[0 * 33] * ga[0], s[1 * 33] * ga[1]); o.y = pk2(s[2 * 33] * ga[2], s[3 * 33] * ga[3]); o.z = pk2(s[4 * 33] * gb[0], s[5 * 33] * gb[1]); o.w = pk2(s[6 * 33] * gb[2], s[7 * 33] * gb[3]);
        *(GAS v4u*)(c.WT + (size_t)dst_row(c.kind, n0 + n) * c.K + k0 + 8 * ch) = o; }
}

__device__ __forceinline__ void stats_phase(Frame& F, const float* x, bf16* XB, unsigned long long* SSQ) {
    const int gw = F.vcu * NWAVES + F.wave, NGW = F.G * NWAVES;
    for (int m = gw; m < M; m += NGW) {
        const float* xr = x + (size_t)m * D; f32x4 v[8]; float s = 0.f;
#pragma unroll
        for (int j = 0; j < 4; ++j) { v[2 * j] = *(const GAS f32x4*)(xr + 512 * j + 8 * F.lane); v[2 * j + 1] = *(const GAS f32x4*)(xr + 512 * j + 8 * F.lane + 4); }
#pragma unroll
        for (int j = 0; j < 8; ++j) s += (v[j].x * v[j].x + v[j].y * v[j].y) + (v[j].z * v[j].z + v[j].w * v[j].w);
        s = wave_sum(s, F.lane);
        if (F.lane == 0) SSQ[m] = (unsigned long long)(s * 16777216.0f);
        bf16* hr = XB + (size_t)m * D;
#pragma unroll
        for (int j = 0; j < 4; ++j) { const f32x4 a = v[2 * j], b = v[2 * j + 1];
            v4u o; o.x = pk2(a.x, a.y); o.y = pk2(a.z, a.w); o.z = pk2(b.x, b.y); o.w = pk2(b.z, b.w);
            *(GAS v4u*)(hr + 512 * j + 8 * F.lane) = o; }
    }
}
__device__ __forceinline__ void final_norm_phase(Frame& F, const bf16* xb, const float* g, float* out) {
    const int gw = F.vcu * NWAVES + F.wave, NGW = F.G * NWAVES;
    f32x4 gv[8];
#pragma unroll
    for (int j = 0; j < 4; ++j) { gv[2 * j] = *(const f32x4*)(g + 512 * j + 8 * F.lane); gv[2 * j + 1] = *(const f32x4*)(g + 512 * j + 8 * F.lane + 4); }
    for (int m = gw; m < M; m += NGW) {
        v4u v[4]; float s = 0.f;
#pragma unroll
        for (int j = 0; j < 4; ++j) v[j] = *(const GAS v4u*)(xb + (size_t)m * D + 512 * j + 8 * F.lane);
#pragma unroll
        for (int j = 0; j < 4; ++j)
#pragma unroll
            for (int q = 0; q < 4; ++q) { const float lo = bflo(v[j][q]), hi = bfhi(v[j][q]); s += lo * lo + hi * hi; }
        const float rstd = 1.0f / sqrtf(wave_sum(s, F.lane) * (1.f / D) + EPS);
        float* orow = out + (size_t)m * D;
#pragma unroll
        for (int j = 0; j < 4; ++j) {
            const f32x4 a = (f32x4){bflo(v[j][0]), bfhi(v[j][0]), bflo(v[j][1]), bfhi(v[j][1])} * rstd * gv[2 * j], b = (f32x4){bflo(v[j][2]), bfhi(v[j][2]), bflo(v[j][3]), bfhi(v[j][3])} * rstd * gv[2 * j + 1];
            *(GAS f32x4*)(orow + 512 * j + 8 * F.lane) = a; *(GAS f32x4*)(orow + 512 * j + 8 * F.lane + 4) = b; }
    }
}
__device__ __forceinline__ void fin_phase(Frame& F, const bf16* O, const bf16* GB, const bf16* CU, bf16* MIX, const float* lq1, const float* lk1, const float* lq2, const float* lk2,
                                          const float* subw, const float* convw, float lam_init) {
    const int gw = F.vcu * NWAVES + F.wave, NGW = F.G * NWAVES, lane = F.lane;
    const float lam = expf(wave_sum(lq1[lane] * lk1[lane], lane)) - expf(wave_sum(lq2[lane] * lk2[lane], lane)) + lam_init;
    const float om = 1.0f - lam_init;
    const int c0 = 16 * lane;
    float sw[16], w0[16], w1[16], w2[16];
#pragma unroll
    for (int j = 0; j < 16; ++j) { sw[j] = subw[(c0 & 127) + j] * om; w0[j] = convw[c0 + j]; w1[j] = convw[1024 + c0 + j]; w2[j] = convw[2048 + c0 + j]; }
    for (int mb = 512 * (gw >> 8) + (gw & 255); mb < 512 * (gw >> 8) + 512; mb += 256) {
        v4u a0[2], a1[2], b0[2], b1[2], g0[2], g1[2], x0[2], x1[2], y0[2], y1[2], u0[2], u1[2];
        const v4u z = (v4u){0u, 0u, 0u, 0u};
#pragma unroll
        for (int k = 0; k < 2; ++k) { const int m = 2 * mb + k;
            a0[k] = *(const GAS v4u*)(O + (size_t)m * 2048 + c0); a1[k] = *(const GAS v4u*)(O + (size_t)m * 2048 + c0 + 8);
            b0[k] = *(const GAS v4u*)(O + (size_t)m * 2048 + 1024 + c0); b1[k] = *(const GAS v4u*)(O + (size_t)m * 2048 + 1024 + c0 + 8);
            g0[k] = *(const GAS v4u*)(GB + (size_t)m * 1024 + c0); g1[k] = *(const GAS v4u*)(GB + (size_t)m * 1024 + c0 + 8);
            x0[k] = *(const GAS v4u*)(CU + (size_t)m * 1024 + c0); x1[k] = *(const GAS v4u*)(CU + (size_t)m * 1024 + c0 + 8); }
        y0[1] = x0[0]; y1[1] = x1[0];
        y0[0] = mb >= 1 ? *(const GAS v4u*)(CU + (size_t)(2 * mb - 1) * 1024 + c0) : z; y1[0] = mb >= 1 ? *(const GAS v4u*)(CU + (size_t)(2 * mb - 1) * 1024 + c0 + 8) : z;
        u0[1] = y0[0]; u1[1] = y1[0];
        u0[0] = mb >= 1 ? *(const GAS v4u*)(CU + (size_t)(2 * mb - 2) * 1024 + c0) : z; u1[0] = mb >= 1 ? *(const GAS v4u*)(CU + (size_t)(2 * mb - 2) * 1024 + c0 + 8) : z;
#pragma unroll
        for (int k = 0; k < 2; ++k) { const int m = 2 * mb + k;
            float d[16]; float ss = 0.f;
#pragma unroll
            for (int q = 0; q < 4; ++q) { d[2 * q] = bflo(a0[k][q]) - lam * bflo(b0[k][q]); d[2 * q + 1] = bfhi(a0[k][q]) - lam * bfhi(b0[k][q]); d[8 + 2 * q] = bflo(a1[k][q]) - lam * bflo(b1[k][q]); d[8 + 2 * q + 1] = bfhi(a1[k][q]) - lam * bfhi(b1[k][q]); }
#pragma unroll
            for (int j = 0; j < 16; ++j) ss += d[j] * d[j];
            ss += shx(ss, lane, 1); ss += shx(ss, lane, 2); ss += shx(ss, lane, 4);
            const float rs = 1.0f / sqrtf(ss * (1.f / 128.f) + EPS);
            v4u o0, o1;
#pragma unroll
            for (int q = 0; q < 4; ++q) { o0[q] = pk2(d[2 * q] * rs * sw[2 * q], d[2 * q + 1] * rs * sw[2 * q + 1]); o1[q] = pk2(d[8 + 2 * q] * rs * sw[8 + 2 * q], d[8 + 2 * q + 1] * rs * sw[8 + 2 * q + 1]); }
            *(GAS v4u*)(MIX + (size_t)m * 2048 + c0) = o0; *(GAS v4u*)(MIX + (size_t)m * 2048 + c0 + 8) = o1;
            v4u p0, p1;
#pragma unroll
            for (int q = 0; q < 4; ++q) {
                const float e0 = bflo(g0[k][q]) * (w0[2 * q] * bflo(u0[k][q]) + w1[2 * q] * bflo(y0[k][q]) + w2[2 * q] * bflo(x0[k][q]));
                const float e1 = bfhi(g0[k][q]) * (w0[2 * q + 1] * bfhi(u0[k][q]) + w1[2 * q + 1] * bfhi(y0[k][q]) + w2[2 * q + 1] * bfhi(x0[k][q]));
                const float e2 = bflo(g1[k][q]) * (w0[8 + 2 * q] * bflo(u1[k][q]) + w1[8 + 2 * q] * bflo(y1[k][q]) + w2[8 + 2 * q] * bflo(x1[k][q]));
                const float e3 = bfhi(g1[k][q]) * (w0[8 + 2 * q + 1] * bfhi(u1[k][q]) + w1[8 + 2 * q + 1] * bfhi(y1[k][q]) + w2[8 + 2 * q + 1] * bfhi(x1[k][q]));
                p0[q] = pk2(e0, e1); p1[q] = pk2(e2, e3); }
            *(GAS v4u*)(MIX + (size_t)m * 2048 + 1024 + c0) = p0; *(GAS v4u*)(MIX + (size_t)m * 2048 + 1024 + c0 + 8) = p1; }
    }
}

struct Args { const float* in[19]; float* out; unsigned char* ws; };
typedef const __attribute__((address_space(4))) Args* cargs_t;
__device__ __forceinline__ cargs_t get_args() { cargs_t p = (cargs_t)__builtin_amdgcn_kernarg_segment_ptr(); asm volatile("" : "+s"(p)); return p; }
__device__ __forceinline__ int bid_o() { int b = (int)__builtin_amdgcn_readfirstlane((int)*(volatile LAS unsigned*)(size_t)(MISC_OFF + 40)); asm volatile("" : "+s"(b)); return b; }
__device__ __forceinline__ int gdim_o() { int g = gridDim.x; asm volatile("" : "+s"(g)); return g; }
__device__ __forceinline__ void make_frame(Frame& F, unsigned char* lds) {
    F.lds = (LAS unsigned char*)lds; F.MISC = (volatile LAS unsigned*)(F.lds + MISC_OFF);
    { int t_ = threadIdx.x; asm volatile("" : "+v"(t_)); F.tid = t_; } F.lane = F.tid & 63; F.wave = __builtin_amdgcn_readfirstlane(F.tid >> 6);
    F.G = gdim_o(); { const int bx = bid_o(); F.vcu = (F.G % 8 == 0) ? (bx % 8) * (F.G / 8) + bx / 8 : bx; }
    F.ctl = (gu32*)(get_args()->ws + WS_CTL);
}
__device__ __forceinline__ void grid_bar(unsigned char* lds) {
    XcdBarrier b; b.bar = (unsigned*)(get_args()->ws + WS_CTL) + CW_BAR; b.x = xb_xcc_id(); b.st = (volatile LAS unsigned*)((LAS unsigned char*)lds + MISC_OFF) + 8;
    xcd_barrier(b);
#if PROBE_BAR2
    xcd_barrier(b);
#endif
#if PROBE_SLEEP
    { const unsigned long long t0 = __builtin_amdgcn_s_memrealtime(); while (__builtin_amdgcn_s_memrealtime() - t0 < 1000ull) __builtin_amdgcn_s_sleep(32); }
#endif
}
__device__ __forceinline__ void grid_bar_local(unsigned char* lds) {
#if LOCAL_BAR
    if (*((volatile LAS unsigned*)((LAS unsigned char*)lds + MISC_OFF) + 11) == 0u) { grid_bar(lds); return; }
    XcdBarrier b; b.bar = (unsigned*)(get_args()->ws + WS_CTL) + CW_BAR; b.x = xb_xcc_id(); b.st = (volatile LAS unsigned*)((LAS unsigned char*)lds + MISC_OFF) + 8;
    xcd_barrier_local(b);
#else
    grid_bar(lds);
#endif
}
__device__ __forceinline__ unsigned char* wlayer(cargs_t a, int l) { return a->ws + WS_W + (size_t)l * W_LAYER; }

constexpr int I_G = (D / 64) * (FF / 32), I_D = (FF / 64) * (D / 32), I_IN = (D / 64) * (NIN / 32), I_OUT = (D / 64) * (D / 32), I_LAYER = 4 * I_G + 2 * I_D + I_IN + I_OUT;
constexpr int CVT_B0 = 2 * I_G, CVT_UP2 = 4 * I_G + I_D + I_IN + I_OUT;
__device__ __forceinline__ int cvt_end(int s) { const int e = CVT_UP2 + s * (I_LAYER / 2); return e < DEPTH * I_LAYER ? e : DEPTH * I_LAYER; }
__device__ __forceinline__ void cvt_decode(cargs_t a, int l, int it, CvtItem& c) {
    unsigned char* wl = a->ws + WS_W + (size_t)l * W_LAYER; int r = it;
    if (r < I_G) { c = CvtItem{a->in[2] + (size_t)l * D * FF, (bf16*)(wl + WO_GU1), a->in[1] + (size_t)l * D, D, FF, 1, r}; return; } r -= I_G;
    if (r < I_G) { c = CvtItem{a->in[3] + (size_t)l * D * FF, (bf16*)(wl + WO_GU1), a->in[1] + (size_t)l * D, D, FF, 2, r}; return; } r -= I_G;
    if (r < I_D) { c = CvtItem{a->in[4] + (size_t)l * FF * D, (bf16*)(wl + WO_D1), nullptr, FF, D, 0, r}; return; } r -= I_D;
    if (r < I_IN) { c = CvtItem{a->in[6] + (size_t)l * D * NIN, (bf16*)(wl + WO_IN), a->in[5] + (size_t)l * D, D, NIN, 3, r}; return; } r -= I_IN;
    if (r < I_OUT) { c = CvtItem{a->in[13] + (size_t)l * D * D, (bf16*)(wl + WO_OUT), nullptr, D, D, 0, r}; return; } r -= I_OUT;
    if (r < I_G) { c = CvtItem{a->in[15] + (size_t)l * D * FF, (bf16*)(wl + WO_GU2), a->in[14] + (size_t)l * D, D, FF, 1, r}; return; } r -= I_G;
    if (r < I_G) { c = CvtItem{a->in[16] + (size_t)l * D * FF, (bf16*)(wl + WO_GU2), a->in[14] + (size_t)l * D, D, FF, 2, r}; return; } r -= I_G;
    c = CvtItem{a->in[17] + (size_t)l * FF * D, (bf16*)(wl + WO_D2), nullptr, FF, D, 0, r};
}
__device__ __forceinline__ void convert_items(unsigned char* lds, int lo, int hi, int worker, int nworkers) {
    Frame F; make_frame(F, lds); cargs_t a = get_args();
    LAS float* scr = (LAS float*)(F.lds + RING_OFF + F.wave * 16384);
    int it = lo + worker; if (it >= hi) return;
    CvtItem cur, nxt; float t[32];
    cvt_decode(a, it / I_LAYER, it % I_LAYER, cur); cvt_load(cur, F.lane, t);
    for (;;) {
#pragma unroll
        for (int i = 0; i < 32; ++i) scr[(2 * i + (F.lane >> 5)) * 33 + (F.lane & 31)] = t[i];
        LDS_WAIT(); asm volatile("" ::: "memory");
        const int ni = it + nworkers; const bool more = ni < hi;
        if (more) { cvt_decode(a, ni / I_LAYER, ni % I_LAYER, nxt); cvt_load(nxt, F.lane, t); }
        cvt_store(cur, F.lane, scr);
        LDS_WAIT(); asm volatile("" ::: "memory");
        if (!more) break;
        cur = nxt; it = ni;
    }
}
__device__ __forceinline__ void ph_prologue(unsigned char* lds) {
    Frame F; make_frame(F, lds);
    convert_items(lds, 0, FILLER ? CVT_B0 : DEPTH * I_LAYER, F.vcu * NWAVES + F.wave, F.G * NWAVES);
    cargs_t a = get_args(); unsigned char* ws = a->ws;
    float* CS = (float*)(ws + WS_CS);
    for (int i = bid_o() * (NWAVES * 64) + F.tid; i < M * 8; i += F.G * NWAVES * 64) {
        const int pos = i >> 3, fi = i & 7; const float ang = (float)pos * INV_FREQ[fi];
        CS[(size_t)pos * 16 + fi] = cosf(ang); CS[(size_t)pos * 16 + 8 + fi] = sinf(ang); }
    stats_phase(F, a->in[0], (bf16*)(ws + WS_XB), (unsigned long long*)(ws + WS_SSQ));
}
__device__ __forceinline__ void ph_gateup(unsigned char* lds, int l, int second) {
    { cargs_t a = get_args(); unsigned char* ws = a->ws;
      pg8::Gemm g{(const bf16*)(ws + WS_XB), (const bf16*)(wlayer(a, l) + (second ? WO_GU2 : WO_GU1)), M, 2 * FF, D}; pg8::StaticOrder S; S.init(M, 2 * FF, gdim_o(), bid_o());
      pg8::EpiSwiGLU E{(bf16*)(ws + WS_ACT), FF, (const unsigned long long*)(ws + WS_SSQ) + (3 * l + (second ? 2 : 0)) * M};
#if PROBE_CLK == 1
      unsigned long long c0_ = __builtin_amdgcn_s_memtime(), r0_ = __builtin_amdgcn_s_memrealtime();
#endif
      pg8::gemm_phase<pg8::EpiSwiGLU, pg8::StaticOrder, PG8_ALIGN, PG8_SP2>((LAS unsigned char*)lds + RING_OFF, g, S, E);
#if PROBE_CLK == 1
      { const unsigned long long c1_ = __builtin_amdgcn_s_memtime(), r1_ = __builtin_amdgcn_s_memrealtime(); volatile LAS unsigned* MISC = (volatile LAS unsigned*)((LAS unsigned char*)lds + MISC_OFF);
        if (threadIdx.x == 0) { MISC[14] += (unsigned)((c1_ - c0_) >> 4); MISC[15] += (unsigned)(r1_ - r0_); } }
#endif
      }
    const int bx = bid_o();
    if (FILLER && bx >= 128 && gdim_o() == 256) {
        int t_ = threadIdx.x; asm volatile("" : "+v"(t_)); const int wave = __builtin_amdgcn_readfirstlane(t_ >> 6);
        const int s = 2 * l + second;
        convert_items(lds, s == 0 ? CVT_B0 : cvt_end(s - 1), cvt_end(s), (bx - 128) * NWAVES + wave, 128 * NWAVES);
#if PROBE_DUP == 5
        convert_items(lds, s == 0 ? CVT_B0 : cvt_end(s - 1), cvt_end(s), (bx - 128) * NWAVES + wave, 128 * NWAVES);
#endif
    }
}
__device__ __forceinline__ void ph_down(unsigned char* lds, int l, int second, int dummy = 0) {
    cargs_t a = get_args(); unsigned char* ws = a->ws;
    pg8::Gemm g{(const bf16*)(ws + WS_ACT), (const bf16*)(wlayer(a, l) + (second ? WO_D2 : WO_D1)), M, D, FF}; pg8::StaticOrder S; S.init(M, D, gdim_o(), bid_o());
    pg8::EpiResidual E{(bf16*)(ws + WS_XB), D, 0.5f, (unsigned long long*)(ws + WS_SSQ) + (3 * l + (second ? 3 : 1)) * M};
    pg8::gemm_phase<pg8::EpiResidual, pg8::StaticOrder, PG8_ALIGN1, PG8_SP2>((LAS unsigned char*)lds + RING_OFF, g, S, E);
}
template <int MODE> __device__ __forceinline__ void ph_win_part(unsigned char* lds, int l) {
    cargs_t a = get_args(); unsigned char* ws = a->ws;
    pg8::Gemm g{(const bf16*)(ws + WS_XB), (const bf16*)(wlayer(a, l) + WO_IN) + (size_t)MODE * 2048 * D, M, D, D}; pg8::StaticOrder S; S.init(M, D, gdim_o(), bid_o());
    pg8::EpiWin<MODE> E{(bf16*)(ws + (MODE == 0 ? WS_Q : MODE == 1 ? WS_V : WS_CU)), (bf16*)(ws + (MODE == 0 ? WS_K : WS_GB)), (const float*)(ws + WS_CS), attn_body::C2, (const unsigned long long*)(ws + WS_SSQ) + (3 * l + 1) * M};
    pg8::gemm_phase<pg8::EpiWin<MODE>, pg8::StaticOrder, PG8_ALIGN, PG8_SP2>((LAS unsigned char*)lds + RING_OFF, g, S, E);
}
#if WIN_SPLIT
__device__ __forceinline__ void ph_win(unsigned char* lds, int l) { ph_win_part<0>(lds, l); ph_win_part<1>(lds, l); ph_win_part<2>(lds, l); }
#else
__device__ __forceinline__ void ph_win(unsigned char* lds, int l) {
    cargs_t a = get_args(); unsigned char* ws = a->ws;
    const bf16* W = (const bf16*)(wlayer(a, l) + WO_IN);
    pg8::Gemm g{(const bf16*)(ws + WS_XB), W, M, D, D}; pg8::StaticOrder S; S.init(M, D, gdim_o(), bid_o());
    const float* cs = (const float*)(ws + WS_CS); const unsigned long long* ssq = (const unsigned long long*)(ws + WS_SSQ) + (3 * l + 1) * M;
    pg8::EpiWin<0> E0{(bf16*)(ws + WS_Q), (bf16*)(ws + WS_K), cs, attn_body::C2, ssq};
    pg8::EpiWin<1> E1{(bf16*)(ws + WS_V), (bf16*)(ws + WS_GB), cs, attn_body::C2, ssq};
    pg8::EpiWin<2> E2{(bf16*)(ws + WS_CU), (bf16*)(ws + WS_GB), cs, attn_body::C2, ssq};
    const bf16* W1 = W + (size_t)2048 * D; const bf16* W2 = W + (size_t)4096 * D;
    asm volatile("" : "+s"(W1), "+s"(W2));
    pg8::gemm_phase3<pg8::EpiWin<0>, pg8::EpiWin<1>, pg8::EpiWin<2>, pg8::StaticOrder, PG8_ALIGN, PG8_SP2>((LAS unsigned char*)lds + RING_OFF, g, W1, W2, S, E0, E1, E2);
}

#endif
__device__ __forceinline__ void ph_attn(unsigned char* lds) {
    unsigned char* ws = get_args()->ws;
    const attn_body::AttnTensors AT{(const attn_body::bf16*)(ws + WS_Q), (const attn_body::bf16*)(ws + WS_K), (const attn_body::bf16*)(ws + WS_V), (attn_body::bf16*)(ws + WS_O)};
    const attn_body::StaticOrder S(gdim_o(), bid_o());
    attn_body::attn_phase<attn_body::StaticOrder>((char*)lds + RING_OFF, AT, S);
}
__device__ __forceinline__ void ph_fin(unsigned char* lds, int l) {
    Frame F; make_frame(F, lds); cargs_t a = get_args(); unsigned char* ws = a->ws;
    fin_phase(F, (const bf16*)(ws + WS_O), (const bf16*)(ws + WS_GB), (const bf16*)(ws + WS_CU), (bf16*)(ws + WS_MIX), a->in[8] + l * 64, a->in[9] + l * 64, a->in[10] + l * 64, a->in[11] + l * 64,
              a->in[12] + l * 128, a->in[7] + (size_t)l * 3 * 1024, LAM_INIT[l]);
}
__device__ __forceinline__ void ph_wout(unsigned char* lds, int l) {
    cargs_t a = get_args(); unsigned char* ws = a->ws;
    pg8::Gemm g{(const bf16*)(ws + WS_MIX), (const bf16*)(wlayer(a, l) + WO_OUT), M, D, D}; pg8::StaticOrder S; S.init(M, D, gdim_o(), bid_o());
    pg8::EpiResidual E{(bf16*)(ws + WS_XB), D, 1.0f, (unsigned long long*)(ws + WS_SSQ) + (3 * l + 2) * M};
    pg8::gemm_phase<pg8::EpiResidual, pg8::StaticOrder, PG8_ALIGN1, PG8_SP2>((LAS unsigned char*)lds + RING_OFF, g, S, E);
}
__device__ __forceinline__ void ph_final(unsigned char* lds) {
    Frame F; make_frame(F, lds); cargs_t a = get_args();
    final_norm_phase(F, (const bf16*)(a->ws + WS_XB), a->in[18], a->out);
}

__global__ void __launch_bounds__(NWAVES * 64, 2) mk_fwd(Args args) {
    extern __shared__ __attribute__((aligned(16))) unsigned char lds[];
    for (int u = threadIdx.x; u < (LDS_BYTES - LDSCTL_OFF) / 4; u += NWAVES * 64) ((LAS unsigned*)((LAS unsigned char*)lds + LDSCTL_OFF))[u] = 0u;
    __syncthreads();
    { volatile LAS unsigned* MISC = (volatile LAS unsigned*)((LAS unsigned char*)lds + MISC_OFF);
      if (threadIdx.x == 0) { unsigned* bar = (unsigned*)(get_args()->ws + WS_CTL) + CW_BAR; MISC[12] = xb_add(&bar[XB_XCNT(xb_xcc_id())], 1u); MISC[10] = blockIdx.x; }
      __syncthreads(); }
    ph_prologue(lds);
    grid_bar(lds);
    { volatile LAS unsigned* MISC = (volatile LAS unsigned*)((LAS unsigned char*)lds + MISC_OFF);
      if (threadIdx.x == 0) { unsigned* bar = (unsigned*)(get_args()->ws + WS_CTL) + CW_BAR; const unsigned x = xb_xcc_id(); bool ok = gridDim.x == 256u; unsigned npop = 0u, below = 0u;
          for (unsigned j = 0; j < 16u; ++j) { const unsigned c = xb_ld(&bar[XB_XCNT(j)]); if (c != 0u && c != 32u) ok = false; if (c == 32u) { ++npop; if (j < x) ++below; } }
          if (ok && npop == 8u && LOCAL_BAR) { MISC[10] = MISC[12] * 8u + below; MISC[11] = 1u; } }
      __syncthreads(); }
#if PROBE_DUP == 4
    ph_prologue(lds);
    grid_bar(lds);
#endif
#pragma unroll 1
    for (int l = 0; l < DEPTH; ++l) {
        ph_gateup(lds, l, 0); grid_bar(lds);
#if PROBE_DUP == 1
        ph_gateup(lds, l, 0); grid_bar(lds);
#endif
        ph_down(lds, l, 0); grid_bar_local(lds);
        ph_win(lds, l); grid_bar(lds);
#if PROBE_DUP == 3
        ph_win(lds, l); grid_bar(lds);
#endif
#if PROBE_CLK == 2
        { const unsigned long long c0_ = __builtin_amdgcn_s_memtime(), r0_ = __builtin_amdgcn_s_memrealtime();
          ph_attn(lds);
          const unsigned long long c1_ = __builtin_amdgcn_s_memtime(), r1_ = __builtin_amdgcn_s_memrealtime(); volatile LAS unsigned* MISC = (volatile LAS unsigned*)((LAS unsigned char*)lds + MISC_OFF);
          if (threadIdx.x == 0) { MISC[14] += (unsigned)((c1_ - c0_) >> 4); MISC[15] += (unsigned)(r1_ - r0_); } }
        grid_bar(lds);
#else
        ph_attn(lds); grid_bar(lds);
#endif
#if PROBE_DUP == 2
        ph_attn(lds); grid_bar(lds);
#endif
        ph_fin(lds, l); grid_bar_local(lds);
        ph_wout(lds, l); grid_bar_local(lds);
        ph_gateup(lds, l, 1); grid_bar(lds);
        ph_down(lds, l, 1); if (l + 1 < DEPTH) grid_bar_local(lds); else grid_bar(lds);
    }
    ph_final(lds);
#if PROBE_CLK
    { volatile LAS unsigned* MISC = (volatile LAS unsigned*)((LAS unsigned char*)lds + MISC_OFF);
      if (blockIdx.x == 0 && threadIdx.x == 0) { const unsigned long long tgt = (unsigned long long)MISC[14] * 16ull * 5000ull / (unsigned long long)(MISC[15] ? MISC[15] : 1u);
          const unsigned long long t0 = __builtin_amdgcn_s_memrealtime(); while (__builtin_amdgcn_s_memrealtime() - t0 < tgt) __builtin_amdgcn_s_sleep(32); } }
#endif
}

extern "C" void kernel_launch(void* const* d_in, const int* in_sizes, int n_in, void* d_out, int out_size, void* d_ws, size_t ws_size, hipStream_t stream) {
    static int grid = 0;
    if (grid == 0) {
        if (n_in != 19 || in_sizes[0] != M * D || out_size != M * D || ws_size < WS_END) { fprintf(stderr, "kernel_launch: built for 19 inputs, x and out of %d floats, >= %zu bytes of workspace; got n_in %d, in0 %d, out %d, ws %zu; nothing launched\n", M * D, (size_t)WS_END, n_in, n_in > 0 ? in_sizes[0] : -1, out_size, ws_size); grid = -1; return; }
        int dev = 0, cus = 0, per_cu = 0;
        if (hipGetDevice(&dev) != hipSuccess || hipDeviceGetAttribute(&cus, hipDeviceAttributeMultiprocessorCount, dev) != hipSuccess) { fprintf(stderr, "kernel_launch: hipGetDevice / hipDeviceGetAttribute failed; nothing launched\n"); grid = -1; return; }
        if (hipFuncSetAttribute((const void*)mk_fwd, hipFuncAttributeMaxDynamicSharedMemorySize, LDS_BYTES) != hipSuccess) { fprintf(stderr, "kernel_launch: hipFuncSetAttribute failed\n"); grid = -1; return; }
        if (hipOccupancyMaxActiveBlocksPerMultiprocessor(&per_cu, (const void*)mk_fwd, NWAVES * 64, LDS_BYTES) != hipSuccess || per_cu < 1)
            fprintf(stderr, "kernel_launch: note: the occupancy query reports %d workgroups per CU\n", per_cu);
        (void)hipGetLastError();
        grid = 256;
        if (cus != 256) fprintf(stderr, "kernel_launch: device has %d CUs; this kernel is built for 256\n", cus);
    }
    if (grid < 0) return;
    if (hipMemsetAsync((char*)d_ws + WS_CTL, 0, CTL_ZERO_BYTES, stream) != hipSuccess) { fprintf(stderr, "kernel_launch: hipMemsetAsync of the control words failed; nothing launched\n"); return; }
    Args a{};
    for (int i = 0; i < 19; ++i) a.in[i] = (const float*)d_in[i];
    a.out = (float*)d_out; a.ws = (unsigned char*)d_ws;
    hipLaunchKernelGGL(mk_fwd, dim3(grid), dim3(NWAVES * 64), LDS_BYTES, stream, a);
    const hipError_t le = hipPeekAtLastError();
    if (le != hipSuccess) fprintf(stderr, "kernel_launch: launch failed: %s\n", hipGetErrorName(le));
}
```
